# Optimizing an MI355X kernel written in HIP

```python
import math
import jax, jax.numpy as jnp
from jax import lax
import numpy as np

D_MODEL = 1024
BATCH = 4
SEQ = 4096
DEPTH = 1
DEC_BATCH = 128
DEC_SEQ = 8
PAST_LEN = 2048
PAGE_SIZE = 128

HEAD_DIM = 64
N_ATTN_HEADS = 8
N_KV_HEADS = 2
GROUP = N_ATTN_HEADS // N_KV_HEADS
N_RNN_HEADS = 8
RNN_DK = 64
RNN_DV = 64
ATTN_WIDTH = N_ATTN_HEADS * HEAD_DIM
RNN_WIDTH = N_RNN_HEADS * RNN_DV
MIX_WIDTH = ATTN_WIDTH + RNN_WIDTH
KV_WIDTH = N_KV_HEADS * HEAD_DIM
N_BRANCH = 3
CMP_BLOCK = 64
SEL_BLOCK = 64
SEL_TOPK = 16
WINDOW = 512
CMP_HIDDEN = 128
D_FF = 4 * D_MODEL
NSA_Q_BLOCK = 64
WIN_Q_BLOCK = 128
HGRN_CHUNK = 64
IN_WIDTH = ATTN_WIDTH + 6 * KV_WIDTH + N_ATTN_HEADS * N_BRANCH + 2 * N_RNN_HEADS * RNN_DK + 2 * RNN_WIDTH
SCALE = HEAD_DIM ** -0.5
EPS = 1e-6
NEG = -1e30
F32 = jnp.float32

kernel_name = 'nsa_hgrn2_hybrid_step'


def rms_norm(x, gain):
    xf = x.astype(F32)
    y = xf * lax.rsqrt(jnp.mean(xf * xf, axis=-1, keepdims=True) + EPS)
    return (y * gain.astype(F32)).astype(x.dtype)


def alibi_slopes():
    h = jnp.arange(1, N_ATTN_HEADS + 1, dtype=F32)
    return jnp.exp2(-8.0 * h / N_ATTN_HEADS).reshape(N_KV_HEADS, GROUP)


def split_points():
    sizes = (ATTN_WIDTH, 2 * KV_WIDTH, 2 * KV_WIDTH, 2 * KV_WIDTH, N_ATTN_HEADS * N_BRANCH,
             N_RNN_HEADS * RNN_DK, N_RNN_HEADS * RNN_DK, RNN_WIDTH, RNN_WIDTH)
    return [int(v) for v in np.cumsum(sizes)[:-1]]


def mix_projections(x, ln, w_in, q_gain, k_gain, lb):
    b, t, _ = x.shape
    z = rms_norm(x, ln) @ w_in
    q, kv_c, kv_s, kv_w, gates, rq, rf, ri, rg = jnp.split(z, split_points(), axis=-1)
    q = rms_norm(q.reshape(b, t, N_ATTN_HEADS, HEAD_DIM), q_gain)
    kv_c = kv_c.reshape(b, t, 2, N_KV_HEADS, HEAD_DIM)
    kv_s = kv_s.reshape(b, t, 2, N_KV_HEADS, HEAD_DIM)
    kv_w = kv_w.reshape(b, t, 2, N_KV_HEADS, HEAD_DIM)
    k_cmp, v_cmp = kv_c[:, :, 0], kv_c[:, :, 1]
    k_sel, v_sel = rms_norm(kv_s[:, :, 0], k_gain[1]), kv_s[:, :, 1]
    k_win, v_win = rms_norm(kv_w[:, :, 0], k_gain[2]), kv_w[:, :, 1]
    gates = jax.nn.sigmoid(gates.astype(F32)).reshape(b, t, N_ATTN_HEADS, N_BRANCH)
    rq = jax.nn.silu(rq.astype(F32)).reshape(b, t, N_RNN_HEADS, RNN_DK)
    f = (lb + (1.0 - lb) * jax.nn.sigmoid(rf.astype(F32))).reshape(b, t, N_RNN_HEADS, RNN_DK)
    rk = 1.0 - f
    g_log = jnp.log(f)
    rv = ri.astype(F32).reshape(b, t, N_RNN_HEADS, RNN_DV)
    return q, k_cmp, v_cmp, k_sel, v_sel, k_win, v_win, gates, rq, rk, rv, g_log, rg


def compress(rows, pe, w1, w2):
    b, l = rows.shape[:2]
    nc = l // CMP_BLOCK
    blk = rows[:, :nc * CMP_BLOCK].reshape(b, nc, CMP_BLOCK, N_KV_HEADS, HEAD_DIM) + pe[None, None, :, None, :]
    blk = blk.transpose(0, 1, 3, 2, 4).reshape(b, nc, N_KV_HEADS, CMP_BLOCK * HEAD_DIM)
    return jax.nn.silu(blk @ w1) @ w2


def nsa_memory(k_cmp, v_cmp, k_sel, v_sel, k_gain_cmp, pe, w1, w2):
    b, l = k_cmp.shape[:2]
    kc = rms_norm(compress(k_cmp, pe[0], w1[0], w2[0]), k_gain_cmp)
    vc = compress(v_cmp, pe[1], w1[1], w2[1])
    ns = -(-l // SEL_BLOCK)
    padlen = ns * SEL_BLOCK - l

    def blocks(x):
        return jnp.pad(x, ((0, 0), (0, padlen), (0, 0), (0, 0))).reshape(b, ns, SEL_BLOCK, N_KV_HEADS, HEAD_DIM)

    return kc, vc, blocks(k_sel), blocks(v_sel)


def cmp_sel_attend(q, q_pos, kc, vc, ksb, vsb, slopes):
    b, tq = q.shape[:2]
    nc, ns = kc.shape[1], ksb.shape[1]
    qg = q.reshape(b, tq, N_KV_HEADS, GROUP, HEAD_DIM).astype(F32)
    end = jnp.arange(nc, dtype=jnp.int32) * CMP_BLOCK + (CMP_BLOCK - 1)
    dist = (q_pos[:, None] - end[None, :]).astype(F32)
    valid = dist >= 0
    s = jnp.einsum('btgrd,bngd->bgrtn', qg, kc.astype(F32)) * SCALE - slopes[None, :, :, None, None] * dist
    s = jnp.where(valid, s, NEG)
    p = jax.nn.softmax(s, axis=-1) * valid
    o_cmp = jnp.einsum('bgrtn,bngd->btgrd', p, vc.astype(F32))
    imp = jnp.pad(p.sum(axis=2), ((0, 0), (0, 0), (0, 0), (0, ns - nc)))
    blk = jnp.arange(ns, dtype=jnp.int32)
    cur = q_pos // SEL_BLOCK
    force = (blk[None, :] == 0) | (blk[None, :] == cur[:, None])
    allowed = blk[None, :] <= cur[:, None]
    score = jnp.where(force, GROUP + 1.0, imp)
    score = jnp.where(allowed, score, -1.0)
    top_s, idx = lax.top_k(score, min(SEL_TOPK, ns))
    blk_ok = top_s >= 0
    gather = jax.vmap(jax.vmap(lambda bl, ix: bl[ix]))
    ks = gather(ksb.transpose(0, 3, 1, 2, 4), idx)
    vs = gather(vsb.transpose(0, 3, 1, 2, 4), idx)
    tok = idx[..., None] * SEL_BLOCK + jnp.arange(SEL_BLOCK, dtype=jnp.int32)
    dist_s = (q_pos[None, None, :, None, None] - tok).astype(F32)
    ok = blk_ok[..., None] & (dist_s >= 0)
    ss = jnp.einsum('btgrd,bgtksd->bgrtks', qg, ks.astype(F32)) * SCALE - slopes[None, :, :, None, None, None] * dist_s[:, :, None]
    ss = jnp.where(ok[:, :, None], ss, NEG)
    ps = jax.nn.softmax(ss.reshape(ss.shape[:4] + (-1,)), axis=-1).reshape(ss.shape)
    o_sel = jnp.einsum('bgrtks,bgtksd->btgrd', ps, vs.astype(F32))
    return (o_cmp.reshape(b, tq, N_ATTN_HEADS, HEAD_DIM), o_sel.reshape(b, tq, N_ATTN_HEADS, HEAD_DIM))


def nsa_prompt_cmp_sel(q, mem, slopes):
    b, t = q.shape[:2]
    nb = t // NSA_Q_BLOCK
    qb = q.reshape(b, nb, NSA_Q_BLOCK, N_ATTN_HEADS, HEAD_DIM).transpose(1, 0, 2, 3, 4)
    starts = jnp.arange(nb, dtype=jnp.int32) * NSA_Q_BLOCK
    kc, vc, ksb, vsb = mem

    def one(args):
        qblk, st = args
        return cmp_sel_attend(qblk, st + jnp.arange(NSA_Q_BLOCK, dtype=jnp.int32), kc, vc, ksb, vsb, slopes)

    o_c, o_s = lax.map(one, (qb, starts))
    back = lambda o: o.transpose(1, 0, 2, 3, 4).reshape(b, t, N_ATTN_HEADS, HEAD_DIM)
    return back(o_c), back(o_s)


def window_banded(q, k, v, slopes):
    b, t = q.shape[:2]
    qbl = WIN_Q_BLOCK
    nb, nprev = t // qbl, WINDOW // qbl
    pad = nprev * qbl

    def band(x):
        xp = jnp.pad(x, ((0, 0), (pad, 0), (0, 0), (0, 0))).reshape(b, nb + nprev, qbl, N_KV_HEADS, HEAD_DIM)
        return jnp.concatenate([xp[:, j:j + nb] for j in range(nprev + 1)], axis=2)

    kb, vb = band(k), band(v)
    qg = q.reshape(b, nb, qbl, N_KV_HEADS, GROUP, HEAD_DIM).astype(F32)
    start = jnp.arange(nb, dtype=jnp.int32)[:, None] * qbl
    q_pos = start + jnp.arange(qbl, dtype=jnp.int32)
    k_pos = start - pad + jnp.arange((nprev + 1) * qbl, dtype=jnp.int32)
    dist = (q_pos[:, :, None] - k_pos[:, None, :]).astype(F32)
    ok = (dist >= 0) & (dist < WINDOW) & (k_pos[:, None, :] >= 0)
    s = jnp.einsum('bnqgrd,bnkgd->bngrqk', qg, kb.astype(F32)) * SCALE - slopes[None, None, :, :, None, None] * dist[None, :, None, None]
    s = jnp.where(ok[None, :, None, None], s, NEG)
    p = jax.nn.softmax(s, axis=-1)
    o = jnp.einsum('bngrqk,bnkgd->bnqgrd', p, vb.astype(F32))
    return o.reshape(b, t, N_ATTN_HEADS, HEAD_DIM)


def window_dense(q, q_pos, k, v, k_pos, slopes):
    b, tq = q.shape[:2]
    qg = q.reshape(b, tq, N_KV_HEADS, GROUP, HEAD_DIM).astype(F32)
    dist = (q_pos[:, None] - k_pos[None, :]).astype(F32)
    ok = (dist >= 0) & (dist < WINDOW)
    s = jnp.einsum('btgrd,bkgd->bgrtk', qg, k.astype(F32)) * SCALE - slopes[None, :, :, None, None] * dist
    s = jnp.where(ok, s, NEG)
    p = jax.nn.softmax(s, axis=-1)
    o = jnp.einsum('bgrtk,bkgd->btgrd', p, v.astype(F32))
    return o.reshape(b, tq, N_ATTN_HEADS, HEAD_DIM)


def hgrn2_chunked(q, k, v, g_log, s0):
    b, t, nh = q.shape[:3]
    c = math.gcd(t, HGRN_CHUNK)
    n = t // c

    def chunks(x):
        return x.astype(F32).reshape(b, n, c, nh, x.shape[-1]).transpose(1, 0, 3, 2, 4)

    tri = jnp.tril(jnp.ones((c, c), dtype=bool))

    def step(S, inp):
        qc, kc, vc, gc = inp
        cum = jnp.cumsum(gc, axis=2)
        o_inter = jnp.einsum('bhtd,bhde->bhte', qc * jnp.exp(cum), S)
        decay = jnp.exp(jnp.where(tri[:, :, None], cum[:, :, :, None, :] - cum[:, :, None, :, :], -jnp.inf))
        a = jnp.einsum('bhtd,bhsd,bhtsd->bhts', qc, kc, decay)
        o = o_inter + jnp.einsum('bhts,bhse->bhte', a, vc)
        last = cum[:, :, -1:]
        S = jnp.exp(last[:, :, 0])[..., None] * S + jnp.einsum('bhsd,bhse->bhde', kc * jnp.exp(last - cum), vc)
        return S, o

    S, o = lax.scan(step, s0.astype(F32), (chunks(q), chunks(k), chunks(v), chunks(g_log)))
    return o.transpose(1, 0, 3, 2, 4).reshape(b, t, nh, v.shape[-1]), S


def finish(x, o_cmp, o_sel, o_win, gates, o_rnn, rg, attn_gain, rnn_gain, w_out, ln_mlp, w_up, w_down):
    b, t, _ = x.shape
    o_a = gates[..., 0:1] * o_cmp + gates[..., 1:2] * o_sel + gates[..., 2:3] * o_win
    o_a = rms_norm(o_a, attn_gain.reshape(N_ATTN_HEADS, HEAD_DIM)).reshape(b, t, ATTN_WIDTH)
    o_r = rms_norm(o_rnn, rnn_gain.reshape(N_RNN_HEADS, RNN_DV)).reshape(b, t, RNN_WIDTH) * jax.nn.silu(rg.astype(F32))
    h = x + jnp.concatenate([o_a, o_r], axis=-1).astype(x.dtype) @ w_out
    u = jax.nn.relu(rms_norm(h, ln_mlp) @ w_up)
    return h + (u * u) @ w_down


def setup_inputs(seed: int = 0) -> dict:
    key = jax.random.key(seed)
    k = jax.random.split(key, 20)
    n_pages = PAST_LEN // PAGE_SIZE
    n_used = DEC_BATCH * n_pages
    n_pool = n_used + (n_used + 3) // 4
    w_buf = min(WINDOW, PAST_LEN)

    def normal(kk, shape, scale):
        return jax.random.normal(kk, shape, F32) * scale

    def gain(kk, shape):
        return 1.0 + normal(kk, shape, 0.05)

    page_table = jax.random.permutation(k[5], n_pool)[:n_used].reshape(DEC_BATCH, n_pages).astype(jnp.int32)
    return {
        'x_prompt': normal(k[0], (BATCH, SEQ, D_MODEL), 1.0),
        'x_sample': normal(k[1], (DEC_BATCH, DEC_SEQ, D_MODEL), 1.0),
        'cache_kv': normal(k[2], (DEPTH, n_pool, PAGE_SIZE, 4, N_KV_HEADS, HEAD_DIM), 1.0),
        'cache_win': normal(k[3], (DEPTH, DEC_BATCH, w_buf, 2, N_KV_HEADS, HEAD_DIM), 1.0),
        'state_rnn': normal(k[4], (DEPTH, DEC_BATCH, N_RNN_HEADS, RNN_DK, RNN_DV), 0.3),
        'page_table': page_table,
        'ln_mix': gain(k[6], (DEPTH, D_MODEL)),
        'w_in': normal(k[7], (DEPTH, D_MODEL, IN_WIDTH), D_MODEL ** -0.5),
        'q_norm': gain(k[8], (DEPTH, HEAD_DIM)),
        'k_norm': gain(k[9], (DEPTH, N_BRANCH, HEAD_DIM)),
        'cmp_pe': normal(k[10], (DEPTH, 2, CMP_BLOCK, HEAD_DIM), 0.1),
        'cmp_w1': normal(k[11], (DEPTH, 2, CMP_BLOCK * HEAD_DIM, CMP_HIDDEN), (CMP_BLOCK * HEAD_DIM) ** -0.5),
        'cmp_w2': normal(k[12], (DEPTH, 2, CMP_HIDDEN, HEAD_DIM), CMP_HIDDEN ** -0.5),
        'attn_out_norm': gain(k[13], (DEPTH, ATTN_WIDTH)),
        'rnn_lb_logits': normal(k[14], (DEPTH + 1, N_RNN_HEADS * RNN_DK), 0.5),
        'rnn_out_norm': gain(k[15], (DEPTH, RNN_WIDTH)),
        'w_out': normal(k[16], (DEPTH, MIX_WIDTH, D_MODEL), MIX_WIDTH ** -0.5),
        'ln_mlp': gain(k[17], (DEPTH, D_MODEL)),
        'w_up': normal(k[18], (DEPTH, D_MODEL, D_FF), D_MODEL ** -0.5),
        'w_down': normal(k[19], (DEPTH, D_FF, D_MODEL), D_FF ** -0.5),
    }


def reference(x_prompt, x_sample, cache_kv, cache_win, state_rnn, page_table, ln_mix, w_in, q_norm, k_norm,
              cmp_pe, cmp_w1, cmp_w2, attn_out_norm, rnn_lb_logits, rnn_out_norm, w_out, ln_mlp, w_up, w_down):
    slopes = alibi_slopes()
    lb_all = jnp.cumsum(jax.nn.softmax(rnn_lb_logits.astype(F32), axis=0), axis=0)
    dec_b, dec_t = x_sample.shape[:2]
    past_len = page_table.shape[1] * PAGE_SIZE
    w_buf = cache_win.shape[2]
    xp, xs = x_prompt, x_sample
    kv_p, kv_s, win_p, win_s, rnn_p, rnn_s = [], [], [], [], [], []
    for l in range(DEPTH):
        lb = lb_all[l]
        b, t = xp.shape[:2]
        q, kc, vc, ksl, vsl, kw, vw, gates, rq, rk, rv, glog, rg = mix_projections(xp, ln_mix[l], w_in[l], q_norm[l], k_norm[l], lb)
        mem = nsa_memory(kc, vc, ksl, vsl, k_norm[l, 0], cmp_pe[l], cmp_w1[l], cmp_w2[l])
        o_c, o_s = nsa_prompt_cmp_sel(q, mem, slopes)
        o_w = window_banded(q, kw, vw, slopes)
        o_r, s_p = hgrn2_chunked(rq, rk, rv, glog, jnp.zeros((b, N_RNN_HEADS, RNN_DK, RNN_DV), F32))
        kv_p.append(jnp.stack([kc, vc, ksl, vsl], axis=2))
        win_p.append(jnp.stack([kw, vw], axis=2)[:, t - min(WINDOW, t):])
        rnn_p.append(s_p.astype(state_rnn.dtype))
        xp = finish(xp, o_c, o_s, o_w, gates, o_r, rg, attn_out_norm[l], rnn_out_norm[l], w_out[l], ln_mlp[l], w_up[l], w_down[l])
        q, kc, vc, ksl, vsl, kw, vw, gates, rq, rk, rv, glog, rg = mix_projections(xs, ln_mix[l], w_in[l], q_norm[l], k_norm[l], lb)
        new_kv = jnp.stack([kc, vc, ksl, vsl], axis=2)
        past = cache_kv[l][page_table].reshape(dec_b, past_len, 4, N_KV_HEADS, HEAD_DIM)
        all_kv = jnp.concatenate([past, new_kv.astype(past.dtype)], axis=1)
        mem = nsa_memory(all_kv[:, :, 0], all_kv[:, :, 1], all_kv[:, :, 2], all_kv[:, :, 3],
                         k_norm[l, 0], cmp_pe[l], cmp_w1[l], cmp_w2[l])
        q_pos = past_len + jnp.arange(dec_t, dtype=jnp.int32)
        o_c, o_s = cmp_sel_attend(q, q_pos, mem[0], mem[1], mem[2], mem[3], slopes)
        win_all = jnp.concatenate([cache_win[l], jnp.stack([kw, vw], axis=2).astype(cache_win.dtype)], axis=1)
        k_pos = past_len - w_buf + jnp.arange(w_buf + dec_t, dtype=jnp.int32)
        o_w = window_dense(q, q_pos, win_all[:, :, 0], win_all[:, :, 1], k_pos, slopes)
        o_r, s_s = hgrn2_chunked(rq, rk, rv, glog, state_rnn[l])
        kv_s.append(new_kv)
        win_s.append(win_all[:, dec_t:])
        rnn_s.append(s_s.astype(state_rnn.dtype))
        xs = finish(xs, o_c, o_s, o_w, gates, o_r, rg, attn_out_norm[l], rnn_out_norm[l], w_out[l], ln_mlp[l], w_up[l], w_down[l])
    return (xp, xs, jnp.stack(kv_p), jnp.stack(kv_s), jnp.stack(win_p), jnp.stack(win_s), jnp.stack(rnn_p), jnp.stack(rnn_s))
```

```cpp
#include <hip/hip_runtime.h>
#include <hip/hip_cooperative_groups.h>
#include <cstdio>
#include <cstdint>
namespace cg = cooperative_groups;

#ifndef REP_P2
#define REP_P2 1
#endif
#ifndef REP_P3
#define REP_P3 1
#endif
#ifndef MK_N_LAUNCHES
#define MK_N_LAUNCHES 1
#endif

#define LAS __attribute__((address_space(3)))
typedef unsigned short bf16;
typedef short bf16x8 __attribute__((ext_vector_type(8)));
typedef short bf16x4 __attribute__((ext_vector_type(4)));
typedef float f32x4 __attribute__((ext_vector_type(4)));
typedef float f32x2 __attribute__((ext_vector_type(2)));
typedef unsigned u32x4 __attribute__((ext_vector_type(4)));
typedef unsigned u32x2 __attribute__((ext_vector_type(2)));
typedef __bf16 bf16x2_t __attribute__((ext_vector_type(2)));

constexpr int DM = 1024, BATCH = 4, SEQ = 4096, DECB = 128, DECT = 8, PAST = 2048, PAGE = 128;
constexpr int NPAGES = PAST / PAGE;
constexpr int MP = BATCH * SEQ;
constexpr int MS = DECB * DECT;
constexpr int MT = MP + MS;
constexpr int INW = 3352, INP = 3584;
constexpr int DFF = 4096;
constexpr float EPS = 1e-6f;

constexpr size_t O_YP = 0, O_YS = (size_t)MP * DM, O_KVP = O_YS + (size_t)MS * DM, O_KVS = O_KVP + (size_t)MP * 512,
                 O_WINP = O_KVS + (size_t)MS * 512, O_WINS = O_WINP + (size_t)BATCH * 512 * 256, O_RNNP = O_WINS + (size_t)DECB * 512 * 256,
                 O_RNNS = O_RNNP + (size_t)BATCH * 8 * 4096, O_END = O_RNNS + (size_t)DECB * 8 * 4096;

constexpr size_t MiB = 1u << 20;
constexpr size_t WS_CTL = 0, CTL_BYTES = 1 * MiB;
constexpr size_t CTL_SSQ = 512 * 1024;
constexpr size_t WS_WIN = 1 * MiB;
constexpr size_t WS_WO = WS_WIN + 7 * MiB;
constexpr size_t WS_WU = WS_WO + 2 * MiB;
constexpr size_t WS_WD = WS_WU + 8 * MiB;
constexpr size_t WS_W1 = WS_WD + 8 * MiB;
constexpr size_t WS_W2 = WS_W1 + 2 * MiB;
constexpr size_t WS_LB = WS_W2 + 64 * 1024;
constexpr size_t WS_XN = 32 * MiB;
constexpr size_t WS_Q = 68 * MiB;
constexpr size_t WS_KC = 86 * MiB;
constexpr size_t WS_KS = 95 * MiB;
constexpr size_t WS_KW = 104 * MiB;
constexpr size_t WS_RQ = 113 * MiB, WS_RK = 131 * MiB, WS_RV = 149 * MiB, WS_RG = 167 * MiB;   static_assert(WS_RV - WS_RK == WS_RK - WS_RQ && WS_RG - WS_RV == WS_RK - WS_RQ, "equal spacing");
constexpr size_t WS_GL = 185 * MiB;
constexpr size_t WS_GATES = 220 * MiB;
constexpr size_t WS_OWIN = 224 * MiB;
constexpr size_t WS_OA = 242 * MiB;
constexpr size_t WS_U = 280 * MiB;
constexpr size_t WS_KCMP = 420 * MiB;
constexpr size_t WS_VCMP = 424 * MiB;
constexpr size_t WS_OLOC = 428 * MiB;
constexpr size_t WS_QH = 462 * MiB;
constexpr size_t WS_TSC = 480 * MiB;
constexpr size_t WS_DSC = 485 * MiB;
constexpr size_t WS_END1 = 486 * MiB;

constexpr int RING_BYTES = 131072;
constexpr int LDS_BYTES = 147456;
constexpr int LDS_CTLW = LDS_BYTES - 64;

__device__ __forceinline__ unsigned cvtpk(float lo, float hi) { f32x2 v = {lo, hi}; bf16x2_t b = __builtin_convertvector(v, bf16x2_t); return __builtin_bit_cast(unsigned, b); }
__device__ __forceinline__ float bf2f(unsigned short b) { return __builtin_bit_cast(float, ((unsigned)b) << 16); }
__device__ __forceinline__ float wave_sum(float v) {
#pragma unroll
    for (int o = 1; o < 64; o <<= 1) v += __shfl_xor(v, o);
    return v;
}
__device__ __forceinline__ float sigmoidf_(float x) { return 1.0f / (1.0f + __expf(-x)); }
__device__ __forceinline__ float siluf_(float x) { return x / (1.0f + __expf(-x)); }
#define LDS_WAIT() asm volatile("s_waitcnt lgkmcnt(0)" ::: "memory")

namespace pg8 {
constexpr int BM = 256, BK = 64, HALF = 128, HTB = HALF * BK * 2, STAGE_BYTES = 8 * HTB, NXCD = 8, WGM = 8;
__host__ __device__ __forceinline__ int lds_byte(int r, int c) { const int st = (r >> 4) * 2 + (c >> 5), rr = r & 15, cc = c & 31, ob = rr * 64 + cc * 2; return st * 1024 + (ob ^ (((ob >> 9) & 1) << 5)); }
__host__ __device__ __forceinline__ void stage_rc(int b, int& R, int& C) { const int st = b / 1024, sb = b % 1024, swz = sb ^ (((sb >> 9) & 1) << 5); R = (st >> 1) * 16 + swz / 64; C = (st & 1) * 32 + (swz % 64) / 2; }
struct Unit { int pm, pn; };
struct Gemm { const bf16* A; const bf16* Bt; int M, N, K; };
struct StaticOrder {
    int nM, nN, nwg, G, c;
    __host__ __device__ void init(int M, int N, int G_, int c_) { nM = M / BM; nN = N / BM; nwg = nM * nN; G = G_; c = c_; }
    __host__ __device__ bool next(int i, Unit& u) const {
        const long L = (long)i * G + c; if (L >= nwg) return false;
        int wgid = (int)L; { const int q = nwg / NXCD, r = nwg % NXCD, xcd = wgid % NXCD, off = wgid / NXCD; wgid = (xcd < r ? xcd * (q + 1) : r * (q + 1) + (xcd - r) * q) + off; }
        const int nig = WGM * nN, gid = wgid / nig, fm = gid * WGM, gsz = (nM - fm) < WGM ? (nM - fm) : WGM;
        u.pm = fm + ((wgid % nig) % gsz); u.pn = (wgid % nig) / gsz; return true;
    }
};
template <class Epi, bool ALIGN_EPI = true>
__device__ __forceinline__ void gemm_phase(LAS unsigned char* lds, const Gemm g, const StaticOrder& S, const Epi& E) {
    const int tid = threadIdx.x, wid = __builtin_amdgcn_readfirstlane(tid >> 6), lane = tid & 63, wr = wid >> 2, wc = wid & 3, fr = lane & 15, fq = lane >> 4;
    const int K = g.K, nt = K / BK;
    unsigned voffA[2], voffB[2];
#pragma unroll
    for (int i = 0; i < 2; ++i) { int R, C; stage_rc(tid * 16 + i * 8192, R, C); voffA[i] = (unsigned)(R * K + C) * 2u; voffB[i] = voffA[i]; }
    const size_t kstep = (size_t)(BK * 2);
    const size_t hstep = (size_t)HALF * K * 2;
    const size_t tstep = 2 * hstep;
    const unsigned ldsw = (unsigned)wid * 1024u;
    const int aoff = lds_byte(wr * 64 + fr, fq * 8), boff = lds_byte(wc * 32 + fr, fq * 8);
#define PG8_SA(b, h) (((b) * 2 + (h)) * HTB)
#define PG8_SB(b, h) ((4 + (b) * 2 + (h)) * HTB)
#define PG8_STAGE(bufoff, gbase, voff) do { _Pragma("unroll") for (int _i = 0; _i < 2; ++_i) \
        __builtin_amdgcn_global_load_lds((const unsigned*)((const char*)(gbase) + (voff)[_i]), (LAS unsigned*)(lds + (bufoff) + ldsw + _i * 8192), 16, 0, 0); } while (0)
#define PG8_LDA(dst, b, h) do { _Pragma("unroll") for (int m = 0; m < 4; ++m) _Pragma("unroll") for (int k = 0; k < 2; ++k) dst[m][k] = *(const LAS bf16x8*)(lds + PG8_SA(b, h) + aoff + m * 2048 + k * 1024); } while (0)
#define PG8_LDB(dst, b, h) do { _Pragma("unroll") for (int n = 0; n < 2; ++n) _Pragma("unroll") for (int k = 0; k < 2; ++k) dst[n][k] = *(const LAS bf16x8*)(lds + PG8_SB(b, h) + boff + n * 2048 + k * 1024); } while (0)
#define PG8_MMA(ai, bj, At, Bt) do { __builtin_amdgcn_s_setprio(1); _Pragma("unroll") for (int m = 0; m < 4; ++m) _Pragma("unroll") for (int n = 0; n < 2; ++n) _Pragma("unroll") for (int k = 0; k < 2; ++k) \
        acc[ai][bj][m][n] = __builtin_amdgcn_mfma_f32_16x16x32_bf16(Bt[n][k], At[m][k], acc[ai][bj][m][n], 0, 0, 0); __builtin_amdgcn_s_setprio(0); } while (0)
#define PG8_WAIT_V(n) asm volatile("s_waitcnt vmcnt(" #n ")" ::: "memory")
#define PG8_WAIT_L(n) asm volatile("s_waitcnt lgkmcnt(" #n ")" ::: "memory")
#define PG8_BAR __builtin_amdgcn_s_barrier()
#define PG8_SCHED __builtin_amdgcn_sched_barrier(0)
    Unit cur, nxt; int ui = 0;
    if (!S.next(0, cur)) return;
    f32x4 acc[2][2][4][2];
#pragma unroll
    for (int a = 0; a < 2; ++a)
#pragma unroll
        for (int b = 0; b < 2; ++b)
#pragma unroll
            for (int m = 0; m < 4; ++m)
#pragma unroll
                for (int n = 0; n < 2; ++n) acc[a][b][m][n] = (f32x4){0.f, 0.f, 0.f, 0.f};
    bf16x8 At[4][2], B0[2][2], B1[2][2];
    const char* cA = (const char*)g.A + (size_t)cur.pm * tstep; const char* cB = (const char*)g.Bt + (size_t)cur.pn * tstep;
    PG8_STAGE(PG8_SB(0, 0), cB, voffB); PG8_STAGE(PG8_SB(0, 1), cB + hstep, voffB); PG8_STAGE(PG8_SA(0, 0), cA, voffA); PG8_STAGE(PG8_SA(0, 1), cA + hstep, voffA);
    if (wr == 1) PG8_BAR;
    PG8_WAIT_V(2); PG8_BAR;
    PG8_STAGE(PG8_SB(1, 0), cB + kstep, voffB); PG8_STAGE(PG8_SA(1, 0), cA + kstep, voffA); PG8_STAGE(PG8_SB(1, 1), cB + hstep + kstep, voffB);
    PG8_WAIT_V(6); PG8_BAR;
    for (;;) {
        const bool has_next = S.next(ui + 1, nxt);
        const char* nA = has_next ? (const char*)g.A + (size_t)nxt.pm * tstep : cA; const char* nB = has_next ? (const char*)g.Bt + (size_t)nxt.pn * tstep : cB;
        for (int t = 0; t < nt; t += 2) {
            const bool last = (t == nt - 2);
            const char* a1 = cA + (size_t)(t + 1) * kstep;
            const char* a2 = last ? nA : cA + (size_t)(t + 2) * kstep; const char* b2 = last ? nB : cB + (size_t)(t + 2) * kstep;
            const char* a3 = a2 + kstep; const char* b3 = b2 + kstep;
            PG8_LDB(B0, 0, 0); PG8_LDB(B1, 0, 1); PG8_SCHED; PG8_LDA(At, 0, 0); PG8_STAGE(PG8_SA(1, 1), a1 + hstep, voffA);
            PG8_WAIT_V(8); PG8_WAIT_L(0); PG8_BAR; PG8_MMA(0, 0, At, B0); PG8_MMA(0, 1, At, B1); PG8_BAR; PG8_SCHED;
            PG8_LDA(At, 0, 1); PG8_STAGE(PG8_SB(0, 0), b2, voffB); PG8_STAGE(PG8_SB(0, 1), b2 + hstep, voffB); PG8_STAGE(PG8_SA(0, 0), a2, voffA);
            PG8_WAIT_V(8); PG8_WAIT_L(0); PG8_BAR; PG8_MMA(1, 0, At, B0); PG8_MMA(1, 1, At, B1); PG8_BAR; PG8_SCHED;
            PG8_LDB(B0, 1, 0); PG8_LDB(B1, 1, 1); PG8_SCHED; PG8_LDA(At, 1, 0); PG8_STAGE(PG8_SA(0, 1), a2 + hstep, voffA);
            PG8_WAIT_V(8); PG8_WAIT_L(0); PG8_BAR; PG8_MMA(0, 0, At, B0); PG8_MMA(0, 1, At, B1); PG8_BAR; PG8_SCHED;
            PG8_LDA(At, 1, 1); PG8_STAGE(PG8_SB(1, 0), b3, voffB); PG8_STAGE(PG8_SB(1, 1), b3 + hstep, voffB); PG8_STAGE(PG8_SA(1, 0), a3, voffA);
            PG8_WAIT_V(8); PG8_WAIT_L(0); PG8_BAR; PG8_MMA(1, 0, At, B0); PG8_MMA(1, 1, At, B1); PG8_BAR; PG8_SCHED;
        }
        if constexpr (ALIGN_EPI) { if (wr == 0) PG8_BAR; }
        E(acc, cur, wr, wc, fr, fq);
        if (!has_next) break;
#pragma unroll
        for (int a = 0; a < 2; ++a)
#pragma unroll
            for (int b = 0; b < 2; ++b)
#pragma unroll
                for (int m = 0; m < 4; ++m)
#pragma unroll
                    for (int n = 0; n < 2; ++n) acc[a][b][m][n] = (f32x4){0.f, 0.f, 0.f, 0.f};
        cur = nxt; cA = nA; cB = nB; ++ui;
        if constexpr (ALIGN_EPI) { if (wr == 1) PG8_BAR; }
    }
    PG8_WAIT_V(0);
    if constexpr (!ALIGN_EPI) { if (wr == 0) PG8_BAR; }
    PG8_BAR;
#undef PG8_SA
#undef PG8_SB
#undef PG8_STAGE
#undef PG8_LDA
#undef PG8_LDB
#undef PG8_MMA
#undef PG8_WAIT_V
#undef PG8_WAIT_L
#undef PG8_BAR
#undef PG8_SCHED
}
}

#define XB_TMO      128
#define XB_XCNT(j)  (256  + 64 * (j))
#define XB_XSUB(j)  (1280 + 64 * (j))
#define XB_XGEN(j)  (2304 + 64 * (j))
#define XB_TOP      3328
#define XB_TOPGEN   3392
#define XCD_BAR_WORDS 3456
#define XB_SPIN_CAP (1u << 18)
constexpr size_t CTL_BAR = 64 * 1024;
__device__ __forceinline__ unsigned xb_ld(unsigned* p)              { return __hip_atomic_load(p, __ATOMIC_RELAXED, __HIP_MEMORY_SCOPE_AGENT); }
__device__ __forceinline__ unsigned xb_add(unsigned* p, unsigned v) { return __hip_atomic_fetch_add(p, v, __ATOMIC_RELAXED, __HIP_MEMORY_SCOPE_AGENT); }
__device__ __forceinline__ unsigned xb_xcc_id() { return (unsigned)__builtin_amdgcn_s_getreg((3 << 11) | 20) & 0xFu; }
#define XB_SPIN(cond, bar) do { unsigned _sp = 0; while (cond) { __builtin_amdgcn_s_sleep(1); \
    if ((++_sp & 255u) == 0u) { if (xb_ld(&(bar)[XB_TMO])) break; if (_sp > XB_SPIN_CAP) { atomicAdd(&(bar)[XB_TMO], 1u); break; } } } } while (0)
struct XcdBarrier { unsigned* bar; unsigned x; volatile LAS unsigned* st; };
__device__ __forceinline__ XcdBarrier xcd_barrier_post(unsigned* bar, volatile LAS unsigned* st) {
    XcdBarrier b; b.bar = bar; b.x = xb_xcc_id(); b.st = st;
    if (threadIdx.x == 0) (void)xb_add(&bar[XB_XCNT(b.x)], 1u);
    return b;
}
__device__ __forceinline__ void xcd_barrier_complete(unsigned* bar, unsigned x, unsigned& nloc, unsigned& nx) {
    const unsigned G = gridDim.x * gridDim.y * gridDim.z;
    unsigned sum, cnt, mine, sp = 0u;
    for (;;) {
        sum = 0u; cnt = 0u; mine = 0u;
#pragma unroll
        for (unsigned j = 0; j < 16; ++j) { const unsigned c = xb_ld(&bar[XB_XCNT(j)]); sum += c; cnt += (c > 0u) ? 1u : 0u; mine = (j == x) ? c : mine; }
        if (sum == G) break;
        __builtin_amdgcn_s_sleep(1);
        if ((++sp & 255u) == 0u) { if (xb_ld(&bar[XB_TMO])) break; if (sp > XB_SPIN_CAP) { atomicAdd(&bar[XB_TMO], 1u); break; } }
    }
    nloc = mine > 0u ? mine : 1u; nx = cnt > 0u ? cnt : 1u;
}
__device__ __forceinline__ void xcd_barrier(const XcdBarrier& b) {
    asm volatile("s_waitcnt vmcnt(0)" ::: "memory");
    __syncthreads();
    if (threadIdx.x == 0) {
        unsigned* bar = b.bar;
        __builtin_amdgcn_s_waitcnt(0);
        unsigned nloc = b.st[0], nx = b.st[1];
        if (nloc == 0u) { xcd_barrier_complete(bar, b.x, nloc, nx); b.st[0] = nloc; b.st[1] = nx; }
        const unsigned old = xb_add(&bar[XB_XSUB(b.x)], 1u);
        const unsigned gen = old / nloc;
        if (old + 1u == (gen + 1u) * nloc) {
            __builtin_amdgcn_fence(__ATOMIC_RELEASE, "agent");
            asm volatile("s_waitcnt vmcnt(0)" ::: "memory");
            const unsigned og = xb_add(&bar[XB_TOP], 1u);
            const unsigned tg = og / nx;
            if (og + 1u == (tg + 1u) * nx) xb_add(&bar[XB_TOPGEN], 1u);
            else XB_SPIN(xb_ld(&bar[XB_TOPGEN]) == tg, bar);
            __builtin_amdgcn_fence(__ATOMIC_ACQUIRE, "agent");
            xb_add(&bar[XB_XGEN(b.x)], 1u);
            asm volatile("s_waitcnt vmcnt(0)" ::: "memory");
        } else {
            XB_SPIN(xb_ld(&bar[XB_XGEN(b.x)]) == gen, bar);
            __builtin_amdgcn_fence(__ATOMIC_ACQUIRE, "agent");
            asm volatile("s_waitcnt vmcnt(0)" ::: "memory");
        }
    }
    __syncthreads();
}

struct Args {
    const float* in[20];
    float* out;
    unsigned char* ws;
    int ph_lo, ph_hi;
};

__host__ __device__ __forceinline__ int win_logical(int c) { return (c < 1280) ? c : (c < 1304 ? 3328 + (c - 1280) : c - 24); }
__host__ __device__ __forceinline__ int tile_perm_row(int L) { const int Lc = L & 255; return (L & ~255) + 128 * ((Lc >> 5) & 1) + 32 * (Lc >> 6) + (Lc & 31); }

template <int MAPKIND>
__device__ __forceinline__ void p0_transpose_item(const float* W, int K, int N, bf16* WT, LAS float* scr, int item, int lane) {
    const int nblk = (N + 31) / 32, kb = item / nblk, nb = item % nblk, k0 = 64 * kb, n0 = 32 * nb;
    const int colr = n0 + (lane & 31);
#pragma unroll 8
    for (int i = 0; i < 32; ++i) { const int kk = 2 * i + (lane >> 5); scr[kk * 33 + (lane & 31)] = (colr < N) ? W[(size_t)(k0 + kk) * N + colr] : 0.f; }
    LDS_WAIT(); asm volatile("" ::: "memory");
    const int c = lane & 7;
#pragma unroll
    for (int j = 0; j < 4; ++j) { const int n = (lane >> 3) + 8 * j; const LAS float* s = scr + (8 * c) * 33 + n; const int col = n0 + n;
        if (col < N) {
            u32x4 o; o.x = cvtpk(s[0 * 33], s[1 * 33]); o.y = cvtpk(s[2 * 33], s[3 * 33]); o.z = cvtpk(s[4 * 33], s[5 * 33]); o.w = cvtpk(s[6 * 33], s[7 * 33]);
            const int row = (MAPKIND == 1) ? tile_perm_row(win_logical(col)) : (MAPKIND == 2 ? tile_perm_row(col) : col);
            *(u32x4*)(WT + (size_t)row * K + k0 + 8 * c) = o; } }
    LDS_WAIT(); asm volatile("" ::: "memory");
}

__device__ __forceinline__ void rms_row_to_bf16(const float* xrow, const float* gain, bf16* orow, int lane) {
    const f32x4* xr = (const f32x4*)xrow + lane; const f32x4* gr = (const f32x4*)gain + lane;
    f32x4 v[4]; float s = 0.f;
#pragma unroll
    for (int j = 0; j < 4; ++j) { v[j] = xr[64 * j]; s += (v[j].x * v[j].x + v[j].y * v[j].y) + (v[j].z * v[j].z + v[j].w * v[j].w); }
    const float rs = 1.0f / sqrtf(wave_sum(s) * (1.f / DM) + EPS);
    u32x2* o8 = (u32x2*)orow + lane;
#pragma unroll
    for (int j = 0; j < 4; ++j) { const f32x4 g = gr[64 * j]; u32x2 w; w.x = cvtpk(v[j].x * rs * g.x, v[j].y * rs * g.y); w.y = cvtpk(v[j].z * rs * g.z, v[j].w * rs * g.w); o8[64 * j] = w; }
}

struct EpiIn {
    float* out; unsigned char* ws;
    const float *q_gain, *k_gain, *pe;
    __device__ __forceinline__ void operator()(const f32x4 (&acc)[2][2][4][2], const pg8::Unit& u, int wr, int wc, int fr, int fq) const {
        const int pn = u.pn;
        bf16* const Q = (bf16*)(ws + WS_Q); bf16* const KC = (bf16*)(ws + WS_KC); bf16* const KS = (bf16*)(ws + WS_KS); bf16* const KW = (bf16*)(ws + WS_KW);
        float* const GL = (float*)(ws + WS_GL); float* const GATES = (float*)(ws + WS_GATES); const float* const lb = (const float*)(ws + WS_LB);
        const int rowb = u.pm * 256 + wr * 64 + fr;
#define EPI_ROWS _Pragma("unroll") for (int ai = 0; ai < 2; ++ai) _Pragma("unroll") for (int m = 0; m < 4; ++m)
#define EPI_COLS _Pragma("unroll") for (int bj = 0; bj < 2; ++bj) _Pragma("unroll") for (int n = 0; n < 2; ++n)
        if (pn < 2) {
            f32x4 g[2][2];
            EPI_COLS g[bj][n] = *(const f32x4*)(q_gain + 32 * bj + 16 * n + 4 * fq);
            EPI_ROWS { const int row = rowb + 128 * ai + 16 * m; float ss = 0.f;
                EPI_COLS { const f32x4 v = acc[ai][bj][m][n]; ss += (v.x * v.x + v.y * v.y) + (v.z * v.z + v.w * v.w); }
                ss += __shfl_xor(ss, 16); ss += __shfl_xor(ss, 32);
                const float rs = 1.0f / sqrtf(ss * (1.f / 64.f) + EPS);
                bf16* dst = Q + (size_t)row * 512 + pn * 256 + 64 * wc + 4 * fq;
                EPI_COLS { const f32x4 v = acc[ai][bj][m][n] * rs * g[bj][n]; u32x2 w; w.x = cvtpk(v.x, v.y); w.y = cvtpk(v.z, v.w); *(u32x2*)(dst + 32 * bj + 16 * n) = w; } }
        } else if (pn < 5) {
            const bool norm = (pn > 2) && (wc < 2);
            f32x4 g[2][2];
            EPI_COLS g[bj][n] = norm ? *(const f32x4*)(k_gain + (pn - 2) * 64 + 32 * bj + 16 * n + 4 * fq) : (f32x4){1.f, 1.f, 1.f, 1.f};
            EPI_ROWS { const int row = rowb + 128 * ai + 16 * m; float rs = 1.f;
                if (norm) { float ss = 0.f;
                    EPI_COLS { const f32x4 v = acc[ai][bj][m][n]; ss += (v.x * v.x + v.y * v.y) + (v.z * v.z + v.w * v.w); }
                    ss += __shfl_xor(ss, 16); ss += __shfl_xor(ss, 32);
                    rs = 1.0f / sqrtf(ss * (1.f / 64.f) + EPS); }
                float* fdst = nullptr; bf16* bdst = nullptr; const float* pep = nullptr;
                if (pn == 2) { fdst = (row < MP) ? out + O_KVP + (size_t)row * 512 : out + O_KVS + (size_t)(row - MP) * 512;
                               if (row < MP) { bdst = KC + (size_t)row * 256; pep = pe + (wc >> 1) * 4096 + (row & 63) * 64; } }
                else if (pn == 3) { fdst = ((row < MP) ? out + O_KVP + (size_t)row * 512 : out + O_KVS + (size_t)(row - MP) * 512) + 256; bdst = KS + (size_t)row * 256; }
                else { bdst = KW + (size_t)row * 256;
                       if (row < MP) { const int t = row & (SEQ - 1), b = row >> 12; if (t >= SEQ - 512) fdst = out + O_WINP + ((size_t)b * 512 + (t - (SEQ - 512))) * 256; }
                       else { const int rs_ = row - MP, b = rs_ >> 3, t = rs_ & 7; fdst = out + O_WINS + ((size_t)b * 512 + 504 + t) * 256; } }
                const int cb = 64 * wc + 4 * fq;
                EPI_COLS { const int off = 32 * bj + 16 * n; f32x4 v = acc[ai][bj][m][n] * rs * g[bj][n];
                    if (fdst) *(f32x4*)(fdst + cb + off) = v;
                    if (bdst) { if (pep) v = v + *(const f32x4*)(pep + 4 * fq + off); u32x2 w; w.x = cvtpk(v.x, v.y); w.y = cvtpk(v.z, v.w); *(u32x2*)(bdst + cb + off) = w; } } }
        } else if (pn < 13) {
            const int kind = (pn - 5) >> 1, cbase = ((pn - 5) & 1) * 256 + 64 * wc + 4 * fq;
            bf16* B = (bf16*)(ws + WS_RQ + (size_t)kind * (WS_RK - WS_RQ));
            f32x4 lbv[2][2];
            EPI_COLS lbv[bj][n] = (kind == 1) ? *(const f32x4*)(lb + cbase + 32 * bj + 16 * n) : (f32x4){0.f, 0.f, 0.f, 0.f};
            EPI_ROWS { const int row = rowb + 128 * ai + 16 * m;
                EPI_COLS { const int off = 32 * bj + 16 * n; f32x4 v = acc[ai][bj][m][n];
                    if (kind == 0 || kind == 3) { v.x = siluf_(v.x); v.y = siluf_(v.y); v.z = siluf_(v.z); v.w = siluf_(v.w); }
                    if (kind == 1) { f32x4 gl, kk; const f32x4 l = lbv[bj][n];
#pragma unroll
                        for (int i = 0; i < 4; ++i) { const float e = __expf(-v[i]); const float sg = 1.0f / (1.0f + e); const float f = l[i] + (1.0f - l[i]) * sg; gl[i] = __logf(f); kk[i] = (1.0f - l[i]) * (e * sg); }
                        *(f32x4*)(GL + (size_t)row * 512 + cbase + off) = gl; v = kk; }
                    u32x2 w; w.x = cvtpk(v.x, v.y); w.y = cvtpk(v.z, v.w); *(u32x2*)(B + (size_t)row * 512 + cbase + off) = w; } }
        } else {
            if (wc == 0) {
                EPI_ROWS { const int row = rowb + 128 * ai + 16 * m;
#pragma unroll
                    for (int n = 0; n < 2; ++n) { const int off = 16 * n + 4 * fq; if (off < 24) { f32x4 v = acc[ai][0][m][n];
                        v.x = sigmoidf_(v.x); v.y = sigmoidf_(v.y); v.z = sigmoidf_(v.z); v.w = sigmoidf_(v.w); *(f32x4*)(GATES + (size_t)row * 24 + off) = v; } } }
            }
        }
#undef EPI_ROWS
#undef EPI_COLS
    }
};


typedef short v4i16_t __attribute__((ext_vector_type(4)));
constexpr int KVS = 144;
constexpr int KVT = 64 * KVS;
constexpr float LOG2E = 1.4426950408889634f;
constexpr float SL2 = 0.125f * LOG2E;
__device__ __forceinline__ f32x4 mfma16(bf16x8 a, bf16x8 b, f32x4 c) { return __builtin_amdgcn_mfma_f32_16x16x32_bf16(a, b, c, 0, 0, 0); }
__device__ __forceinline__ bf16x4 ldtr(LAS const unsigned char* p) { return __builtin_bit_cast(bf16x4, __builtin_amdgcn_ds_read_tr16_b64_v4i16((LAS v4i16_t*)p)); }
__device__ __forceinline__ bf16x8 pack8(f32x4 a, f32x4 b) { u32x4 w; w.x = cvtpk(a.x, a.y); w.y = cvtpk(a.z, a.w); w.z = cvtpk(b.x, b.y); w.w = cvtpk(b.z, b.w); return __builtin_bit_cast(bf16x8, w); }
__device__ __forceinline__ bf16x8 cat44(bf16x4 a, bf16x4 b) { return (bf16x8){a[0], a[1], a[2], a[3], b[0], b[1], b[2], b[3]}; }
struct AttnSt { f32x4 o[4][2]; float m[2], l[2]; };
__device__ __forceinline__ void attn_init(AttnSt& st) {
#pragma unroll
    for (int dt = 0; dt < 4; ++dt) { st.o[dt][0] = (f32x4){0.f, 0.f, 0.f, 0.f}; st.o[dt][1] = (f32x4){0.f, 0.f, 0.f, 0.f}; }
    st.m[0] = st.m[1] = -__builtin_inff(); st.l[0] = st.l[1] = 0.f;
}
__device__ __forceinline__ void attn_scores(f32x4 (&s)[2][4], const bf16x8 (&qf)[2][2], LAS const unsigned char* Kt, int c, int q4) {
#pragma unroll
    for (int kt4 = 0; kt4 < 4; ++kt4) {
        const bf16x8 k0 = *(LAS const bf16x8*)(Kt + (16 * kt4 + c) * KVS + 16 * q4);
        const bf16x8 k1 = *(LAS const bf16x8*)(Kt + (16 * kt4 + c) * KVS + 64 + 16 * q4);
#pragma unroll
        for (int qt2 = 0; qt2 < 2; ++qt2) s[qt2][kt4] = mfma16(k1, qf[qt2][1], mfma16(k0, qf[qt2][0], (f32x4){0.f, 0.f, 0.f, 0.f}));
    }
}
__device__ __forceinline__ void attn_pv(f32x4 (&o)[4][2], const f32x4 (&p)[2][4], LAS const unsigned char* Vt, int c, int q4) {
    const int vrow = 4 * q4 + (c >> 2), vcol = 8 * (c & 3);
#pragma unroll
    for (int s2 = 0; s2 < 2; ++s2) {
        const bf16x8 pb0 = pack8(p[0][2 * s2], p[0][2 * s2 + 1]), pb1 = pack8(p[1][2 * s2], p[1][2 * s2 + 1]);
#pragma unroll
        for (int dt = 0; dt < 4; ++dt) {
            const bf16x4 lo = ldtr(Vt + (32 * s2 + vrow) * KVS + 32 * dt + vcol);
            const bf16x4 hi = ldtr(Vt + (32 * s2 + 16 + vrow) * KVS + 32 * dt + vcol);
            const bf16x8 vf = cat44(lo, hi);
            o[dt][0] = mfma16(vf, pb0, o[dt][0]); o[dt][1] = mfma16(vf, pb1, o[dt][1]);
        }
    }
}
__device__ __forceinline__ void attn_update(AttnSt& st, f32x4 (&x)[2][4], LAS const unsigned char* Vt, int c, int q4) {
#pragma unroll
    for (int qt2 = 0; qt2 < 2; ++qt2) {
        float mx = -__builtin_inff();
#pragma unroll
        for (int kt4 = 0; kt4 < 4; ++kt4) mx = fmaxf(mx, fmaxf(fmaxf(x[qt2][kt4].x, x[qt2][kt4].y), fmaxf(x[qt2][kt4].z, x[qt2][kt4].w)));
        mx = fmaxf(mx, __shfl_xor(mx, 16)); mx = fmaxf(mx, __shfl_xor(mx, 32));
        const float mn = fmaxf(st.m[qt2], mx), mu = (mn == -__builtin_inff()) ? 0.f : mn;
        const float alpha = __builtin_amdgcn_exp2f(st.m[qt2] - mu);
        float ls = 0.f;
#pragma unroll
        for (int kt4 = 0; kt4 < 4; ++kt4) { f32x4 e;
#pragma unroll
            for (int i = 0; i < 4; ++i) e[i] = __builtin_amdgcn_exp2f(x[qt2][kt4][i] - mu);
            x[qt2][kt4] = e; ls += (e.x + e.y) + (e.z + e.w); }
        st.l[qt2] = st.l[qt2] * alpha + ls; st.m[qt2] = mn;
#pragma unroll
        for (int dt = 0; dt < 4; ++dt) st.o[dt][qt2] = st.o[dt][qt2] * alpha;
    }
    attn_pv(st.o, x, Vt, c, q4);
}
__device__ __forceinline__ void kv_load_regs(u32x4& kr, u32x4& vr, const bf16* base, size_t row0, int kcol, int tid) {
    const bf16* p = base + (row0 + (tid >> 3)) * 256 + kcol + 8 * (tid & 7);
    kr = *(const u32x4*)p; vr = *(const u32x4*)(p + 128);
}
__device__ __forceinline__ void kv_store_lds(LAS unsigned char* Kt, LAS unsigned char* Vt, u32x4 kr, u32x4 vr, int tid) {
    const int off = (tid >> 3) * KVS + 16 * (tid & 7);
    *(LAS u32x4*)(Kt + off) = kr; *(LAS u32x4*)(Vt + off) = vr;
}
__device__ __forceinline__ void load_qfrags(bf16x8 (&qf)[2][2], const bf16* Q, size_t row0, int hcol, int c, int q4) {
#pragma unroll
    for (int qt2 = 0; qt2 < 2; ++qt2)
#pragma unroll
        for (int ks = 0; ks < 2; ++ks) qf[qt2][ks] = *(const bf16x8*)(Q + (row0 + 16 * qt2 + c) * 512 + hcol + 32 * ks + 8 * q4);
}

__device__ __forceinline__ void win_prompt_unit(LAS unsigned char* lds, unsigned char* ws, int unit, int tid) {
    const int lane = tid & 63, w = __builtin_amdgcn_readfirstlane(tid >> 6), c = lane & 15, q4 = lane >> 4;
    const int b = unit >> 7, g = (unit >> 6) & 1, qblk = unit & 63, t0 = 64 * qblk, r = w & 3, th = w >> 2, head = 4 * g + r;
    const float slope2 = __builtin_amdgcn_exp2f(-(float)(head + 1)) * LOG2E;
    const bf16* KW = (const bf16*)(ws + WS_KW);
    const size_t rowb = (size_t)b * SEQ;
    bf16x8 qf[2][2]; load_qfrags(qf, (const bf16*)(ws + WS_Q), rowb + t0 + 32 * th, 64 * head, c, q4);
    AttnSt st; attn_init(st);
    const int j0 = qblk >= 8 ? qblk - 8 : 0, nt = qblk - j0 + 1;
    u32x4 kr, vr;
    kv_load_regs(kr, vr, KW, rowb + 64 * j0, 64 * g, tid);
    kv_store_lds(lds, lds + KVT, kr, vr, tid);
    __syncthreads();
    for (int i = 0; i < nt; ++i) {
        LAS unsigned char* Kt = lds + (i & 1) * 2 * KVT; LAS unsigned char* Vt = Kt + KVT;
        if (i + 1 < nt) kv_load_regs(kr, vr, KW, rowb + 64 * (j0 + i + 1), 64 * g, tid);
        f32x4 s[2][4]; attn_scores(s, qf, Kt, c, q4);
        const int kbase = 64 * (j0 + i);
#pragma unroll
        for (int qt2 = 0; qt2 < 2; ++qt2) { const int qpos = t0 + 32 * th + 16 * qt2 + c;
#pragma unroll
            for (int kt4 = 0; kt4 < 4; ++kt4)
#pragma unroll
                for (int e = 0; e < 4; ++e) { const int dist = qpos - (kbase + 16 * kt4 + 4 * q4 + e);
                    s[qt2][kt4][e] = (dist >= 0 && dist < 512) ? s[qt2][kt4][e] * SL2 - slope2 * (float)dist : -__builtin_inff(); } }
        attn_update(st, s, Vt, c, q4);
        if (i + 1 < nt) { LAS unsigned char* Kn = lds + ((i + 1) & 1) * 2 * KVT; kv_store_lds(Kn, Kn + KVT, kr, vr, tid); }
        __syncthreads();
    }
    bf16* OW = (bf16*)(ws + WS_OWIN);
#pragma unroll
    for (int qt2 = 0; qt2 < 2; ++qt2) { float l = st.l[qt2]; l += __shfl_xor(l, 16); l += __shfl_xor(l, 32); const float il = 1.0f / l;
        bf16* dst = OW + (rowb + t0 + 32 * th + 16 * qt2 + c) * 512 + 64 * head + 4 * q4;
#pragma unroll
        for (int dt = 0; dt < 4; ++dt) { const f32x4 v = st.o[dt][qt2] * il; u32x2 wv; wv.x = cvtpk(v.x, v.y); wv.y = cvtpk(v.z, v.w); *(u32x2*)(dst + 16 * dt) = wv; } }
}

constexpr int SL_KV = 0, SL_PSLAB = 4 * KVT  , SL_IMP = SL_PSLAB + 65536, SL_MASK = SL_IMP + 16384, SL_UMASK = SL_MASK + 512;
__device__ __forceinline__ void sel_prompt_unit(LAS unsigned char* lds, unsigned char* ws, const float* attn_gain, int unit, int tid) {
    const int lane = tid & 63, w = __builtin_amdgcn_readfirstlane(tid >> 6), c = lane & 15, q4 = lane >> 4;
    const int b = unit >> 7, g = (unit >> 6) & 1, qblk = unit & 63, t0 = 64 * qblk, r = w & 3, th = w >> 2, head = 4 * g + r;
    const float slope2 = __builtin_amdgcn_exp2f(-(float)(head + 1)) * LOG2E;
    const size_t rowb = (size_t)b * SEQ;
    bf16x8 qf[2][2]; load_qfrags(qf, (const bf16*)(ws + WS_Q), rowb + t0 + 32 * th, 64 * head, c, q4);
    LAS float* PSLAB = (LAS float*)(lds + SL_PSLAB); LAS float* IMP = (LAS float*)(lds + SL_IMP);
    LAS unsigned long long* MASK = (LAS unsigned long long*)(lds + SL_MASK);
    {
        const float* kc = (const float*)(ws + WS_KCMP) + (((size_t)b * 64 + (tid >> 3)) * 2 + g) * 64 + 8 * (tid & 7);
        const float* vc = (const float*)(ws + WS_VCMP) + (((size_t)b * 64 + (tid >> 3)) * 2 + g) * 64 + 8 * (tid & 7);
        const f32x4 k0 = *(const f32x4*)kc, k1 = *(const f32x4*)(kc + 4), v0 = *(const f32x4*)vc, v1 = *(const f32x4*)(vc + 4);
        kv_store_lds(lds, lds + KVT, __builtin_bit_cast(u32x4, pack8(k0, k1)), __builtin_bit_cast(u32x4, pack8(v0, v1)), tid);
    }
    __syncthreads();
    AttnSt sc; attn_init(sc);
    {
        f32x4 s[2][4]; attn_scores(s, qf, lds, c, q4);
#pragma unroll
        for (int qt2 = 0; qt2 < 2; ++qt2) { const int tok = 32 * th + 16 * qt2 + c, qpos = t0 + tok; float mx = -__builtin_inff();
#pragma unroll
            for (int kt4 = 0; kt4 < 4; ++kt4)
#pragma unroll
                for (int e = 0; e < 4; ++e) { const int dist = qpos - (64 * (16 * kt4 + 4 * q4 + e) + 63);
                    const float x = (dist >= 0) ? s[qt2][kt4][e] * SL2 - slope2 * (float)dist : -__builtin_inff(); s[qt2][kt4][e] = x; mx = fmaxf(mx, x); }
            mx = fmaxf(mx, __shfl_xor(mx, 16)); mx = fmaxf(mx, __shfl_xor(mx, 32));
            const float mu = (mx == -__builtin_inff()) ? 0.f : mx; float ls = 0.f;
#pragma unroll
            for (int kt4 = 0; kt4 < 4; ++kt4)
#pragma unroll
                for (int e = 0; e < 4; ++e) { const float p = __builtin_amdgcn_exp2f(s[qt2][kt4][e] - mu); s[qt2][kt4][e] = p; ls += p; }
            ls += __shfl_xor(ls, 16); ls += __shfl_xor(ls, 32);
            const float il = ls > 0.f ? 1.0f / ls : 0.f;
#pragma unroll
            for (int kt4 = 0; kt4 < 4; ++kt4) { s[qt2][kt4] = s[qt2][kt4] * il; *(LAS f32x4*)(PSLAB + (r * 64 + tok) * 64 + 16 * kt4 + 4 * q4) = s[qt2][kt4]; } }
        attn_pv(sc.o, s, lds + KVT, c, q4);
    }
    __syncthreads();
    {
        const int tok = tid >> 3, jg = tid & 7;
#pragma unroll
        for (int h2 = 0; h2 < 2; ++h2) { f32x4 a = (f32x4){0.f, 0.f, 0.f, 0.f};
#pragma unroll
            for (int rr = 0; rr < 4; ++rr) a = a + *(LAS const f32x4*)(PSLAB + (rr * 64 + tok) * 64 + 8 * jg + 4 * h2);
            *(LAS f32x4*)(IMP + tok * 64 + 8 * jg + 4 * h2) = a; }
    }
    __syncthreads();
    {
        const int tok = tid >> 3, jg = tid & 7; unsigned long long bits = 0ull;
        for (int jj = 0; jj < 8; ++jj) { const int j = 8 * jg + jj; bool sel = false;
            if (j == 0 || j == qblk) sel = true;
            else if (j < qblk) { const float vj = IMP[tok * 64 + j]; int cnt = 0;
                for (int i = 1; i < qblk; ++i) { const float vi = IMP[tok * 64 + i]; cnt += (vi > vj || (vi == vj && i < j)) ? 1 : 0; }
                sel = cnt < 14; }
            if (sel) bits |= 1ull << j; }
        bits |= __shfl_xor(bits, 1); bits |= __shfl_xor(bits, 2); bits |= __shfl_xor(bits, 4);
        if (jg == 0) MASK[tok] = bits;
    }
    __syncthreads();
    if (tid < 64) { unsigned long long u = MASK[tid];
#pragma unroll
        for (int o = 1; o < 64; o <<= 1) u |= __shfl_xor(u, o);
        if (tid == 0) *(LAS unsigned long long*)(lds + SL_UMASK) = u; }
    __syncthreads();
    unsigned long long um = *(LAS unsigned long long*)(lds + SL_UMASK);
    um = ((unsigned long long)__builtin_amdgcn_readfirstlane((unsigned)(um >> 32)) << 32) | (unsigned)__builtin_amdgcn_readfirstlane((unsigned)um);
    const unsigned long long msk0 = MASK[32 * th + c], msk1 = MASK[32 * th + 16 + c];
    const bf16* KS = (const bf16*)(ws + WS_KS);
    AttnSt st; attn_init(st);
    u32x4 kr, vr;
    int jcur = __builtin_ctzll(um); um &= um - 1;
    kv_load_regs(kr, vr, KS, rowb + 64 * jcur, 64 * g, tid);
    __syncthreads();
    kv_store_lds(lds, lds + KVT, kr, vr, tid);
    __syncthreads();
    for (int i = 0;; ++i) {
        LAS unsigned char* Kt = lds + (i & 1) * 2 * KVT; LAS unsigned char* Vt = Kt + KVT;
        const bool more = um != 0ull; int jn = 0;
        if (more) { jn = __builtin_ctzll(um); um &= um - 1; kv_load_regs(kr, vr, KS, rowb + 64 * jn, 64 * g, tid); }
        const bool s0 = (msk0 >> jcur) & 1ull, s1 = (msk1 >> jcur) & 1ull;
        if (__any(s0 || s1)) {
            f32x4 s[2][4]; attn_scores(s, qf, Kt, c, q4);
            const int kbase = 64 * jcur;
#pragma unroll
            for (int qt2 = 0; qt2 < 2; ++qt2) { const int qpos = t0 + 32 * th + 16 * qt2 + c; const bool sq = qt2 ? s1 : s0;
#pragma unroll
                for (int kt4 = 0; kt4 < 4; ++kt4)
#pragma unroll
                    for (int e = 0; e < 4; ++e) { const int dist = qpos - (kbase + 16 * kt4 + 4 * q4 + e);
                        s[qt2][kt4][e] = (sq && dist >= 0) ? s[qt2][kt4][e] * SL2 - slope2 * (float)dist : -__builtin_inff(); } }
            attn_update(st, s, Vt, c, q4);
        }
        if (more) { LAS unsigned char* Kn = lds + ((i + 1) & 1) * 2 * KVT; kv_store_lds(Kn, Kn + KVT, kr, vr, tid); }
        __syncthreads();
        if (!more) break;
        jcur = jn;
    }
    const float* GATES = (const float*)(ws + WS_GATES); const bf16* OW = (const bf16*)(ws + WS_OWIN); bf16* OA = (bf16*)(ws + WS_OA);
#pragma unroll
    for (int qt2 = 0; qt2 < 2; ++qt2) { const size_t row = rowb + t0 + 32 * th + 16 * qt2 + c;
        float l = st.l[qt2]; l += __shfl_xor(l, 16); l += __shfl_xor(l, 32); const float il = l > 0.f ? 1.0f / l : 0.f;
        const float g0 = GATES[row * 24 + head * 3 + 0], g1 = GATES[row * 24 + head * 3 + 1] * il, g2 = GATES[row * 24 + head * 3 + 2];
        f32x4 oa[4]; float ss = 0.f;
#pragma unroll
        for (int dt = 0; dt < 4; ++dt) { const u32x2 wv = *(const u32x2*)(OW + row * 512 + 64 * head + 16 * dt + 4 * q4);
            const f32x4 ow = (f32x4){__builtin_bit_cast(float, wv.x << 16), __builtin_bit_cast(float, wv.x & 0xffff0000u), __builtin_bit_cast(float, wv.y << 16), __builtin_bit_cast(float, wv.y & 0xffff0000u)};
            oa[dt] = sc.o[dt][qt2] * g0 + st.o[dt][qt2] * g1 + ow * g2;
            ss += (oa[dt].x * oa[dt].x + oa[dt].y * oa[dt].y) + (oa[dt].z * oa[dt].z + oa[dt].w * oa[dt].w); }
        ss += __shfl_xor(ss, 16); ss += __shfl_xor(ss, 32);
        const float rs = 1.0f / sqrtf(ss * (1.f / 64.f) + EPS);
#pragma unroll
        for (int dt = 0; dt < 4; ++dt) { const f32x4 gn = *(const f32x4*)(attn_gain + 64 * head + 16 * dt + 4 * q4); const f32x4 v = oa[dt] * rs * gn;
            u32x2 wv; wv.x = cvtpk(v.x, v.y); wv.y = cvtpk(v.z, v.w); *(u32x2*)(OA + row * 1024 + 64 * head + 16 * dt + 4 * q4) = wv; } }
    __syncthreads();
}

constexpr int CA_RS = 528, CA_KIND = 32 * CA_RS, CA_BUF = 2 * CA_KIND  , CL_H = 2 * CA_BUF  , CH_RS = 272, CL_O = CL_H + 2 * 32 * CH_RS  , CO_RS = 272;
constexpr int N_CMP_ITEMS = 272;
__device__ __forceinline__ void compress_item(LAS unsigned char* lds, unsigned char* ws, const float* cache_kv, const int* page_table, const float* pe, const float* k_gain, int item, int tid) {
    const int lane = tid & 63, w = __builtin_amdgcn_readfirstlane(tid >> 6), c = lane & 15, q4 = lane >> 4;
    const bool prompt = item < 16;
    const int sb = prompt ? (item >> 2) : ((item - 16) >> 1), blk0 = prompt ? (item & 3) * 16 : ((item - 16) & 1) * 16;
    const int l_pl = (tid >> 6) & 3, l_piece = tid & 63, l_kind = l_piece >> 5, l_g = (l_piece >> 4) & 1, l_d = 4 * (l_piece & 15), l_blo = tid >> 8;
    const float* srcS[8]; const bf16* srcP[8];
#pragma unroll
    for (int i = 0; i < 8; ++i) { const int blk = blk0 + 2 * i + l_blo;
        if (prompt) { srcP[i] = (const bf16*)(ws + WS_KC) + ((size_t)sb * SEQ + 64 * blk + l_pl) * 256 + 4 * l_piece; srcS[i] = nullptr; }
        else { const int page = page_table[sb * NPAGES + (blk >> 1)]; srcS[i] = cache_kv + ((size_t)page * PAGE + (blk & 1) * 64 + l_pl) * 512 + 4 * l_piece; srcP[i] = nullptr; } }
    const float* pep = pe + l_kind * 4096 + l_pl * 64 + l_d;
    const int l_dst = l_kind * CA_KIND + l_g * CA_RS + (l_pl * 64 + l_d) * 2;
    f32x4 rs_[8]; u32x2 rp_[8];
#define CMP_LOAD(ch) do { if (prompt) { _Pragma("unroll") for (int i = 0; i < 8; ++i) rp_[i] = *(const u32x2*)(srcP[i] + (size_t)(4 * (ch)) * 256); } \
        else { _Pragma("unroll") for (int i = 0; i < 8; ++i) rs_[i] = *(const f32x4*)(srcS[i] + (size_t)(4 * (ch)) * 512); } } while (0)
#define CMP_STORE(ch, buf) do { LAS unsigned char* A_ = lds + (buf) * CA_BUF + l_dst; \
        if (prompt) { _Pragma("unroll") for (int i = 0; i < 8; ++i) *(LAS u32x2*)(A_ + 2 * (2 * i + l_blo) * CA_RS) = rp_[i]; } \
        else { const f32x4 pv_ = *(const f32x4*)(pep + (4 * (ch)) * 64); _Pragma("unroll") for (int i = 0; i < 8; ++i) { const f32x4 v_ = rs_[i] + pv_; u32x2 w_; w_.x = cvtpk(v_.x, v_.y); w_.y = cvtpk(v_.z, v_.w); *(LAS u32x2*)(A_ + 2 * (2 * i + l_blo) * CA_RS) = w_; } } } while (0)
    const int kind = w >> 2, nq = w & 3;
    const bf16* W1 = (const bf16*)(ws + WS_W1) + (size_t)kind * 128 * 4096 + (size_t)(32 * nq + c) * 4096 + 8 * q4;
    f32x4 acc[2][2];
#pragma unroll
    for (int mt = 0; mt < 2; ++mt) { acc[mt][0] = (f32x4){0.f, 0.f, 0.f, 0.f}; acc[mt][1] = (f32x4){0.f, 0.f, 0.f, 0.f}; }
    CMP_LOAD(0); CMP_STORE(0, 0);
    __syncthreads();
    for (int ch = 0; ch < 16; ++ch) {
        if (ch + 1 < 16) CMP_LOAD(ch + 1);
        bf16x8 bfr[8][2];
#pragma unroll
        for (int ks = 0; ks < 8; ++ks) { bfr[ks][0] = *(const bf16x8*)(W1 + 256 * ch + 32 * ks); bfr[ks][1] = *(const bf16x8*)(W1 + 16 * 4096 + 256 * ch + 32 * ks); }
        LAS const unsigned char* A = lds + (ch & 1) * CA_BUF + kind * CA_KIND + c * CA_RS + 16 * q4;
#pragma unroll
        for (int ks = 0; ks < 8; ++ks) {
            const bf16x8 a0 = *(LAS const bf16x8*)(A + 64 * ks), a1 = *(LAS const bf16x8*)(A + 16 * CA_RS + 64 * ks);
            acc[0][0] = mfma16(a0, bfr[ks][0], acc[0][0]); acc[0][1] = mfma16(a0, bfr[ks][1], acc[0][1]);
            acc[1][0] = mfma16(a1, bfr[ks][0], acc[1][0]); acc[1][1] = mfma16(a1, bfr[ks][1], acc[1][1]);
        }
        if (ch + 1 < 16) CMP_STORE(ch + 1, (ch + 1) & 1);
        __syncthreads();
    }
#undef CMP_LOAD
#undef CMP_STORE
    {
        LAS unsigned short* H = (LAS unsigned short*)(lds + CL_H + kind * 32 * CH_RS);
#pragma unroll
        for (int mt = 0; mt < 2; ++mt)
#pragma unroll
            for (int nt = 0; nt < 2; ++nt)
#pragma unroll
                for (int e = 0; e < 4; ++e) { const float v = siluf_(acc[mt][nt][e]); H[(16 * mt + 4 * q4 + e) * (CH_RS / 2) + 32 * nq + 16 * nt + c] = (unsigned short)(cvtpk(v, 0.f) & 0xffffu); }
    }
    __syncthreads();
    {
        const bf16* W2 = (const bf16*)(ws + WS_W2) + (size_t)kind * 64 * 128 + (size_t)(16 * nq + c) * 128 + 8 * q4;
        LAS const unsigned char* H = lds + CL_H + kind * 32 * CH_RS + c * CH_RS + 16 * q4;
        f32x4 o0 = (f32x4){0.f, 0.f, 0.f, 0.f}, o1 = o0;
#pragma unroll
        for (int ks = 0; ks < 4; ++ks) { const bf16x8 bw = *(const bf16x8*)(W2 + 32 * ks);
            o0 = mfma16(*(LAS const bf16x8*)(H + 64 * ks), bw, o0); o1 = mfma16(*(LAS const bf16x8*)(H + 16 * CH_RS + 64 * ks), bw, o1); }
        LAS float* O = (LAS float*)(lds + CL_O + kind * 32 * CO_RS);
#pragma unroll
        for (int e = 0; e < 4; ++e) { O[(4 * q4 + e) * (CO_RS / 4) + 16 * nq + c] = o0[e]; O[(16 + 4 * q4 + e) * (CO_RS / 4) + 16 * nq + c] = o1[e]; }
    }
    __syncthreads();
    {
        const int fk = tid >> 8, row = (tid >> 3) & 31, seg = tid & 7;
        LAS const float* O = (LAS const float*)(lds + CL_O + fk * 32 * CO_RS) + row * (CO_RS / 4) + 8 * seg;
        f32x4 a = *(LAS const f32x4*)O, b = *(LAS const f32x4*)(O + 4);
        if (fk == 0) { float ss = (a.x * a.x + a.y * a.y) + (a.z * a.z + a.w * a.w) + (b.x * b.x + b.y * b.y) + (b.z * b.z + b.w * b.w);
            ss += __shfl_xor(ss, 1); ss += __shfl_xor(ss, 2); ss += __shfl_xor(ss, 4);
            const float rs = 1.0f / sqrtf(ss * (1.f / 64.f) + EPS);
            a = a * rs * *(const f32x4*)(k_gain + 8 * seg); b = b * rs * *(const f32x4*)(k_gain + 8 * seg + 4); }
        float* dst = (float*)(ws + (fk == 0 ? WS_KCMP : WS_VCMP)) + ((size_t)(16 * item + (row >> 1)) * 2 + (row & 1)) * 64 + 8 * seg;
        *(f32x4*)dst = a; *(f32x4*)(dst + 4) = b;
    }
    __syncthreads();
}

constexpr int HG_QH = 0, HG_QT = KVT, HG_KT = 2 * KVT, HG_KH = 3 * KVT, HG_V = 4 * KVT, HG_QS = 5 * KVT, HG_LAST = HG_QS + 1024, HG_HALF = HG_LAST + 256;
__device__ __forceinline__ void hgrn_local_item(LAS unsigned char* lds_all, unsigned char* ws, int item, int tid) {
    const int half = tid >> 8, lt = tid & 255, lane = tid & 63, we = __builtin_amdgcn_readfirstlane((tid >> 6) & 3), c = lane & 15, q4 = lane >> 4;
    LAS unsigned char* lds = lds_all + half * HG_HALF;
    const int unit = 2 * item + half, b = unit >> 6, h = (unit >> 3) & 7, sc = unit & 7;
    const size_t T0 = (size_t)b * SEQ + 512 * sc; const int hc = 64 * h;
    const bf16* RQ = (const bf16*)(ws + WS_RQ); const bf16* RK = (const bf16*)(ws + WS_RK); const bf16* RV = (const bf16*)(ws + WS_RV); const float* GL = (const float*)(ws + WS_GL);
    float* OLOC = (float*)(ws + WS_OLOC); bf16* QH = (bf16*)(ws + WS_QH);
    const int ed = lt & 63, etq = lt >> 6;
    LAS float* QS = (LAS float*)(lds + HG_QS); LAS float* LASTE = (LAS float*)(lds + HG_LAST);
    f32x4 S[4];
#pragma unroll
    for (int dt = 0; dt < 4; ++dt) S[dt] = (f32x4){0.f, 0.f, 0.f, 0.f};
    float base = 0.f;
    for (int cc = 0; cc < 8; ++cc) {
        const size_t R0 = T0 + 64 * cc;
        float pre[16];
        { float run = 0.f;
#pragma unroll
          for (int i = 0; i < 16; ++i) { run += GL[(R0 + 16 * etq + i) * 512 + hc + ed]; pre[i] = run; }
          QS[etq * 64 + ed] = run; }
        { const int vr_ = lt >> 2, vc_ = lt & 3;
          const bf16* vp = RV + (R0 + vr_) * 512 + hc + 8 * vc_;
          const u32x4 v0 = *(const u32x4*)vp, v1 = *(const u32x4*)(vp + 32);
          *(LAS u32x4*)(lds + HG_V + vr_ * KVS + 16 * vc_) = v0; *(LAS u32x4*)(lds + HG_V + vr_ * KVS + 64 + 16 * vc_) = v1; }
        __syncthreads();
        {
            const float s0 = QS[ed], s1 = QS[64 + ed], s2 = QS[128 + ed], s3 = QS[192 + ed];
            const float off = (etq > 0 ? s0 : 0.f) + (etq > 1 ? s1 : 0.f) + (etq > 2 ? s2 : 0.f);
            const float ref = s0 + s1, last = (s0 + s1) + (s2 + s3);
            if (etq == 0) LASTE[ed] = __expf(last);
#pragma unroll
            for (int i = 0; i < 16; ++i) { const int t = 16 * etq + i; const size_t gi = (R0 + t) * 512 + hc + ed;
                const float cum = off + pre[i], q = bf2f(RQ[gi]), k = bf2f(RK[gi]);
                const float dq = fminf(fmaxf(cum - ref, -60.f), 60.f);
                const float qh = q * __expf(cum), qt = q * __expf(dq), kt = k * __expf(-dq), kh = k * __expf(last - cum);
                const int lo = t * KVS + 2 * ed;
                *(LAS unsigned short*)(lds + HG_QH + lo) = (unsigned short)(cvtpk(qh, 0.f) & 0xffffu);
                *(LAS unsigned short*)(lds + HG_QT + lo) = (unsigned short)(cvtpk(qt, 0.f) & 0xffffu);
                *(LAS unsigned short*)(lds + HG_KT + lo) = (unsigned short)(cvtpk(kt, 0.f) & 0xffffu);
                *(LAS unsigned short*)(lds + HG_KH + lo) = (unsigned short)(cvtpk(kh, 0.f) & 0xffffu);
                QH[gi] = (unsigned short)(cvtpk(q * __expf(base + cum), 0.f) & 0xffffu); }
            base += last;
        }
        __syncthreads();
        f32x4 at[4][4];
#pragma unroll
        for (int tt = 0; tt < 4; ++tt) {
            const bf16x8 qa = *(LAS const bf16x8*)(lds + HG_QT + (16 * tt + c) * KVS + 16 * q4), qb = *(LAS const bf16x8*)(lds + HG_QT + (16 * tt + c) * KVS + 64 + 16 * q4);
#pragma unroll
            for (int st = 0; st < 4; ++st) {
                if (st <= tt) {
                    const bf16x8 ka = *(LAS const bf16x8*)(lds + HG_KT + (16 * st + c) * KVS + 16 * q4), kb = *(LAS const bf16x8*)(lds + HG_KT + (16 * st + c) * KVS + 64 + 16 * q4);
                    f32x4 a = mfma16(kb, qb, mfma16(ka, qa, (f32x4){0.f, 0.f, 0.f, 0.f}));
                    if (st == tt) {
#pragma unroll
                        for (int i = 0; i < 4; ++i) a[i] = (4 * q4 + i <= c) ? a[i] : 0.f; }
                    at[st][tt] = a;
                } else at[st][tt] = (f32x4){0.f, 0.f, 0.f, 0.f};
            }
        }
        const int vrow = 4 * q4 + (c >> 2), vcol = 8 * (c & 3);
        f32x4 o[4];
#pragma unroll
        for (int tt = 0; tt < 4; ++tt) o[tt] = (f32x4){0.f, 0.f, 0.f, 0.f};
#pragma unroll
        for (int s2 = 0; s2 < 2; ++s2) {
            const bf16x8 vf = cat44(ldtr(lds + HG_V + (32 * s2 + vrow) * KVS + 32 * we + vcol), ldtr(lds + HG_V + (32 * s2 + 16 + vrow) * KVS + 32 * we + vcol));
#pragma unroll
            for (int tt = 0; tt < 4; ++tt) if (2 * s2 <= tt) o[tt] = mfma16(vf, pack8(at[2 * s2][tt], at[2 * s2 + 1][tt]), o[tt]);
        }
#pragma unroll
        for (int ks = 0; ks < 2; ++ks) {
            const bf16x8 sf = pack8(S[2 * ks], S[2 * ks + 1]);
#pragma unroll
            for (int tt = 0; tt < 4; ++tt) {
                const bf16x8 qh = cat44(*(LAS const bf16x4*)(lds + HG_QH + (16 * tt + c) * KVS + 64 * ks + 8 * q4), *(LAS const bf16x4*)(lds + HG_QH + (16 * tt + c) * KVS + 64 * ks + 32 + 8 * q4));
                o[tt] = mfma16(sf, qh, o[tt]);
            }
        }
#pragma unroll
        for (int tt = 0; tt < 4; ++tt) *(f32x4*)(OLOC + (R0 + 16 * tt + c) * 512 + hc + 16 * we + 4 * q4) = o[tt];
        const int srow = 8 * q4 + (c >> 2);
#pragma unroll
        for (int dt = 0; dt < 4; ++dt) { const f32x4 dec = *(LAS const f32x4*)(LASTE + 16 * dt + 4 * q4); S[dt] = S[dt] * dec; }
#pragma unroll
        for (int s2 = 0; s2 < 2; ++s2) {
            const bf16x8 vb = cat44(ldtr(lds + HG_V + (32 * s2 + srow) * KVS + 32 * we + vcol), ldtr(lds + HG_V + (32 * s2 + 4 + srow) * KVS + 32 * we + vcol));
#pragma unroll
            for (int dt = 0; dt < 4; ++dt) {
                const bf16x8 ka = cat44(ldtr(lds + HG_KH + (32 * s2 + srow) * KVS + 32 * dt + vcol), ldtr(lds + HG_KH + (32 * s2 + 4 + srow) * KVS + 32 * dt + vcol));
                S[dt] = mfma16(ka, vb, S[dt]);
            }
        }
        __syncthreads();
    }
    float* TS = (float*)(ws + WS_TSC) + (size_t)unit * 4096;
#pragma unroll
    for (int dt = 0; dt < 4; ++dt)
#pragma unroll
        for (int i = 0; i < 4; ++i) TS[(16 * dt + 4 * q4 + i) * 64 + 16 * we + c] = S[dt][i];
    if (etq == 0) ((float*)(ws + WS_DSC))[unit * 64 + ed] = __expf(base);
}

__device__ __forceinline__ void hgrn_combine_unit(LAS unsigned char* lds, unsigned char* ws, float* out, const float* rnn_gain, int unit, int tid) {
    const int lane = tid & 63, w = __builtin_amdgcn_readfirstlane(tid >> 6), c = lane & 15, q4 = lane >> 4;
    const int b = unit >> 6, h = (unit >> 3) & 7, sc = unit & 7, hc = 64 * h;
    const size_t T0 = (size_t)b * SEQ + 512 * sc;
    const float* TSC = (const float*)(ws + WS_TSC); const float* DSC = (const float*)(ws + WS_DSC);
    {
        const int d = tid >> 3, e0 = 8 * (tid & 7);
        f32x4 c0 = (f32x4){0.f, 0.f, 0.f, 0.f}, c1 = c0;
        for (int j = 0; j < sc; ++j) { const int u = unit - sc + j; const float dj = DSC[u * 64 + d]; const float* tp = TSC + (size_t)u * 4096 + d * 64 + e0;
            c0 = c0 * dj + *(const f32x4*)tp; c1 = c1 * dj + *(const f32x4*)(tp + 4); }
        if (sc == 7) { const float dj = DSC[unit * 64 + d]; const float* tp = TSC + (size_t)unit * 4096 + d * 64 + e0; float* op = out + O_RNNP + (size_t)(b * 8 + h) * 4096 + d * 64 + e0;
            *(f32x4*)op = c0 * dj + *(const f32x4*)tp; *(f32x4*)(op + 4) = c1 * dj + *(const f32x4*)(tp + 4); }
        LAS unsigned short* CT = (LAS unsigned short*)lds;
#pragma unroll
        for (int i = 0; i < 4; ++i) { CT[(e0 + i) * (KVS / 2) + d] = (unsigned short)(cvtpk(c0[i], 0.f) & 0xffffu); CT[(e0 + 4 + i) * (KVS / 2) + d] = (unsigned short)(cvtpk(c1[i], 0.f) & 0xffffu); }
    }
    __syncthreads();
    const bf16* QH = (const bf16*)(ws + WS_QH); const float* OLOC = (const float*)(ws + WS_OLOC); const bf16* RG = (const bf16*)(ws + WS_RG); bf16* OA = (bf16*)(ws + WS_OA);
    bf16x8 ctf[4][2];
#pragma unroll
    for (int et = 0; et < 4; ++et)
#pragma unroll
        for (int ks = 0; ks < 2; ++ks) ctf[et][ks] = *(LAS const bf16x8*)(lds + (16 * et + c) * KVS + 64 * ks + 16 * q4);
#pragma unroll
    for (int tt = 0; tt < 4; ++tt) {
        const size_t row = T0 + 64 * w + 16 * tt + c;
        const bf16x8 q0 = *(const bf16x8*)(QH + row * 512 + hc + 8 * q4), q1 = *(const bf16x8*)(QH + row * 512 + hc + 32 + 8 * q4);
        f32x4 o[4]; float ss = 0.f;
#pragma unroll
        for (int et = 0; et < 4; ++et) { o[et] = mfma16(ctf[et][1], q1, mfma16(ctf[et][0], q0, *(const f32x4*)(OLOC + row * 512 + hc + 16 * et + 4 * q4)));
            ss += (o[et].x * o[et].x + o[et].y * o[et].y) + (o[et].z * o[et].z + o[et].w * o[et].w); }
        ss += __shfl_xor(ss, 16); ss += __shfl_xor(ss, 32);
        const float rs = 1.0f / sqrtf(ss * (1.f / 64.f) + EPS);
#pragma unroll
        for (int et = 0; et < 4; ++et) { const int col = hc + 16 * et + 4 * q4; const u32x2 gw = *(const u32x2*)(RG + row * 512 + col);
            const f32x4 gg = (f32x4){__builtin_bit_cast(float, gw.x << 16), __builtin_bit_cast(float, gw.x & 0xffff0000u), __builtin_bit_cast(float, gw.y << 16), __builtin_bit_cast(float, gw.y & 0xffff0000u)};
            const f32x4 v = o[et] * rs * *(const f32x4*)(rnn_gain + col) * gg;
            u32x2 wv; wv.x = cvtpk(v.x, v.y); wv.y = cvtpk(v.z, v.w); *(u32x2*)(OA + row * 1024 + 512 + col) = wv; }
    }
    __syncthreads();
}

__device__ __forceinline__ void rnn_sample_wave(unsigned char* ws, float* out, const float* state_rnn, const float* rnn_gain, int bh, int lane) {
    const int b = bh >> 3, h = bh & 7, hc = 64 * h;
    const float* sp = state_rnn + (size_t)bh * 4096 + lane; float* op = out + O_RNNS + (size_t)bh * 4096 + lane;
    float S[64];
#pragma unroll
    for (int d = 0; d < 64; ++d) S[d] = sp[d * 64];
    const bf16* RQ = (const bf16*)(ws + WS_RQ); const bf16* RK = (const bf16*)(ws + WS_RK); const bf16* RV = (const bf16*)(ws + WS_RV); const bf16* RG = (const bf16*)(ws + WS_RG);
    const float* GL = (const float*)(ws + WS_GL); bf16* OA = (bf16*)(ws + WS_OA);
    for (int t = 0; t < DECT; ++t) {
        const size_t gi = ((size_t)MP + b * DECT + t) * 512 + hc + lane;
        const float f = __expf(GL[gi]), k = bf2f(RK[gi]), q = bf2f(RQ[gi]), v = bf2f(RV[gi]);
        float o = 0.f;
#pragma unroll
        for (int d = 0; d < 64; ++d) { const float fd = __shfl(f, d), kd = __shfl(k, d), qd = __shfl(q, d); S[d] = fd * S[d] + kd * v; o += qd * S[d]; }
        const float rs = 1.0f / sqrtf(wave_sum(o * o) * (1.f / 64.f) + EPS);
        const float y = o * rs * rnn_gain[hc + lane] * bf2f(RG[gi]);
        OA[((size_t)MP + b * DECT + t) * 1024 + 512 + hc + lane] = (unsigned short)(cvtpk(y, 0.f) & 0xffffu);
    }
#pragma unroll
    for (int d = 0; d < 64; ++d) op[d * 64] = S[d];
}


template <int RS, bool WINDOW>
__device__ __forceinline__ void samp_tile_f32(AttnSt& st, const bf16x8 (&qf)[2][2], const float* kp, int kpos0, int qpos, float sl0, float sl1, bool blocksel, LAS unsigned char* Vw, int lane, int c, int q4) {
    f32x4 s[2][4];
    const float* vb = kp + (size_t)(lane >> 4) * RS + 128 + 4 * (lane & 15);
    const float* kb = kp + (size_t)c * RS + 8 * q4;
    LAS unsigned char* vd = Vw + (lane >> 4) * KVS + 8 * (lane & 15);
    f32x4 va[4];
#define SAMP_VLOAD(B) _Pragma("unroll") for (int it = 0; it < 4; ++it) va[it] = *(const f32x4*)(vb + (size_t)(4 * (B) + it) * 4 * RS)
#define SAMP_VSTORE(B) _Pragma("unroll") for (int it = 0; it < 4; ++it) { u32x2 wv; wv.x = cvtpk(va[it].x, va[it].y); wv.y = cvtpk(va[it].z, va[it].w); *(LAS u32x2*)(vd + (4 * (B) + it) * 4 * KVS) = wv; }
#pragma unroll
    for (int kt4 = 0; kt4 < 4; ++kt4) {
        SAMP_VLOAD(kt4);
        f32x4 kl[2][2];
#pragma unroll
        for (int ks = 0; ks < 2; ++ks) { const float* p = kb + (size_t)(16 * kt4) * RS + 32 * ks; kl[ks][0] = *(const f32x4*)p; kl[ks][1] = *(const f32x4*)(p + 4); }
        const bf16x8 k0 = pack8(kl[0][0], kl[0][1]), k1 = pack8(kl[1][0], kl[1][1]);
#pragma unroll
        for (int qt2 = 0; qt2 < 2; ++qt2) s[qt2][kt4] = mfma16(k1, qf[qt2][1], mfma16(k0, qf[qt2][0], (f32x4){0.f, 0.f, 0.f, 0.f}));
        SAMP_VSTORE(kt4);
        asm volatile("" ::: "memory");
    }
#undef SAMP_VLOAD
#undef SAMP_VSTORE
#pragma unroll
    for (int qt2 = 0; qt2 < 2; ++qt2)
#pragma unroll
        for (int kt4 = 0; kt4 < 4; ++kt4)
#pragma unroll
            for (int e = 0; e < 4; ++e) { const int dist = qpos - (kpos0 + 16 * kt4 + 4 * q4 + e);
                const bool ok = WINDOW ? (dist >= 0 && dist < 512) : (blocksel && dist >= 0);
                s[qt2][kt4][e] = ok ? s[qt2][kt4][e] * SL2 - (qt2 ? sl1 : sl0) * (float)dist : -__builtin_inff(); }
    attn_update(st, s, Vw, c, q4);
}
__device__ __forceinline__ void samp_tile_new(AttnSt& st, const bf16x8 (&qf)[2][2], const bf16* base  , int ti, float sl0, float sl1, bool blocksel, LAS unsigned char* Vw, int lane, int c, int q4) {
    bf16x8 kf[2]; const bf16x8 z8 = (bf16x8){0, 0, 0, 0, 0, 0, 0, 0};
#pragma unroll
    for (int ks = 0; ks < 2; ++ks) kf[ks] = (c < 8) ? *(const bf16x8*)(base + (size_t)c * 256 + 32 * ks + 8 * q4) : z8;
#pragma unroll
    for (int it = 0; it < 8; ++it) { const int idx = it * 64 + lane, row = idx >> 3, pc = idx & 7;
        const u32x4 v = (row < 8) ? *(const u32x4*)(base + (size_t)row * 256 + 128 + 8 * pc) : (u32x4){0u, 0u, 0u, 0u};
        *(LAS u32x4*)(Vw + row * KVS + 16 * pc) = v; }
    f32x4 s[2][4];
#pragma unroll
    for (int qt2 = 0; qt2 < 2; ++qt2) { s[qt2][0] = mfma16(kf[1], qf[qt2][1], mfma16(kf[0], qf[qt2][0], (f32x4){0.f, 0.f, 0.f, 0.f}));
#pragma unroll
        for (int kt4 = 1; kt4 < 4; ++kt4) s[qt2][kt4] = (f32x4){-__builtin_inff(), -__builtin_inff(), -__builtin_inff(), -__builtin_inff()};
#pragma unroll
        for (int e = 0; e < 4; ++e) { const int key = 4 * q4 + e, dist = ti - key;
            const bool ok = key < 8 && dist >= 0 && blocksel;
            s[qt2][0][e] = ok ? s[qt2][0][e] * SL2 - (qt2 ? sl1 : sl0) * (float)dist : -__builtin_inff(); } }
    attn_update(st, s, Vw, c, q4);
}

constexpr int SA_V = 0, SA_PART = 8 * KVT  , SA_ML = SA_PART + 65536, SA_IMP = SA_ML + 2048, SA_SM = SA_IMP + 1024, SA_END = SA_SM + 64;
static_assert(SA_END <= LDS_CTLW, "sample attention LDS");
__device__ __forceinline__ void samp_attn_unit(LAS unsigned char* lds, unsigned char* ws, const float* cache_kv, const float* cache_win, const int* page_table, const float* attn_gain, int unit, int tid) {
    const int lane = tid & 63, w = __builtin_amdgcn_readfirstlane(tid >> 6), c = lane & 15, q4 = lane >> 4;
    const int b = unit >> 1, g = unit & 1, ti = c & 7;
    const size_t srow = (size_t)MP + (size_t)b * DECT;
    float slope2[2]; int headq[2];
#pragma unroll
    for (int qt2 = 0; qt2 < 2; ++qt2) { headq[qt2] = 4 * g + 2 * qt2 + (c >> 3); slope2[qt2] = __builtin_amdgcn_exp2f(-(float)(headq[qt2] + 1)) * LOG2E; }
    const int qpos = PAST + ti;
    bf16x8 qf[2][2];
    { const bf16* Q = (const bf16*)(ws + WS_Q);
#pragma unroll
      for (int qt2 = 0; qt2 < 2; ++qt2)
#pragma unroll
          for (int ks = 0; ks < 2; ++ks) qf[qt2][ks] = *(const bf16x8*)(Q + (srow + ti) * 512 + 64 * headq[qt2] + 32 * ks + 8 * q4); }
    LAS unsigned char* Vw = lds + SA_V + w * KVT;
    LAS float* PART = (LAS float*)(lds + SA_PART); LAS float* ML = (LAS float*)(lds + SA_ML); LAS float* IMP = (LAS float*)(lds + SA_IMP);
    LAS unsigned long long* SM = (LAS unsigned long long*)(lds + SA_SM);
    const int frow = tid >> 4, fseg = tid & 15;

    auto write_partial = [&](AttnSt& st) {
#pragma unroll
        for (int qt2 = 0; qt2 < 2; ++qt2) { float l = st.l[qt2]; l += __shfl_xor(l, 16); l += __shfl_xor(l, 32);
            if (q4 == 0) { ML[(w * 32 + 16 * qt2 + c) * 2] = st.m[qt2]; ML[(w * 32 + 16 * qt2 + c) * 2 + 1] = l; }
#pragma unroll
            for (int dt = 0; dt < 4; ++dt) *(LAS f32x4*)(PART + (w * 32 + 16 * qt2 + c) * 64 + 16 * dt + 4 * q4) = st.o[dt][qt2]; }
    };
    auto combine = [&]() -> f32x4 {
        float M = -__builtin_inff();
#pragma unroll
        for (int ww = 0; ww < 8; ++ww) M = fmaxf(M, ML[(ww * 32 + frow) * 2]);
        float L = 0.f; f32x4 o = (f32x4){0.f, 0.f, 0.f, 0.f};
#pragma unroll
        for (int ww = 0; ww < 8; ++ww) { const float mw = ML[(ww * 32 + frow) * 2]; const float wgt = (mw == -__builtin_inff()) ? 0.f : __builtin_amdgcn_exp2f(mw - M);
            L += ML[(ww * 32 + frow) * 2 + 1] * wgt; o = o + *(LAS const f32x4*)(PART + (ww * 32 + frow) * 64 + 4 * fseg) * wgt; }
        return o * (L > 0.f ? 1.0f / L : 0.f);
    };

    f32x4 o_cmp;
    {
        const float* kc = (const float*)(ws + WS_KCMP) + ((size_t)(256 + b * 32) * 2 + g) * 64;
        const float* vc = (const float*)(ws + WS_VCMP) + ((size_t)(256 + b * 32) * 2 + g) * 64;
        bf16x8 kf[2][2];
#pragma unroll
        for (int kt4 = 0; kt4 < 2; ++kt4)
#pragma unroll
            for (int ks = 0; ks < 2; ++ks) { const float* p = kc + (size_t)(16 * kt4 + c) * 128 + 32 * ks + 8 * q4; kf[kt4][ks] = pack8(*(const f32x4*)p, *(const f32x4*)(p + 4)); }
#pragma unroll
        for (int it = 0; it < 16; ++it) { const int idx = it * 64 + lane, row = idx >> 4, pc = idx & 15;
            const f32x4 v = (row < 32) ? *(const f32x4*)(vc + (size_t)row * 128 + 4 * pc) : (f32x4){0.f, 0.f, 0.f, 0.f};
            u32x2 wv; wv.x = cvtpk(v.x, v.y); wv.y = cvtpk(v.z, v.w); *(LAS u32x2*)(Vw + row * KVS + 8 * pc) = wv; }
        f32x4 s[2][4]; AttnSt sc; attn_init(sc);
#pragma unroll
        for (int qt2 = 0; qt2 < 2; ++qt2) { float mx = -__builtin_inff();
#pragma unroll
            for (int kt4 = 0; kt4 < 2; ++kt4) { s[qt2][kt4] = mfma16(kf[kt4][1], qf[qt2][1], mfma16(kf[kt4][0], qf[qt2][0], (f32x4){0.f, 0.f, 0.f, 0.f}));
#pragma unroll
                for (int e = 0; e < 4; ++e) { const int dist = qpos - (64 * (16 * kt4 + 4 * q4 + e) + 63); const float x = s[qt2][kt4][e] * SL2 - slope2[qt2] * (float)dist; s[qt2][kt4][e] = x; mx = fmaxf(mx, x); } }
            s[qt2][2] = (f32x4){0.f, 0.f, 0.f, 0.f}; s[qt2][3] = (f32x4){0.f, 0.f, 0.f, 0.f};
            mx = fmaxf(mx, __shfl_xor(mx, 16)); mx = fmaxf(mx, __shfl_xor(mx, 32)); float ls = 0.f;
#pragma unroll
            for (int kt4 = 0; kt4 < 2; ++kt4)
#pragma unroll
                for (int e = 0; e < 4; ++e) { const float p = __builtin_amdgcn_exp2f(s[qt2][kt4][e] - mx); s[qt2][kt4][e] = p; ls += p; }
            ls += __shfl_xor(ls, 16); ls += __shfl_xor(ls, 32); const float il = 1.0f / ls;
            s[qt2][0] = s[qt2][0] * il; s[qt2][1] = s[qt2][1] * il; }
#pragma unroll
        for (int kt4 = 0; kt4 < 2; ++kt4) { f32x4 a = s[0][kt4] + s[1][kt4];
#pragma unroll
            for (int e = 0; e < 4; ++e) a[e] += __shfl_xor(a[e], 8);
            if (w == 0 && c < 8) *(LAS f32x4*)(IMP + c * 32 + 16 * kt4 + 4 * q4) = a; }
        attn_pv(sc.o, s, Vw, c, q4);
        if (w == 0) {
#pragma unroll
            for (int qt2 = 0; qt2 < 2; ++qt2)
#pragma unroll
                for (int dt = 0; dt < 4; ++dt) *(LAS f32x4*)(PART + (16 * qt2 + c) * 64 + 16 * dt + 4 * q4) = sc.o[dt][qt2]; }
    }
    __syncthreads();
    o_cmp = *(LAS const f32x4*)(PART + frow * 64 + 4 * fseg);
    {
        bool sel = false; const int j = lane;
        if (j == 0 || j == 32) sel = true;
        else if (j < 32) { const float vj = IMP[w * 32 + j]; int cnt = 0;
            for (int i = 1; i < 32; ++i) { const float vi = IMP[w * 32 + i]; cnt += (vi > vj || (vi == vj && i < j)) ? 1 : 0; }
            sel = cnt < 14; }
        const unsigned long long bm = __ballot(sel);
        if (lane == 0) SM[w] = bm;
    }
    __syncthreads();
    const unsigned long long mymask = SM[ti];
    unsigned long long um = 0ull;
#pragma unroll
    for (int i = 0; i < 8; ++i) um |= SM[i];
    um = ((unsigned long long)__builtin_amdgcn_readfirstlane((unsigned)(um >> 32)) << 32) | (unsigned)__builtin_amdgcn_readfirstlane((unsigned)um);
    f32x4 o_win, o_sel;
    {
        AttnSt st; attn_init(st);
        const float* wb = cache_win + (size_t)b * 512 * 256 + 64 * g;
        samp_tile_f32<256, true>(st, qf, wb + (size_t)(64 * w) * 256, PAST - 512 + 64 * w, qpos, slope2[0], slope2[1], true, Vw, lane, c, q4);
        if (w == 0) samp_tile_new(st, qf, (const bf16*)(ws + WS_KW) + srow * 256 + 64 * g, ti, slope2[0], slope2[1], true, Vw, lane, c, q4);
        write_partial(st);
    }
    __syncthreads();
    o_win = combine();
    __syncthreads();
    {
        AttnSt st; attn_init(st);
        unsigned long long rem = um; int idx = 0;
        while (rem) { const int j = __builtin_ctzll(rem); rem &= rem - 1;
            if ((idx & 7) == w) {
                const bool bit = (mymask >> j) & 1ull;
                if (j < 32) { const int page = page_table[b * NPAGES + (j >> 1)];
                    samp_tile_f32<512, false>(st, qf, cache_kv + ((size_t)page * PAGE + (j & 1) * 64) * 512 + 256 + 64 * g, 64 * j, qpos, slope2[0], slope2[1], bit, Vw, lane, c, q4); }
                else samp_tile_new(st, qf, (const bf16*)(ws + WS_KS) + srow * 256 + 64 * g, ti, slope2[0], slope2[1], bit, Vw, lane, c, q4);
            }
            ++idx; }
        write_partial(st);
    }
    __syncthreads();
    o_sel = combine();
    {
        const int qt2 = frow >> 4, cc = frow & 15, head = 4 * g + 2 * qt2 + (cc >> 3); const size_t row = srow + (cc & 7);
        const float* GATES = (const float*)(ws + WS_GATES);
        const float g0 = GATES[row * 24 + head * 3], g1 = GATES[row * 24 + head * 3 + 1], g2 = GATES[row * 24 + head * 3 + 2];
        const f32x4 oa = o_cmp * g0 + o_sel * g1 + o_win * g2;
        float ss = (oa.x * oa.x + oa.y * oa.y) + (oa.z * oa.z + oa.w * oa.w);
        ss += __shfl_xor(ss, 1); ss += __shfl_xor(ss, 2); ss += __shfl_xor(ss, 4); ss += __shfl_xor(ss, 8);
        const float rs = 1.0f / sqrtf(ss * (1.f / 64.f) + EPS);
        const f32x4 v = oa * rs * *(const f32x4*)(attn_gain + 64 * head + 4 * fseg);
        u32x2 wv; wv.x = cvtpk(v.x, v.y); wv.y = cvtpk(v.z, v.w); *(u32x2*)((bf16*)(ws + WS_OA) + row * 1024 + 64 * head + 4 * fseg) = wv;
    }
    __syncthreads();
}

#define EPI_ROWS _Pragma("unroll") for (int ai = 0; ai < 2; ++ai) _Pragma("unroll") for (int m = 0; m < 4; ++m)
#define EPI_COLS _Pragma("unroll") for (int bj = 0; bj < 2; ++bj) _Pragma("unroll") for (int n = 0; n < 2; ++n)
struct EpiOut {
    float* out; unsigned char* ws; const float *xp, *xs, *ln_mlp;
    __device__ __forceinline__ void operator()(const f32x4 (&acc)[2][2][4][2], const pg8::Unit& u, int wr, int wc, int fr, int fq) const {
        const int rowb = u.pm * 256 + wr * 64 + fr, colb = u.pn * 256 + 32 * wc + 4 * fq;
        bf16* const HB = (bf16*)(ws + WS_XN); float* const ssq = (float*)(ws + CTL_SSQ);
        f32x4 g[2][2];
        EPI_COLS g[bj][n] = *(const f32x4*)(ln_mlp + colb + 128 * bj + 16 * n);
        EPI_ROWS { const int row = rowb + 128 * ai + 16 * m; const float* xr = (row < MP) ? xp + (size_t)row * DM : xs + (size_t)(row - MP) * DM; float ss = 0.f;
            EPI_COLS { const int col = colb + 128 * bj + 16 * n; const f32x4 h = acc[ai][bj][m][n] + *(const f32x4*)(xr + col);
                ss += (h.x * h.x + h.y * h.y) + (h.z * h.z + h.w * h.w);
                *(f32x4*)(out + (size_t)row * DM + col) = h;
                const f32x4 hg = h * g[bj][n]; u32x2 w; w.x = cvtpk(hg.x, hg.y); w.y = cvtpk(hg.z, hg.w); *(u32x2*)(HB + (size_t)row * DM + col) = w; }
            ss += __shfl_xor(ss, 16); ss += __shfl_xor(ss, 32);
            if (fq == 0) atomicAdd(ssq + row, ss); }
    }
};
struct EpiUp {
    unsigned char* ws;
    __device__ __forceinline__ void operator()(const f32x4 (&acc)[2][2][4][2], const pg8::Unit& u, int wr, int wc, int fr, int fq) const {
        const int rowb = u.pm * 256 + wr * 64 + fr, colb = u.pn * 256 + 32 * wc + 4 * fq;
        bf16* const U = (bf16*)(ws + WS_U); const float* const ssq = (const float*)(ws + CTL_SSQ);
        EPI_ROWS { const int row = rowb + 128 * ai + 16 * m; const float rs = 1.0f / sqrtf(ssq[row] * (1.f / DM) + EPS);
            EPI_COLS { const int col = colb + 128 * bj + 16 * n; f32x4 v = acc[ai][bj][m][n] * rs;
                v.x = fmaxf(v.x, 0.f); v.y = fmaxf(v.y, 0.f); v.z = fmaxf(v.z, 0.f); v.w = fmaxf(v.w, 0.f); v = v * v;
                u32x2 w; w.x = cvtpk(v.x, v.y); w.y = cvtpk(v.z, v.w); *(u32x2*)(U + (size_t)row * DFF + col) = w; } }
    }
};
struct EpiDown {
    float* out;
    __device__ __forceinline__ void operator()(const f32x4 (&acc)[2][2][4][2], const pg8::Unit& u, int wr, int wc, int fr, int fq) const {
        const int rowb = u.pm * 256 + wr * 64 + fr, colb = u.pn * 256 + 32 * wc + 4 * fq;
        EPI_ROWS { const int row = rowb + 128 * ai + 16 * m;
            EPI_COLS { float* p = out + (size_t)row * DM + colb + 128 * bj + 16 * n; *(f32x4*)p = *(const f32x4*)p + acc[ai][bj][m][n]; } }
    }
};
#undef EPI_ROWS
#undef EPI_COLS

template <int WM, int WN, int NWM, int NWN, int UNR, class Epi>
__device__ __forceinline__ void small_gemm_tile(const bf16* A, int lda, const bf16* Bt, int ldb, int K, int row0, int col0, const Epi& E, int tid) {
    const int lane = tid & 63, w = __builtin_amdgcn_readfirstlane(tid >> 6), wm = w / NWN, wn = w % NWN, fr = lane & 15, fq = lane >> 4;
    const bf16* ap = A + (size_t)(row0 + 16 * WM * wm + fr) * lda + 8 * fq;
    const bf16* bp = Bt + (size_t)(col0 + 16 * WN * wn + fr) * ldb + 8 * fq;
    f32x4 acc[WM][WN];
#pragma unroll
    for (int mt = 0; mt < WM; ++mt)
#pragma unroll
        for (int nt = 0; nt < WN; ++nt) acc[mt][nt] = (f32x4){0.f, 0.f, 0.f, 0.f};
    bf16x8 a0[UNR][WM], b0[UNR][WN], a1[UNR][WM], b1[UNR][WN];
#define SG_LOAD(A_, B_, kk) do { _Pragma("unroll") for (int u = 0; u < UNR; ++u) { \
        _Pragma("unroll") for (int mt = 0; mt < WM; ++mt) A_[u][mt] = *(const bf16x8*)(ap + (size_t)(16 * mt) * lda + (kk) + 32 * u); \
        _Pragma("unroll") for (int nt = 0; nt < WN; ++nt) B_[u][nt] = *(const bf16x8*)(bp + (size_t)(16 * nt) * ldb + (kk) + 32 * u); } } while (0)
#define SG_MMA(A_, B_) do { _Pragma("unroll") for (int u = 0; u < UNR; ++u) _Pragma("unroll") for (int mt = 0; mt < WM; ++mt) _Pragma("unroll") for (int nt = 0; nt < WN; ++nt) \
        acc[mt][nt] = mfma16(B_[u][nt], A_[u][mt], acc[mt][nt]); } while (0)
    SG_LOAD(a0, b0, 0);
    for (int k = 0; k < K; k += 64 * UNR) {
        SG_LOAD(a1, b1, k + 32 * UNR);
        SG_MMA(a0, b0);
        if (k + 64 * UNR < K) SG_LOAD(a0, b0, k + 64 * UNR);
        SG_MMA(a1, b1);
    }
#undef SG_LOAD
#undef SG_MMA
    E(acc, row0 + 16 * WM * wm + fr, col0 + 16 * WN * wn + 4 * fq);
}
struct SEpiOut {
    float* out; unsigned char* ws; const float *xs, *ln_mlp;
    template <int WM, int WN> __device__ __forceinline__ void operator()(const f32x4 (&acc)[WM][WN], int row, int col) const {
        bf16* const HB = (bf16*)(ws + WS_XN); float* const ssq = (float*)(ws + CTL_SSQ);
#pragma unroll
        for (int mt = 0; mt < WM; ++mt) { const int r = row + 16 * mt; float ss = 0.f;
#pragma unroll
            for (int nt = 0; nt < WN; ++nt) { const int cc = col + 16 * nt; const f32x4 h = acc[mt][nt] + *(const f32x4*)(xs + (size_t)(r - MP) * DM + cc);
                ss += (h.x * h.x + h.y * h.y) + (h.z * h.z + h.w * h.w);
                *(f32x4*)(out + (size_t)r * DM + cc) = h;
                const f32x4 hg = h * *(const f32x4*)(ln_mlp + cc); u32x2 wv; wv.x = cvtpk(hg.x, hg.y); wv.y = cvtpk(hg.z, hg.w); *(u32x2*)(HB + (size_t)r * DM + cc) = wv; }
            ss += __shfl_xor(ss, 16); ss += __shfl_xor(ss, 32);
            if ((threadIdx.x & 63) < 16) atomicAdd(ssq + r, ss); }
    }
};
struct SEpiUp {
    unsigned char* ws;
    template <int WM, int WN> __device__ __forceinline__ void operator()(const f32x4 (&acc)[WM][WN], int row, int col) const {
        bf16* const U = (bf16*)(ws + WS_U); const float* const ssq = (const float*)(ws + CTL_SSQ);
#pragma unroll
        for (int mt = 0; mt < WM; ++mt) { const int r = row + 16 * mt; const float rs = 1.0f / sqrtf(ssq[r] * (1.f / DM) + EPS);
#pragma unroll
            for (int nt = 0; nt < WN; ++nt) { f32x4 v = acc[mt][nt] * rs; v.x = fmaxf(v.x, 0.f); v.y = fmaxf(v.y, 0.f); v.z = fmaxf(v.z, 0.f); v.w = fmaxf(v.w, 0.f); v = v * v;
                u32x2 wv; wv.x = cvtpk(v.x, v.y); wv.y = cvtpk(v.z, v.w); *(u32x2*)(U + (size_t)r * DFF + col + 16 * nt) = wv; } }
    }
};
struct SEpiDown {
    float* out;
    template <int WM, int WN> __device__ __forceinline__ void operator()(const f32x4 (&acc)[WM][WN], int row, int col) const {
#pragma unroll
        for (int mt = 0; mt < WM; ++mt)
#pragma unroll
            for (int nt = 0; nt < WN; ++nt) { float* p = out + (size_t)(row + 16 * mt) * DM + col + 16 * nt; *(f32x4*)p = *(const f32x4*)p + acc[mt][nt]; }
    }
};

#ifdef MK_DEBUG
constexpr size_t CTL_DBG = 256 * 1024;
__device__ __forceinline__ void dbg_report(unsigned char* ws, float num, float den) { if (!(num >= 0.f)) num = 1e30f; atomicAdd((float*)(ws + CTL_DBG), num); atomicAdd((float*)(ws + CTL_DBG) + 1, den); }
__global__ void dbg_final(Args a) { const float n = *(const float*)(a.ws + CTL_DBG), d = *((const float*)(a.ws + CTL_DBG) + 1); a.out[O_RNNP] = 100.f + 1e7f * (n / (d + 1e-30f)); }
__global__ void __launch_bounds__(256) dbg_check_p1(Args a) {
    __shared__ float xs[1024]; __shared__ float z[3352]; __shared__ float red[256];
    const int nsamp = gridDim.x; const int tid = threadIdx.x;
    const int row = (int)(((long)blockIdx.x * 7919 * 131 + 37 * blockIdx.x) % MT);
    const float* x = row < MP ? a.in[0] + (size_t)row * DM : a.in[1] + (size_t)(row - MP) * DM;
    float ss = 0.f; for (int i = tid; i < 1024; i += 256) { const float v = x[i]; ss += v * v; }
    red[tid] = ss; __syncthreads(); for (int o = 128; o > 0; o >>= 1) { if (tid < o) red[tid] += red[tid + o]; __syncthreads(); }
    const float rs = 1.0f / sqrtf(red[0] / 1024.f + EPS);
    for (int i = tid; i < 1024; i += 256) xs[i] = x[i] * rs * a.in[6][i];
    __syncthreads();
    const float* w = a.in[7];
    for (int c = tid; c < 3352; c += 256) { float acc = 0.f; for (int k = 0; k < 1024; ++k) acc += xs[k] * w[(size_t)k * 3352 + c]; z[c] = acc; }
    __syncthreads();
    unsigned char* ws = a.ws; float num = 0.f, den = 0.f;
    auto cmp = [&](float got, float exp) { const float e = got - exp; num += e * e; den += exp * exp; };
    auto headrs = [&](int c0) { float s = 0.f; for (int d = 0; d < 64; ++d) s += z[c0 + d] * z[c0 + d]; return 1.0f / sqrtf(s / 64.f + EPS); };
    const float* kvout = row < MP ? a.out + O_KVP + (size_t)row * 512 : a.out + O_KVS + (size_t)(row - MP) * 512;
    const float* lbp = (const float*)(ws + WS_LB);
    for (int c = tid; c < 3352; c += 256) {
        if (c < 512) { const float r = headrs(c & ~63); cmp(bf2f(((const bf16*)(ws + WS_Q))[(size_t)row * 512 + c]), z[c] * r * a.in[8][c & 63]); }
        else if (c < 768) { cmp(kvout[c - 512], z[c]); if (row < MP) cmp(bf2f(((const bf16*)(ws + WS_KC))[(size_t)row * 256 + c - 512]), z[c] + a.in[10][((c - 512) >> 7) * 4096 + (row & 63) * 64 + (c & 63)]); }
        else if (c < 1024) { float e = z[c]; if (c < 896) e *= headrs(c & ~63) * a.in[9][64 + (c & 63)]; cmp(kvout[c - 512], e); cmp(bf2f(((const bf16*)(ws + WS_KS))[(size_t)row * 256 + c - 768]), e); }
        else if (c < 1280) { float e = z[c]; if (c < 1152) e *= headrs(c & ~63) * a.in[9][128 + (c & 63)]; cmp(bf2f(((const bf16*)(ws + WS_KW))[(size_t)row * 256 + c - 1024]), e);
            if (row >= MP) { const int r_ = row - MP; cmp(a.out[O_WINS + ((size_t)(r_ >> 3) * 512 + 504 + (r_ & 7)) * 256 + c - 1024], e); }
            else if ((row & 4095) >= 3584) cmp(a.out[O_WINP + ((size_t)(row >> 12) * 512 + (row & 4095) - 3584) * 256 + c - 1024], e); }
        else if (c < 1304) cmp(((const float*)(ws + WS_GATES))[(size_t)row * 24 + c - 1280], 1.f / (1.f + expf(-z[c])));
        else if (c < 1816) cmp(bf2f(((const bf16*)(ws + WS_RQ))[(size_t)row * 512 + c - 1304]), z[c] / (1.f + expf(-z[c])));
        else if (c < 2328) { const float l = lbp[c - 1816], f = l + (1.f - l) / (1.f + expf(-z[c])); cmp(((const float*)(ws + WS_GL))[(size_t)row * 512 + c - 1816], logf(f)); cmp(bf2f(((const bf16*)(ws + WS_RK))[(size_t)row * 512 + c - 1816]), 1.f - f); }
        else if (c < 2840) cmp(bf2f(((const bf16*)(ws + WS_RV))[(size_t)row * 512 + c - 2328]), z[c]);
        else cmp(bf2f(((const bf16*)(ws + WS_RG))[(size_t)row * 512 + c - 2840]), z[c] / (1.f + expf(-z[c])));
    }
    if (tid < 512 && blockIdx.x == 0) { const float l0 = a.in[14][tid], l1 = a.in[14][512 + tid]; const float e0 = expf(l0), e1 = expf(l1); cmp(lbp[tid], e0 / (e0 + e1)); if (tid + 256 < 512) { const float m0 = a.in[14][tid + 256], m1 = a.in[14][768 + tid]; cmp(lbp[tid + 256], expf(m0) / (expf(m0) + expf(m1))); } }
    (void)nsamp;
    red[tid] = num; __syncthreads(); for (int o = 128; o > 0; o >>= 1) { if (tid < o) red[tid] += red[tid + o]; __syncthreads(); } num = red[0]; __syncthreads();
    red[tid] = den; __syncthreads(); for (int o = 128; o > 0; o >>= 1) { if (tid < o) red[tid] += red[tid + o]; __syncthreads(); } den = red[0];
    if (tid == 0) dbg_report(ws, num, den);
}
#endif

constexpr int NPHASE = 7;
__global__ void __launch_bounds__(512, 2) mega(Args args) {
    extern __shared__ __attribute__((aligned(16))) unsigned char lds_raw[];
    LAS unsigned char* lds = (LAS unsigned char*)lds_raw;
    const int tid = threadIdx.x, lane = tid & 63, wave = __builtin_amdgcn_readfirstlane(tid >> 6);
    const int G = gridDim.x, bx = blockIdx.x;
    unsigned char* ws = args.ws;
    const int lo = args.ph_lo, hi = args.ph_hi;
#define IN(k) (lo <= (k) && (k) < hi)
#define GRID_BAR_CG() do { cg::this_grid().sync(); } while (0)
#define GRID_BAR() do { xcd_barrier(xbar); } while (0)
    if (tid < 16) ((LAS unsigned*)(lds + LDS_CTLW))[tid] = 0u;
    __syncthreads();
    XcdBarrier xbar; xbar.bar = (unsigned*)(ws + WS_CTL + CTL_BAR); xbar.x = 0; xbar.st = (volatile LAS unsigned*)(lds + LDS_CTLW);
    if (hi - lo > 1) xbar = xcd_barrier_post((unsigned*)(ws + WS_CTL + CTL_BAR), (volatile LAS unsigned*)(lds + LDS_CTLW));

    if (IN(0)) {
        LAS float* scr = (LAS float*)(lds + wave * 16384);
        const int gw = bx * 8 + wave, NGW = G * 8;
        const float* w_in = args.in[7]; const float* w_out = args.in[16]; const float* w_up = args.in[18]; const float* w_down = args.in[19];
        const float* cw1 = args.in[11]; const float* cw2 = args.in[12];
        constexpr int I_IN = 16 * 105, I_O = 16 * 32, I_U = 16 * 128, I_D = 64 * 32, I_1 = 64 * 4, I_2 = 2 * 2;
        constexpr int NITEMS = I_IN + I_O + I_U + I_D + 2 * I_1 + 2 * I_2;
        for (int it = gw; it < NITEMS; it += NGW) {
            int r = it;
            if (r < I_IN) { p0_transpose_item<1>(w_in, DM, INW, (bf16*)(ws + WS_WIN), scr, r, lane); continue; } r -= I_IN;
            if (r < I_O) { p0_transpose_item<0>(w_out, DM, DM, (bf16*)(ws + WS_WO), scr, r, lane); continue; } r -= I_O;
            if (r < I_U) { p0_transpose_item<0>(w_up, DM, DFF, (bf16*)(ws + WS_WU), scr, r, lane); continue; } r -= I_U;
            if (r < I_D) { p0_transpose_item<0>(w_down, DFF, DM, (bf16*)(ws + WS_WD), scr, r, lane); continue; } r -= I_D;
            if (r < 2 * I_1) { const int kv = r / I_1; p0_transpose_item<0>(cw1 + (size_t)kv * 4096 * 128, 4096, 128, (bf16*)(ws + WS_W1) + (size_t)kv * 128 * 4096, scr, r % I_1, lane); continue; } r -= 2 * I_1;
            { const int kv = r / I_2; p0_transpose_item<0>(cw2 + (size_t)kv * 128 * 64, 128, 64, (bf16*)(ws + WS_W2) + (size_t)kv * 64 * 128, scr, r % I_2, lane); }
        }
        const float* xp = args.in[0]; const float* xs = args.in[1]; const float* ln_mix = args.in[6];
        for (int m = gw; m < MT; m += NGW) rms_row_to_bf16(m < MP ? xp + (size_t)m * DM : xs + (size_t)(m - MP) * DM, ln_mix, (bf16*)(ws + WS_XN) + (size_t)m * DM, lane);
        {
            const f32x4* src = (const f32x4*)args.in[3]; f32x4* dst = (f32x4*)(args.out + O_WINS);
            const size_t per_b = 504 * 64, total = (size_t)DECB * per_b;
            for (size_t i = (size_t)bx * 512 + tid; i < total; i += (size_t)G * 512) { const size_t b = i / per_b, r = i - b * per_b; dst[b * (512 * 64) + r] = src[b * (512 * 64) + 8 * 64 + r]; }
        }
        if (bx == 0) { const float* lg = args.in[14]; float* lbp = (float*)(ws + WS_LB); const float l0 = lg[tid], l1 = lg[512 + tid]; lbp[tid] = 1.0f / (1.0f + __expf(l1 - l0)); }
        if (hi > 1) GRID_BAR_CG();
    }
    if (IN(1)) {
        pg8::Gemm g{(const bf16*)(ws + WS_XN), (const bf16*)(ws + WS_WIN), MT, INP, DM};
        pg8::StaticOrder S; S.init(MT, INP, G, bx);
        EpiIn E{args.out, ws, args.in[8], args.in[9], args.in[10]};
        pg8::gemm_phase<EpiIn, true>(lds, g, S, E);
        if (hi > 2) GRID_BAR();
    }
    if (IN(2)) {
        constexpr int N_WIN = 512, N_CMP = N_CMP_ITEMS, N_HG = 128, N_RNN = 128, N2 = N_WIN + N_CMP + N_HG + N_RNN;
        for (int rep = 0; rep < REP_P2; ++rep)
        for (int it = bx; it < N2; it += G) {
            int t_ = tid; asm volatile("" : "+v"(t_));
            if (it < N_WIN) win_prompt_unit(lds, ws, it, t_);
            else if (it < N_WIN + N_CMP) compress_item(lds, ws, args.in[2], (const int*)args.in[5], args.in[10], args.in[9], it - N_WIN, t_);
            else if (it < N_WIN + N_CMP + N_HG) hgrn_local_item(lds, ws, it - N_WIN - N_CMP, t_);
            else rnn_sample_wave(ws, args.out, args.in[4], args.in[15], (it - N_WIN - N_CMP - N_HG) * 8 + __builtin_amdgcn_readfirstlane(t_ >> 6), t_ & 63);
        }
        if (hi > 3) GRID_BAR();
    }
    if (IN(3)) {
        constexpr int N_SEL = 512, N_SA = 256, N_HC = 256, N3 = N_SEL + N_SA + N_HC;
        for (int rep = 0; rep < REP_P3; ++rep)
        for (int it = bx; it < N3; it += G) {
            int t_ = tid; asm volatile("" : "+v"(t_));
            if (it < N_SEL) { const int qblk = 63 - (it >> 3), bg = it & 7; sel_prompt_unit(lds, ws, args.in[13], ((bg >> 1) << 7) | ((bg & 1) << 6) | qblk, t_); }
            else if (it < N_SEL + N_SA) samp_attn_unit(lds, ws, args.in[2], args.in[3], (const int*)args.in[5], args.in[13], it - N_SEL, t_);
            else hgrn_combine_unit(lds, ws, args.out, args.in[15], it - N_SEL - N_SA, t_);
        }
        if (hi > 4) GRID_BAR();
    }
    if (IN(4)) {
        pg8::Gemm g{(const bf16*)(ws + WS_OA), (const bf16*)(ws + WS_WO), MP, DM, DM};
        pg8::StaticOrder S; S.init(MP, DM, G, bx);
        EpiOut E{args.out, ws, args.in[0], args.in[1], args.in[17]};
        pg8::gemm_phase<EpiOut, true>(lds, g, S, E);
        {
            SEpiOut SE{args.out, ws, args.in[1], args.in[17]};
            for (int t = bx; t < 256; t += G) small_gemm_tile<1, 2, 4, 2, 4, SEpiOut>((const bf16*)(ws + WS_OA), DM, (const bf16*)(ws + WS_WO), DM, DM, MP + 64 * (t >> 4), 64 * (t & 15), SE, tid);
        }
        if (hi > 5) GRID_BAR();
    }
    if (IN(5)) {
        pg8::Gemm g{(const bf16*)(ws + WS_XN), (const bf16*)(ws + WS_WU), MP, DFF, DM};
        pg8::StaticOrder S; S.init(MP, DFF, G, bx);
        EpiUp E{ws};
        pg8::gemm_phase<EpiUp, true>(lds, g, S, E);
        {
            SEpiUp SE{ws};
            for (int t = bx; t < 256; t += G) small_gemm_tile<2, 4, 2, 4, 2, SEpiUp>((const bf16*)(ws + WS_XN), DM, (const bf16*)(ws + WS_WU), DM, DM, MP + 64 * (t >> 4), 256 * (t & 15), SE, tid);
        }
        if (hi > 6) GRID_BAR();
    }
    if (IN(6)) {
        pg8::Gemm g{(const bf16*)(ws + WS_U), (const bf16*)(ws + WS_WD), MP, DM, DFF};
        pg8::StaticOrder S; S.init(MP, DM, G, bx);
        EpiDown E{args.out};
        pg8::gemm_phase<EpiDown, true>(lds, g, S, E);
        {
            SEpiDown SE{args.out};
            for (int t = bx; t < 256; t += G) small_gemm_tile<1, 2, 4, 2, 4, SEpiDown>((const bf16*)(ws + WS_U), DFF, (const bf16*)(ws + WS_WD), DFF, DFF, MP + 64 * (t >> 4), 64 * (t & 15), SE, tid);
        }
    }
#undef IN
#undef GRID_BAR
#undef GRID_BAR_CG
}

extern "C" void kernel_launch(void* const* d_in, const int* in_sizes, int n_in, void* d_out, int out_size, void* d_ws, size_t ws_size, hipStream_t stream) {
    static int grid = 0;
    if (grid == 0) {
        int dev = 0, cus = 0, per_cu = 0;
        (void)hipGetDevice(&dev);
        (void)hipDeviceGetAttribute(&cus, hipDeviceAttributeMultiprocessorCount, dev);
        (void)hipFuncSetAttribute((const void*)mega, hipFuncAttributeMaxDynamicSharedMemorySize, LDS_BYTES);
        (void)hipOccupancyMaxActiveBlocksPerMultiprocessor(&per_cu, (const void*)mega, 512, LDS_BYTES);
        if (per_cu < 1) per_cu = 1;
        grid = cus * 1;
        if (n_in != 20 || (size_t)out_size != O_END) fprintf(stderr, "kernel_launch: unexpected shapes n_in %d out %d\n", n_in, out_size);
        (void)hipGetLastError();
    }
    (void)hipMemsetAsync((char*)d_ws + WS_CTL, 0, CTL_BYTES, stream);
    Args a{};
    for (int i = 0; i < 20; ++i) a.in[i] = (const float*)d_in[i];
    a.out = (float*)d_out; a.ws = (unsigned char*)d_ws;
#if MK_N_LAUNCHES == 1
    a.ph_lo = 0; a.ph_hi = NPHASE;
    void* kargs[] = {&a};
    hipError_t e = hipLaunchCooperativeKernel((const void*)mega, dim3(grid), dim3(512), kargs, LDS_BYTES, stream);
    if (e != hipSuccess) fprintf(stderr, "cooperative launch failed: %s (grid %d)\n", hipGetErrorString(e), grid);
#else
    for (int p = 0; p < NPHASE; ++p) { a.ph_lo = p; a.ph_hi = p + 1; hipLaunchKernelGGL(mega, dim3(grid), dim3(512), LDS_BYTES, stream, a);
#ifdef MK_DEBUG
        if (p == 1 && MK_DEBUG == 1) hipLaunchKernelGGL(dbg_check_p1, dim3(192), dim3(256), 0, stream, a);
#endif
    }
#ifdef MK_DEBUG
    hipLaunchKernelGGL(dbg_final, dim3(1), dim3(1), 0, stream, a);
#endif
#endif
}
```

```cpp
#include <hip/hip_runtime.h>
#include <hip/hip_cooperative_groups.h>
#include <cstdio>
#include <cstdint>
namespace cg = cooperative_groups;

#ifndef PROBE_A
#define PROBE_A -1
#define PROBE_B -1
#define PROBE_BLK 0
#define PROBE_E -1
#endif
#ifndef REP_P2
#define REP_P2 1
#endif
#ifndef REP_P3
#define REP_P3 1
#endif
#ifndef MK_N_LAUNCHES
#define MK_N_LAUNCHES 1
#endif

#define LAS __attribute__((address_space(3)))
typedef unsigned short bf16;
typedef short bf16x8 __attribute__((ext_vector_type(8)));
typedef short bf16x4 __attribute__((ext_vector_type(4)));
typedef float f32x4 __attribute__((ext_vector_type(4)));
typedef float f32x2 __attribute__((ext_vector_type(2)));
typedef unsigned u32x4 __attribute__((ext_vector_type(4)));
typedef unsigned u32x2 __attribute__((ext_vector_type(2)));
typedef __bf16 bf16x2_t __attribute__((ext_vector_type(2)));

constexpr int DM = 1024, BATCH = 4, SEQ = 4096, DECB = 128, DECT = 8, PAST = 2048, PAGE = 128;
constexpr int NPAGES = PAST / PAGE;
constexpr int MP = BATCH * SEQ;
constexpr int MS = DECB * DECT;
constexpr int MT = MP + MS;
constexpr int INW = 3352, INP = 3584;
constexpr int DFF = 4096;
constexpr float EPS = 1e-6f;

constexpr size_t O_YP = 0, O_YS = (size_t)MP * DM, O_KVP = O_YS + (size_t)MS * DM, O_KVS = O_KVP + (size_t)MP * 512,
                 O_WINP = O_KVS + (size_t)MS * 512, O_WINS = O_WINP + (size_t)BATCH * 512 * 256, O_RNNP = O_WINS + (size_t)DECB * 512 * 256,
                 O_RNNS = O_RNNP + (size_t)BATCH * 8 * 4096, O_END = O_RNNS + (size_t)DECB * 8 * 4096;

constexpr size_t MiB = 1u << 20;
constexpr size_t WS_CTL = 0, CTL_BYTES = 1 * MiB;
constexpr size_t CTL_SSQ = 512 * 1024;
constexpr size_t WS_WIN = 1 * MiB;
constexpr size_t WS_WO = WS_WIN + 7 * MiB;
constexpr size_t WS_WU = WS_WO + 2 * MiB;
constexpr size_t WS_WD = WS_WU + 8 * MiB;
constexpr size_t WS_W1 = WS_WD + 8 * MiB;
constexpr size_t WS_W2 = WS_W1 + 2 * MiB;
constexpr size_t WS_LB = WS_W2 + 64 * 1024;
constexpr size_t WS_XN = 32 * MiB;
constexpr size_t WS_Q = 68 * MiB;
constexpr size_t WS_KC = 86 * MiB;
constexpr size_t WS_KS = 95 * MiB;
constexpr size_t WS_KW = 104 * MiB;
constexpr size_t WS_RQ = 113 * MiB, WS_RK = 131 * MiB, WS_RV = 149 * MiB, WS_RG = 167 * MiB;   static_assert(WS_RV - WS_RK == WS_RK - WS_RQ && WS_RG - WS_RV == WS_RK - WS_RQ, "equal spacing");
constexpr size_t WS_GL = 185 * MiB;
constexpr size_t WS_GATES = 220 * MiB;
constexpr size_t WS_OWIN = 224 * MiB;
constexpr size_t WS_OA = 242 * MiB;
constexpr size_t WS_U = 280 * MiB;
constexpr size_t WS_KCMP = 420 * MiB;
constexpr size_t WS_VCMP = 424 * MiB;
constexpr size_t WS_OLOC = 428 * MiB;
constexpr size_t WS_QH = 462 * MiB;
constexpr size_t WS_TSC = 480 * MiB;
constexpr size_t WS_DSC = 489 * MiB;
constexpr size_t WS_END1 = 490 * MiB;

constexpr int RING_BYTES = 131072;
constexpr int LDS_BYTES = 147456;
constexpr int LDS_CTLW = LDS_BYTES - 320; constexpr int LDS_STAMPS = LDS_BYTES - 256;

__device__ __forceinline__ unsigned cvtpk(float lo, float hi) { f32x2 v = {lo, hi}; bf16x2_t b = __builtin_convertvector(v, bf16x2_t); return __builtin_bit_cast(unsigned, b); }
__device__ __forceinline__ float bf2f(unsigned short b) { return __builtin_bit_cast(float, ((unsigned)b) << 16); }
__device__ __forceinline__ float wave_sum(float v) {
#pragma unroll
    for (int o = 1; o < 64; o <<= 1) v += __shfl_xor(v, o);
    return v;
}
__device__ __forceinline__ float sigmoidf_(float x) { return __builtin_amdgcn_rcpf(1.0f + __expf(-x)); }
__device__ __forceinline__ float siluf_(float x) { return x * __builtin_amdgcn_rcpf(1.0f + __expf(-x)); }
#define LDS_WAIT() asm volatile("s_waitcnt lgkmcnt(0)" ::: "memory")

namespace pg8 {
constexpr int BM = 256, BK = 64, HALF = 128, HTB = HALF * BK * 2, STAGE_BYTES = 8 * HTB, NXCD = 8, WGM = 8;
__host__ __device__ __forceinline__ int lds_byte(int r, int c) { const int st = (r >> 4) * 2 + (c >> 5), rr = r & 15, cc = c & 31, ob = rr * 64 + cc * 2; return st * 1024 + (ob ^ (((ob >> 9) & 1) << 5)); }
__host__ __device__ __forceinline__ void stage_rc(int b, int& R, int& C) { const int st = b / 1024, sb = b % 1024, swz = sb ^ (((sb >> 9) & 1) << 5); R = (st >> 1) * 16 + swz / 64; C = (st & 1) * 32 + (swz % 64) / 2; }
struct Unit { int pm, pn; };
struct Gemm { const bf16* A; const bf16* Bt; int M, N, K; };
struct StaticOrder {
    int nM, nN, nwg, G, c;
    __host__ __device__ void init(int M, int N, int G_, int c_) { nM = M / BM; nN = N / BM; nwg = nM * nN; G = G_; c = c_; }
    __host__ __device__ bool next(int i, Unit& u) const {
        const long L = (long)i * G + c; if (L >= nwg) return false;
        int wgid = (int)L; { const int q = nwg / NXCD, r = nwg % NXCD, xcd = wgid % NXCD, off = wgid / NXCD; wgid = (xcd < r ? xcd * (q + 1) : r * (q + 1) + (xcd - r) * q) + off; }
        const int nig = WGM * nN, gid = wgid / nig, fm = gid * WGM, gsz = (nM - fm) < WGM ? (nM - fm) : WGM;
        u.pm = fm + ((wgid % nig) % gsz); u.pn = (wgid % nig) / gsz; return true;
    }
};
template <class Epi, bool ALIGN_EPI = true>
__device__ __forceinline__ void gemm_phase(LAS unsigned char* lds, const Gemm g, const StaticOrder& S, const Epi& E) {
    const int tid = threadIdx.x, wid = __builtin_amdgcn_readfirstlane(tid >> 6), lane = tid & 63, wr = wid >> 2, wc = wid & 3, fr = lane & 15, fq = lane >> 4;
    const int K = g.K, nt = K / BK;
    unsigned voffA[2], voffB[2];
#pragma unroll
    for (int i = 0; i < 2; ++i) { int R, C; stage_rc(tid * 16 + i * 8192, R, C); voffA[i] = (unsigned)(R * K + C) * 2u; voffB[i] = voffA[i]; }
    const size_t kstep = (size_t)(BK * 2);
    const size_t hstep = (size_t)HALF * K * 2;
    const size_t tstep = 2 * hstep;
    const unsigned ldsw = (unsigned)wid * 1024u;
    const int aoff = lds_byte(wr * 64 + fr, fq * 8), boff = lds_byte(wc * 32 + fr, fq * 8);
#define PG8_SA(b, h) (((b) * 2 + (h)) * HTB)
#define PG8_SB(b, h) ((4 + (b) * 2 + (h)) * HTB)
#define PG8_STAGE(bufoff, gbase, voff) do { _Pragma("unroll") for (int _i = 0; _i < 2; ++_i) \
        __builtin_amdgcn_global_load_lds((const unsigned*)((const char*)(gbase) + (voff)[_i]), (LAS unsigned*)(lds + (bufoff) + ldsw + _i * 8192), 16, 0, 0); } while (0)
#define PG8_LDA(dst, b, h) do { _Pragma("unroll") for (int m = 0; m < 4; ++m) _Pragma("unroll") for (int k = 0; k < 2; ++k) dst[m][k] = *(const LAS bf16x8*)(lds + PG8_SA(b, h) + aoff + m * 2048 + k * 1024); } while (0)
#define PG8_LDB(dst, b, h) do { _Pragma("unroll") for (int n = 0; n < 2; ++n) _Pragma("unroll") for (int k = 0; k < 2; ++k) dst[n][k] = *(const LAS bf16x8*)(lds + PG8_SB(b, h) + boff + n * 2048 + k * 1024); } while (0)
#define PG8_MMA(ai, bj, At, Bt) do { __builtin_amdgcn_s_setprio(1); _Pragma("unroll") for (int m = 0; m < 4; ++m) _Pragma("unroll") for (int n = 0; n < 2; ++n) _Pragma("unroll") for (int k = 0; k < 2; ++k) \
        acc[ai][bj][m][n] = __builtin_amdgcn_mfma_f32_16x16x32_bf16(Bt[n][k], At[m][k], acc[ai][bj][m][n], 0, 0, 0); __builtin_amdgcn_s_setprio(0); } while (0)
#define PG8_WAIT_V(n) asm volatile("s_waitcnt vmcnt(" #n ")" ::: "memory")
#define PG8_WAIT_L(n) asm volatile("s_waitcnt lgkmcnt(" #n ")" ::: "memory")
#define PG8_BAR __builtin_amdgcn_s_barrier()
#define PG8_SCHED __builtin_amdgcn_sched_barrier(0)
    Unit cur, nxt; int ui = 0;
    if (!S.next(0, cur)) return;
    f32x4 acc[2][2][4][2];
#pragma unroll
    for (int a = 0; a < 2; ++a)
#pragma unroll
        for (int b = 0; b < 2; ++b)
#pragma unroll
            for (int m = 0; m < 4; ++m)
#pragma unroll
                for (int n = 0; n < 2; ++n) acc[a][b][m][n] = (f32x4){0.f, 0.f, 0.f, 0.f};
    bf16x8 At[4][2], B0[2][2], B1[2][2];
    const char* cA = (const char*)g.A + (size_t)cur.pm * tstep; const char* cB = (const char*)g.Bt + (size_t)cur.pn * tstep;
    PG8_STAGE(PG8_SB(0, 0), cB, voffB); PG8_STAGE(PG8_SB(0, 1), cB + hstep, voffB); PG8_STAGE(PG8_SA(0, 0), cA, voffA); PG8_STAGE(PG8_SA(0, 1), cA + hstep, voffA);
    if (wr == 1) PG8_BAR;
    PG8_WAIT_V(2); PG8_BAR;
    PG8_STAGE(PG8_SB(1, 0), cB + kstep, voffB); PG8_STAGE(PG8_SA(1, 0), cA + kstep, voffA); PG8_STAGE(PG8_SB(1, 1), cB + hstep + kstep, voffB);
    PG8_WAIT_V(6); PG8_BAR;
    for (;;) {
        const bool has_next = S.next(ui + 1, nxt);
        const char* nA = has_next ? (const char*)g.A + (size_t)nxt.pm * tstep : cA; const char* nB = has_next ? (const char*)g.Bt + (size_t)nxt.pn * tstep : cB;
        for (int t = 0; t < nt; t += 2) {
            const bool last = (t == nt - 2);
            const char* a1 = cA + (size_t)(t + 1) * kstep;
            const char* a2 = last ? nA : cA + (size_t)(t + 2) * kstep; const char* b2 = last ? nB : cB + (size_t)(t + 2) * kstep;
            const char* a3 = a2 + kstep; const char* b3 = b2 + kstep;
            PG8_LDB(B0, 0, 0); PG8_LDB(B1, 0, 1); PG8_SCHED; PG8_LDA(At, 0, 0); PG8_STAGE(PG8_SA(1, 1), a1 + hstep, voffA);
            PG8_WAIT_V(8); PG8_WAIT_L(0); PG8_BAR; PG8_MMA(0, 0, At, B0); PG8_MMA(0, 1, At, B1); PG8_BAR; PG8_SCHED;
            PG8_LDA(At, 0, 1); PG8_STAGE(PG8_SB(0, 0), b2, voffB); PG8_STAGE(PG8_SB(0, 1), b2 + hstep, voffB); PG8_STAGE(PG8_SA(0, 0), a2, voffA);
            PG8_WAIT_V(8); PG8_WAIT_L(0); PG8_BAR; PG8_MMA(1, 0, At, B0); PG8_MMA(1, 1, At, B1); PG8_BAR; PG8_SCHED;
            PG8_LDB(B0, 1, 0); PG8_LDB(B1, 1, 1); PG8_SCHED; PG8_LDA(At, 1, 0); PG8_STAGE(PG8_SA(0, 1), a2 + hstep, voffA);
            PG8_WAIT_V(8); PG8_WAIT_L(0); PG8_BAR; PG8_MMA(0, 0, At, B0); PG8_MMA(0, 1, At, B1); PG8_BAR; PG8_SCHED;
            PG8_LDA(At, 1, 1); PG8_STAGE(PG8_SB(1, 0), b3, voffB); PG8_STAGE(PG8_SB(1, 1), b3 + hstep, voffB); PG8_STAGE(PG8_SA(1, 0), a3, voffA);
            PG8_WAIT_V(8); PG8_WAIT_L(0); PG8_BAR; PG8_MMA(1, 0, At, B0); PG8_MMA(1, 1, At, B1); PG8_BAR; PG8_SCHED;
        }
        if constexpr (ALIGN_EPI) { if (wr == 0) PG8_BAR; }
        E(acc, cur, wr, wc, fr, fq);
        if (!has_next) break;
#pragma unroll
        for (int a = 0; a < 2; ++a)
#pragma unroll
            for (int b = 0; b < 2; ++b)
#pragma unroll
                for (int m = 0; m < 4; ++m)
#pragma unroll
                    for (int n = 0; n < 2; ++n) acc[a][b][m][n] = (f32x4){0.f, 0.f, 0.f, 0.f};
        cur = nxt; cA = nA; cB = nB; ++ui;
        if constexpr (ALIGN_EPI) { if (wr == 1) PG8_BAR; }
    }
    PG8_WAIT_V(0);
    if constexpr (!ALIGN_EPI) { if (wr == 0) PG8_BAR; }
    PG8_BAR;
#undef PG8_SA
#undef PG8_SB
#undef PG8_STAGE
#undef PG8_LDA
#undef PG8_LDB
#undef PG8_MMA
#undef PG8_WAIT_V
#undef PG8_WAIT_L
#undef PG8_BAR
#undef PG8_SCHED
}
}

#define XB_TMO      128
#define XB_XCNT(j)  (256  + 64 * (j))
#define XB_XSUB(j)  (1280 + 64 * (j))
#define XB_XGEN(j)  (2304 + 64 * (j))
#define XB_TOP      3328
#define XB_TOPGEN   3392
#define XCD_BAR_WORDS 3456
#define XB_SPIN_CAP (1u << 18)
constexpr size_t CTL_XCEN = 160 * 1024;
constexpr size_t CTL_Q = 128 * 1024;
constexpr size_t CTL_BAR = 64 * 1024;
__device__ __forceinline__ unsigned xb_ld(unsigned* p)              { return __hip_atomic_load(p, __ATOMIC_RELAXED, __HIP_MEMORY_SCOPE_AGENT); }
__device__ __forceinline__ unsigned xb_add(unsigned* p, unsigned v) { return __hip_atomic_fetch_add(p, v, __ATOMIC_RELAXED, __HIP_MEMORY_SCOPE_AGENT); }
__device__ __forceinline__ unsigned xb_xcc_id() { return (unsigned)__builtin_amdgcn_s_getreg((3 << 11) | 20) & 0xFu; }
#define XB_SPIN(cond, bar) do { unsigned _sp = 0; while (cond) { __builtin_amdgcn_s_sleep(1); \
    if ((++_sp & 255u) == 0u) { if (xb_ld(&(bar)[XB_TMO])) break; if (_sp > XB_SPIN_CAP) { atomicAdd(&(bar)[XB_TMO], 1u); break; } } } } while (0)
struct XcdBarrier { unsigned* bar; unsigned x; volatile LAS unsigned* st; };
__device__ __forceinline__ XcdBarrier xcd_barrier_post(unsigned* bar, volatile LAS unsigned* st) {
    XcdBarrier b; b.bar = bar; b.x = xb_xcc_id(); b.st = st;
    if (threadIdx.x == 0) (void)xb_add(&bar[XB_XCNT(b.x)], 1u);
    return b;
}
__device__ __forceinline__ void xcd_barrier_complete(unsigned* bar, unsigned x, unsigned& nloc, unsigned& nx) {
    const unsigned G = gridDim.x * gridDim.y * gridDim.z;
    unsigned sum, cnt, mine, sp = 0u;
    for (;;) {
        sum = 0u; cnt = 0u; mine = 0u;
#pragma unroll
        for (unsigned j = 0; j < 16; ++j) { const unsigned c = xb_ld(&bar[XB_XCNT(j)]); sum += c; cnt += (c > 0u) ? 1u : 0u; mine = (j == x) ? c : mine; }
        if (sum == G) break;
        __builtin_amdgcn_s_sleep(1);
        if ((++sp & 255u) == 0u) { if (xb_ld(&bar[XB_TMO])) break; if (sp > XB_SPIN_CAP) { atomicAdd(&bar[XB_TMO], 1u); break; } }
    }
    nloc = mine > 0u ? mine : 1u; nx = cnt > 0u ? cnt : 1u;
}
__device__ __forceinline__ void xcd_barrier(const XcdBarrier& b) {
    asm volatile("s_waitcnt vmcnt(0)" ::: "memory");
    __syncthreads();
    if (threadIdx.x == 0) {
        unsigned* bar = b.bar;
        __builtin_amdgcn_s_waitcnt(0);
        unsigned nloc = b.st[0], nx = b.st[1];
        if (nloc == 0u) { xcd_barrier_complete(bar, b.x, nloc, nx); b.st[0] = nloc; b.st[1] = nx; }
        const unsigned old = xb_add(&bar[XB_XSUB(b.x)], 1u);
        const unsigned gen = old / nloc;
        if (old + 1u == (gen + 1u) * nloc) {
            __builtin_amdgcn_fence(__ATOMIC_RELEASE, "agent");
            asm volatile("s_waitcnt vmcnt(0)" ::: "memory");
            const unsigned og = xb_add(&bar[XB_TOP], 1u);
            const unsigned tg = og / nx;
            if (og + 1u == (tg + 1u) * nx) xb_add(&bar[XB_TOPGEN], 1u);
            else XB_SPIN(xb_ld(&bar[XB_TOPGEN]) == tg, bar);
            __builtin_amdgcn_fence(__ATOMIC_ACQUIRE, "agent");
            xb_add(&bar[XB_XGEN(b.x)], 1u);
            asm volatile("s_waitcnt vmcnt(0)" ::: "memory");
        } else {
            XB_SPIN(xb_ld(&bar[XB_XGEN(b.x)]) == gen, bar);
            __builtin_amdgcn_fence(__ATOMIC_ACQUIRE, "agent");
            asm volatile("s_waitcnt vmcnt(0)" ::: "memory");
        }
    }
    __syncthreads();
}

__device__ __forceinline__ float xcd_barrier_prefetch(const XcdBarrier& b, const float* tile, int ld) {
    asm volatile("s_waitcnt vmcnt(0)" ::: "memory");
    __syncthreads();
    float v = 0.f;
    if (threadIdx.x >= 64) {
        const int t = (int)threadIdx.x - 64;
#pragma unroll
        for (int j = 0; j < 5; ++j) { const int L = t + 448 * j; if (L < 2048) v += __builtin_nontemporal_load(tile + (size_t)(L >> 3) * ld + 32 * (L & 7)); }
    } else if (threadIdx.x == 0) {
        unsigned* bar = b.bar;
        __builtin_amdgcn_s_waitcnt(0);
        unsigned nloc = b.st[0], nx = b.st[1];
        if (nloc == 0u) { xcd_barrier_complete(bar, b.x, nloc, nx); b.st[0] = nloc; b.st[1] = nx; }
        const unsigned old = xb_add(&bar[XB_XSUB(b.x)], 1u);
        const unsigned gen = old / nloc;
        if (old + 1u == (gen + 1u) * nloc) {
            __builtin_amdgcn_fence(__ATOMIC_RELEASE, "agent");
            asm volatile("s_waitcnt vmcnt(0)" ::: "memory");
            const unsigned og = xb_add(&bar[XB_TOP], 1u);
            const unsigned tg = og / nx;
            if (og + 1u == (tg + 1u) * nx) xb_add(&bar[XB_TOPGEN], 1u);
            else XB_SPIN(xb_ld(&bar[XB_TOPGEN]) == tg, bar);
            __builtin_amdgcn_fence(__ATOMIC_ACQUIRE, "agent");
            xb_add(&bar[XB_XGEN(b.x)], 1u);
            asm volatile("s_waitcnt vmcnt(0)" ::: "memory");
        } else {
            XB_SPIN(xb_ld(&bar[XB_XGEN(b.x)]) == gen, bar);
            __builtin_amdgcn_fence(__ATOMIC_ACQUIRE, "agent");
            asm volatile("s_waitcnt vmcnt(0)" ::: "memory");
        }
    }
    __syncthreads();
    return v;
}

struct Args {
    const float* in[20];
    float* out;
    unsigned char* ws;
    int ph_lo, ph_hi;
};

__host__ __device__ __forceinline__ int win_logical(int c) { return (c < 1280) ? c : (c < 1304 ? 3328 + (c - 1280) : c - 24); }
__host__ __device__ __forceinline__ int tile_perm_row(int L) { const int Lc = L & 255, lo = Lc & 31; return (L & ~255) + 128 * ((Lc >> 5) & 1) + 32 * (Lc >> 6) + 16 * ((lo >> 2) & 1) + 4 * (lo >> 3) + (lo & 3); }

__host__ __device__ __forceinline__ int perm32_row(int col) { const int cg = col & 31; return (col & ~31) + 16 * ((cg >> 2) & 1) + 4 * (cg >> 3) + (cg & 3); }
template <int MAPKIND>
__device__ __forceinline__ void p0_transpose_item(const float* W, int K, int N, bf16* WT, LAS float* scr, int item, int lane, const float* kscale = nullptr) {
    const int nblk = (N + 31) / 32, kb = item / nblk, nb = item % nblk, k0 = 64 * kb, n0 = 32 * nb;
    const int c4 = lane & 7, colr = n0 + 4 * c4;
    f32x4 wv[8];
#pragma unroll
    for (int i = 0; i < 8; ++i) { const int kk = (lane >> 3) + 8 * i; wv[i] = (colr < N) ? *(const f32x4*)(W + (size_t)(k0 + kk) * N + colr) : (f32x4){0.f, 0.f, 0.f, 0.f}; }
#pragma unroll
    for (int i = 0; i < 8; ++i) { const int kk = (lane >> 3) + 8 * i; const float ksc = kscale ? kscale[k0 + kk] : 1.0f; LAS float* d = scr + kk * 33 + 4 * c4;
        d[0] = wv[i].x * ksc; d[1] = wv[i].y * ksc; d[2] = wv[i].z * ksc; d[3] = wv[i].w * ksc; }
    LDS_WAIT(); asm volatile("" ::: "memory");
    const int c = lane & 7;
#pragma unroll
    for (int j = 0; j < 4; ++j) { const int n = (lane >> 3) + 8 * j; const LAS float* s = scr + (8 * c) * 33 + n; const int col = n0 + n;
        if (col < N) {
            u32x4 o; o.x = cvtpk(s[0 * 33], s[1 * 33]); o.y = cvtpk(s[2 * 33], s[3 * 33]); o.z = cvtpk(s[4 * 33], s[5 * 33]); o.w = cvtpk(s[6 * 33], s[7 * 33]);
            const int row = (MAPKIND == 1) ? tile_perm_row(win_logical(col)) : (MAPKIND == 2 ? tile_perm_row(col) : (MAPKIND == 3 ? perm32_row(col) : col));
            *(u32x4*)(WT + (size_t)row * K + k0 + 8 * c) = o; } }
    LDS_WAIT(); asm volatile("" ::: "memory");
}

__device__ __forceinline__ void rms_row_to_bf16(const float* xrow, const float* gain, bf16* orow, int lane) {
    const f32x4* xr = (const f32x4*)xrow + lane; const f32x4* gr = (const f32x4*)gain + lane;
    f32x4 v[4]; float s = 0.f;
#pragma unroll
    for (int j = 0; j < 4; ++j) { v[j] = xr[64 * j]; s += (v[j].x * v[j].x + v[j].y * v[j].y) + (v[j].z * v[j].z + v[j].w * v[j].w); }
    const float rs = 1.0f / sqrtf(wave_sum(s) * (1.f / DM) + EPS);
    u32x2* o8 = (u32x2*)orow + lane;
#pragma unroll
    for (int j = 0; j < 4; ++j) { const f32x4 g = gr[64 * j]; u32x2 w; w.x = cvtpk(v[j].x * rs * g.x, v[j].y * rs * g.y); w.y = cvtpk(v[j].z * rs * g.z, v[j].w * rs * g.w); o8[64 * j] = w; }
}

struct EpiIn {
    float* out; unsigned char* ws;
    const float *q_gain, *k_gain, *pe;
    __device__ __forceinline__ void operator()(const f32x4 (&acc)[2][2][4][2], const pg8::Unit& u, int wr, int wc, int fr, int fq) const {
        const int pn = u.pn;
        bf16* const Q = (bf16*)(ws + WS_Q); bf16* const KC = (bf16*)(ws + WS_KC); bf16* const KS = (bf16*)(ws + WS_KS); bf16* const KW = (bf16*)(ws + WS_KW);
        float* const GL = (float*)(ws + WS_GL); float* const GATES = (float*)(ws + WS_GATES); const float* const lb = (const float*)(ws + WS_LB);
        const int rowb = u.pm * 256 + wr * 64 + fr;
        const int lo8 = 8 * fq;
#define EPI_ROWS _Pragma("unroll") for (int ai = 0; ai < 2; ++ai) _Pragma("unroll") for (int m = 0; m < 4; ++m)
#define EPI_COLS _Pragma("unroll") for (int bj = 0; bj < 2; ++bj) _Pragma("unroll") for (int n = 0; n < 2; ++n)
#define EPI_BJ _Pragma("unroll") for (int bj = 0; bj < 2; ++bj)
#define PACK16(v0_, v1_) (u32x4){cvtpk((v0_).x, (v0_).y), cvtpk((v0_).z, (v0_).w), cvtpk((v1_).x, (v1_).y), cvtpk((v1_).z, (v1_).w)}
        if (pn < 2) {
            f32x4 g[2][2];
            EPI_COLS g[bj][n] = *(const f32x4*)(q_gain + 32 * bj + lo8 + 4 * n);
            EPI_ROWS { const int row = rowb + 128 * ai + 16 * m; float ss = 0.f;
                EPI_COLS { const f32x4 v = acc[ai][bj][m][n]; ss += (v.x * v.x + v.y * v.y) + (v.z * v.z + v.w * v.w); }
                ss += __shfl_xor(ss, 16); ss += __shfl_xor(ss, 32);
                const float rs = __builtin_amdgcn_rsqf(ss * (1.f / 64.f) + EPS);
                bf16* dst = Q + (size_t)row * 512 + pn * 256 + 64 * wc + lo8;
                EPI_BJ { const f32x4 v0 = acc[ai][bj][m][0] * rs * g[bj][0], v1 = acc[ai][bj][m][1] * rs * g[bj][1]; *(u32x4*)(dst + 32 * bj) = PACK16(v0, v1); } }
        } else if (pn < 5) {
            const bool norm = (pn > 2) && (wc < 2);
            f32x4 g[2][2];
            EPI_COLS g[bj][n] = norm ? *(const f32x4*)(k_gain + (pn - 2) * 64 + 32 * bj + lo8 + 4 * n) : (f32x4){1.f, 1.f, 1.f, 1.f};
            EPI_ROWS { const int row = rowb + 128 * ai + 16 * m; float rs = 1.f;
                if (norm) { float ss = 0.f;
                    EPI_COLS { const f32x4 v = acc[ai][bj][m][n]; ss += (v.x * v.x + v.y * v.y) + (v.z * v.z + v.w * v.w); }
                    ss += __shfl_xor(ss, 16); ss += __shfl_xor(ss, 32);
                    rs = __builtin_amdgcn_rsqf(ss * (1.f / 64.f) + EPS); }
                float* fdst = nullptr; bf16* bdst = nullptr; const float* pep = nullptr;
                if (pn == 2) { fdst = (row < MP) ? out + O_KVP + (size_t)row * 512 : out + O_KVS + (size_t)(row - MP) * 512;
                               if (row < MP) { bdst = KC + (size_t)row * 256; pep = pe + (wc >> 1) * 4096 + (row & 63) * 64; } }
                else if (pn == 3) { fdst = ((row < MP) ? out + O_KVP + (size_t)row * 512 : out + O_KVS + (size_t)(row - MP) * 512) + 256; bdst = KS + (size_t)row * 256; }
                else { bdst = KW + (size_t)row * 256;
                       if (row < MP) { const int t = row & (SEQ - 1), b = row >> 12; if (t >= SEQ - 512) fdst = out + O_WINP + ((size_t)b * 512 + (t - (SEQ - 512))) * 256; }
                       else { const int rs_ = row - MP, b = rs_ >> 3, t = rs_ & 7; fdst = out + O_WINS + ((size_t)b * 512 + 504 + t) * 256; } }
                const int cb = 64 * wc + lo8;
                EPI_BJ { f32x4 v0 = acc[ai][bj][m][0] * rs * g[bj][0], v1 = acc[ai][bj][m][1] * rs * g[bj][1];
                    if (fdst) { __builtin_nontemporal_store(v0, (f32x4*)(fdst + cb + 32 * bj)); __builtin_nontemporal_store(v1, (f32x4*)(fdst + cb + 32 * bj + 4)); }
                    if (bdst) { if (pep) { v0 = v0 + *(const f32x4*)(pep + lo8 + 32 * bj); v1 = v1 + *(const f32x4*)(pep + lo8 + 32 * bj + 4); } *(u32x4*)(bdst + cb + 32 * bj) = PACK16(v0, v1); } } }
        } else if (pn < 13) {
            const int kind = (pn - 5) >> 1, cbase = ((pn - 5) & 1) * 256 + 64 * wc + lo8;
            bf16* B = (bf16*)(ws + WS_RQ + (size_t)kind * (WS_RK - WS_RQ));
            f32x4 lbv[2][2];
            EPI_COLS lbv[bj][n] = (kind == 1) ? *(const f32x4*)(lb + cbase + 32 * bj + 4 * n) : (f32x4){0.f, 0.f, 0.f, 0.f};
            EPI_ROWS { const int row = rowb + 128 * ai + 16 * m;
                EPI_BJ { f32x4 v[2];
#pragma unroll
                    for (int n = 0; n < 2; ++n) { v[n] = acc[ai][bj][m][n];
                        if (kind == 0 || kind == 3) { v[n].x = siluf_(v[n].x); v[n].y = siluf_(v[n].y); v[n].z = siluf_(v[n].z); v[n].w = siluf_(v[n].w); }
                        if (kind == 1) { f32x4 gl, kk; const f32x4 l = lbv[bj][n];
#pragma unroll
                            for (int i = 0; i < 4; ++i) { const float e = __expf(-v[n][i]); const float sg = __builtin_amdgcn_rcpf(1.0f + e); const float f = l[i] + (1.0f - l[i]) * sg; gl[i] = __logf(f); kk[i] = (1.0f - l[i]) * (e * sg); }
                            *(f32x4*)(GL + (size_t)row * 512 + cbase + 32 * bj + 4 * n) = gl; v[n] = kk; } }
                    *(u32x4*)(B + (size_t)row * 512 + cbase + 32 * bj) = PACK16(v[0], v[1]); } }
        } else {
            if (wc == 0 && fq < 3) {
                EPI_ROWS { const int row = rowb + 128 * ai + 16 * m;
#pragma unroll
                    for (int n = 0; n < 2; ++n) { f32x4 v = acc[ai][0][m][n];
                        v.x = sigmoidf_(v.x); v.y = sigmoidf_(v.y); v.z = sigmoidf_(v.z); v.w = sigmoidf_(v.w); *(f32x4*)(GATES + (size_t)row * 24 + lo8 + 4 * n) = v; } }
            }
        }
#undef EPI_ROWS
#undef EPI_COLS
#undef EPI_BJ
#undef PACK16
    }
};

typedef short v4i16_t __attribute__((ext_vector_type(4)));
constexpr int KVS = 144;
constexpr int KVT = 64 * KVS;
constexpr float LOG2E = 1.4426950408889634f;
constexpr float SL2 = 0.125f * LOG2E;
__device__ __forceinline__ f32x4 mfma16(bf16x8 a, bf16x8 b, f32x4 c) { return __builtin_amdgcn_mfma_f32_16x16x32_bf16(a, b, c, 0, 0, 0); }
__device__ __forceinline__ bf16x4 ldtr(LAS const unsigned char* p) { return __builtin_bit_cast(bf16x4, __builtin_amdgcn_ds_read_tr16_b64_v4i16((LAS v4i16_t*)p)); }
__device__ __forceinline__ bf16x8 pack8(f32x4 a, f32x4 b) { u32x4 w; w.x = cvtpk(a.x, a.y); w.y = cvtpk(a.z, a.w); w.z = cvtpk(b.x, b.y); w.w = cvtpk(b.z, b.w); return __builtin_bit_cast(bf16x8, w); }
__device__ __forceinline__ bf16x8 cat44(bf16x4 a, bf16x4 b) { return (bf16x8){a[0], a[1], a[2], a[3], b[0], b[1], b[2], b[3]}; }
struct AttnSt { f32x4 o[4][2]; float m[2], l[2]; };
__device__ __forceinline__ void attn_init(AttnSt& st) {
#pragma unroll
    for (int dt = 0; dt < 4; ++dt) { st.o[dt][0] = (f32x4){0.f, 0.f, 0.f, 0.f}; st.o[dt][1] = (f32x4){0.f, 0.f, 0.f, 0.f}; }
    st.m[0] = st.m[1] = 0.f; st.l[0] = st.l[1] = 0.f;
}
__device__ __forceinline__ void attn_scores(f32x4 (&s)[2][4], const bf16x8 (&qf)[2][2], LAS const unsigned char* Kt, int c, int q4) {
    bf16x8 kf[4][2];
#pragma unroll
    for (int kt4 = 0; kt4 < 4; ++kt4) { kf[kt4][0] = *(LAS const bf16x8*)(Kt + (16 * kt4 + c) * KVS + 16 * q4); kf[kt4][1] = *(LAS const bf16x8*)(Kt + (16 * kt4 + c) * KVS + 64 + 16 * q4); }
    __builtin_amdgcn_sched_barrier(0);
#pragma unroll
    for (int kt4 = 0; kt4 < 4; ++kt4)
#pragma unroll
        for (int qt2 = 0; qt2 < 2; ++qt2) s[qt2][kt4] = mfma16(kf[kt4][0], qf[qt2][0], (f32x4){0.f, 0.f, 0.f, 0.f});
#pragma unroll
    for (int kt4 = 0; kt4 < 4; ++kt4)
#pragma unroll
        for (int qt2 = 0; qt2 < 2; ++qt2) s[qt2][kt4] = mfma16(kf[kt4][1], qf[qt2][1], s[qt2][kt4]);
}
__device__ __forceinline__ void attn_pv(f32x4 (&o)[4][2], const f32x4 (&p)[2][4], LAS const unsigned char* Vt, int c, int q4) {
    const int vrow = 4 * q4 + (c >> 2), vcol = 8 * (c & 3);
    bf16x4 lo[2][4], hi[2][4];
#pragma unroll
    for (int s2 = 0; s2 < 2; ++s2)
#pragma unroll
        for (int dt = 0; dt < 4; ++dt) { lo[s2][dt] = ldtr(Vt + (32 * s2 + vrow) * KVS + 32 * dt + vcol); hi[s2][dt] = ldtr(Vt + (32 * s2 + 16 + vrow) * KVS + 32 * dt + vcol); }
    bf16x8 pb[2][2];
#pragma unroll
    for (int s2 = 0; s2 < 2; ++s2) { pb[s2][0] = pack8(p[0][2 * s2], p[0][2 * s2 + 1]); pb[s2][1] = pack8(p[1][2 * s2], p[1][2 * s2 + 1]); }
    __builtin_amdgcn_sched_barrier(0);
#pragma unroll
    for (int s2 = 0; s2 < 2; ++s2)
#pragma unroll
        for (int dt = 0; dt < 4; ++dt) { const bf16x8 vf = cat44(lo[s2][dt], hi[s2][dt]); o[dt][0] = mfma16(vf, pb[s2][0], o[dt][0]); o[dt][1] = mfma16(vf, pb[s2][1], o[dt][1]); }
}
__device__ __forceinline__ void attn_pv_lean(f32x4 (&o)[4][2], const f32x4 (&p)[2][4], LAS const unsigned char* Vt, int c, int q4) {
    const int vrow = 4 * q4 + (c >> 2), vcol = 8 * (c & 3);
#pragma unroll
    for (int s2 = 0; s2 < 2; ++s2) {
        const bf16x8 pb0 = pack8(p[0][2 * s2], p[0][2 * s2 + 1]), pb1 = pack8(p[1][2 * s2], p[1][2 * s2 + 1]);
#pragma unroll
        for (int dt = 0; dt < 4; ++dt) {
            const bf16x4 lo = ldtr(Vt + (32 * s2 + vrow) * KVS + 32 * dt + vcol);
            const bf16x4 hi = ldtr(Vt + (32 * s2 + 16 + vrow) * KVS + 32 * dt + vcol);
            const bf16x8 vf = cat44(lo, hi);
            o[dt][0] = mfma16(vf, pb0, o[dt][0]); o[dt][1] = mfma16(vf, pb1, o[dt][1]);
        }
    }
}
template <bool LEAN = false>
__device__ __forceinline__ void attn_update(AttnSt& st, f32x4 (&x)[2][4], LAS const unsigned char* Vt, int c, int q4) {
#pragma unroll
    for (int qt2 = 0; qt2 < 2; ++qt2) {
        float mx = -__builtin_inff();
#pragma unroll
        for (int kt4 = 0; kt4 < 4; ++kt4) mx = fmaxf(mx, fmaxf(fmaxf(x[qt2][kt4].x, x[qt2][kt4].y), fmaxf(x[qt2][kt4].z, x[qt2][kt4].w)));
        mx = fmaxf(mx, __shfl_xor(mx, 16)); mx = fmaxf(mx, __shfl_xor(mx, 32));
        const float mn = fmaxf(st.m[qt2], mx), mu = (mn == -__builtin_inff()) ? 0.f : mn;
        const float alpha = __builtin_amdgcn_exp2f(st.m[qt2] - mu);
        float ls = 0.f;
#pragma unroll
        for (int kt4 = 0; kt4 < 4; ++kt4) { f32x4 e;
#pragma unroll
            for (int i = 0; i < 4; ++i) e[i] = __builtin_amdgcn_exp2f(x[qt2][kt4][i] - mu);
            x[qt2][kt4] = e; ls += (e.x + e.y) + (e.z + e.w); }
        st.l[qt2] = st.l[qt2] * alpha + ls; st.m[qt2] = mn;
#pragma unroll
        for (int dt = 0; dt < 4; ++dt) st.o[dt][qt2] = st.o[dt][qt2] * alpha;
    }
    if (LEAN) attn_pv_lean(st.o, x, Vt, c, q4); else attn_pv(st.o, x, Vt, c, q4);
}
constexpr float MFIX = 17.0f;
template <bool LEAN = false>
__device__ __forceinline__ void attn_update_fixed(AttnSt& st, f32x4 (&x)[2][4], LAS const unsigned char* Vt, int c, int q4) {
#pragma unroll
    for (int qt2 = 0; qt2 < 2; ++qt2) { float ls = 0.f;
#pragma unroll
        for (int kt4 = 0; kt4 < 4; ++kt4) { f32x4 e;
#pragma unroll
            for (int i = 0; i < 4; ++i) e[i] = __builtin_amdgcn_exp2f(x[qt2][kt4][i]);
            x[qt2][kt4] = e; ls += (e.x + e.y) + (e.z + e.w); }
        st.l[qt2] += ls; }
    if (LEAN) attn_pv_lean(st.o, x, Vt, c, q4); else attn_pv(st.o, x, Vt, c, q4);
}
__device__ __forceinline__ void kv_load_regs(u32x4& kr, u32x4& vr, const bf16* base, size_t row0, int kcol, int tid) {
    const bf16* p = base + (row0 + (tid >> 3)) * 256 + kcol + 8 * (tid & 7);
    kr = *(const u32x4*)p; vr = *(const u32x4*)(p + 128);
}
__device__ __forceinline__ void kv_store_lds(LAS unsigned char* Kt, LAS unsigned char* Vt, u32x4 kr, u32x4 vr, int tid) {
    const int off = (tid >> 3) * KVS + 16 * (tid & 7);
    *(LAS u32x4*)(Kt + off) = kr; *(LAS u32x4*)(Vt + off) = vr;
}
__device__ __forceinline__ void load_qfrags(bf16x8 (&qf)[2][2], const bf16* Q, size_t row0, int hcol, int c, int q4) {
#pragma unroll
    for (int qt2 = 0; qt2 < 2; ++qt2)
#pragma unroll
        for (int ks = 0; ks < 2; ++ks) qf[qt2][ks] = *(const bf16x8*)(Q + (row0 + 16 * qt2 + c) * 512 + hcol + 32 * ks + 8 * q4);
}

__device__ __forceinline__ void win_prompt_unit(LAS unsigned char* lds, unsigned char* ws, int unit, int tid) {
    const int lane = tid & 63, w = __builtin_amdgcn_readfirstlane(tid >> 6), c = lane & 15, q4 = lane >> 4;
    const int b = unit >> 7, g = (unit >> 6) & 1, qblk = unit & 63, t0 = 64 * qblk, r = w & 3, th = w >> 2, head = 4 * g + r;
    const float slope2 = __builtin_amdgcn_exp2f(-(float)(head + 1)) * LOG2E;
    const bf16* KW = (const bf16*)(ws + WS_KW);
    const size_t rowb = (size_t)b * SEQ;
    bf16x8 qf[2][2]; load_qfrags(qf, (const bf16*)(ws + WS_Q), rowb + t0 + 32 * th, 64 * head, c, q4);
    AttnSt st; attn_init(st);
    f32x4 kb[4];
#pragma unroll
    for (int kt4 = 0; kt4 < 4; ++kt4) kb[kt4] = (f32x4){slope2 * (float)(16 * kt4 + 4 * q4), slope2 * (float)(16 * kt4 + 4 * q4 + 1), slope2 * (float)(16 * kt4 + 4 * q4 + 2), slope2 * (float)(16 * kt4 + 4 * q4 + 3)};
    const int j0 = qblk >= 8 ? qblk - 8 : 0, nt = qblk - j0 + 1;
    u32x4 kr, vr;
    kv_load_regs(kr, vr, KW, rowb + 64 * j0, 64 * g, tid);
    kv_store_lds(lds, lds + KVT, kr, vr, tid);
    __syncthreads();
    for (int i = 0; i < nt; ++i) {
        LAS unsigned char* Kt = lds + (i & 1) * 2 * KVT; LAS unsigned char* Vt = Kt + KVT;
        if (i + 1 < nt) kv_load_regs(kr, vr, KW, rowb + 64 * (j0 + i + 1), 64 * g, tid);
        f32x4 s[2][4]; attn_scores(s, qf, Kt, c, q4);
        const int kbase = 64 * (j0 + i), jt = j0 + i;
        if (jt > qblk - 8 && jt < qblk) {
#pragma unroll
            for (int qt2 = 0; qt2 < 2; ++qt2) { const float c0 = slope2 * (float)(kbase - (t0 + 32 * th + 16 * qt2 + c)) - MFIX;
#pragma unroll
                for (int kt4 = 0; kt4 < 4; ++kt4) s[qt2][kt4] = s[qt2][kt4] * SL2 + (kb[kt4] + c0); }
        } else {
#pragma unroll
            for (int qt2 = 0; qt2 < 2; ++qt2) { const int qpos = t0 + 32 * th + 16 * qt2 + c;
#pragma unroll
                for (int kt4 = 0; kt4 < 4; ++kt4)
#pragma unroll
                    for (int e = 0; e < 4; ++e) { const int dist = qpos - (kbase + 16 * kt4 + 4 * q4 + e);
                        s[qt2][kt4][e] = (dist >= 0 && dist < 512) ? s[qt2][kt4][e] * SL2 - slope2 * (float)dist - MFIX : -__builtin_inff(); } }
        }
        attn_update_fixed(st, s, Vt, c, q4);
        if (i + 1 < nt) { LAS unsigned char* Kn = lds + ((i + 1) & 1) * 2 * KVT; kv_store_lds(Kn, Kn + KVT, kr, vr, tid); }
        __syncthreads();
    }
    bf16* OW = (bf16*)(ws + WS_OWIN);
#pragma unroll
    for (int qt2 = 0; qt2 < 2; ++qt2) { float l = st.l[qt2]; l += __shfl_xor(l, 16); l += __shfl_xor(l, 32); const float il = 1.0f / l;
        bf16* dst = OW + (rowb + t0 + 32 * th + 16 * qt2 + c) * 512 + 64 * head + 4 * q4;
#pragma unroll
        for (int dt = 0; dt < 4; ++dt) { const f32x4 v = st.o[dt][qt2] * il; u32x2 wv; wv.x = cvtpk(v.x, v.y); wv.y = cvtpk(v.z, v.w); *(u32x2*)(dst + 16 * dt) = wv; } }
}

constexpr int SL_KV = 0, SL_PSLAB = 4 * KVT  , SL_IMP = SL_PSLAB + 65536, SL_MASK = SL_IMP + 16384, SL_UMASK = SL_MASK + 512;
__device__ __forceinline__ void sel_prompt_unit(LAS unsigned char* lds, unsigned char* ws, const float* attn_gain, int unit, int tid) {
    const int lane = tid & 63, w = __builtin_amdgcn_readfirstlane(tid >> 6), c = lane & 15, q4 = lane >> 4;
    const int b = unit >> 7, g = (unit >> 6) & 1, qblk = unit & 63, t0 = 64 * qblk, r = w & 3, th = w >> 2, head = 4 * g + r;
    const float slope2 = __builtin_amdgcn_exp2f(-(float)(head + 1)) * LOG2E;
    const size_t rowb = (size_t)b * SEQ;
    bf16x8 qf[2][2]; load_qfrags(qf, (const bf16*)(ws + WS_Q), rowb + t0 + 32 * th, 64 * head, c, q4);
    LAS float* PSLAB = (LAS float*)(lds + SL_PSLAB); LAS float* IMP = (LAS float*)(lds + SL_IMP);
    LAS unsigned long long* MASK = (LAS unsigned long long*)(lds + SL_MASK);
    {
        const float* kc = (const float*)(ws + WS_KCMP) + (((size_t)b * 64 + (tid >> 3)) * 2 + g) * 64 + 8 * (tid & 7);
        const float* vc = (const float*)(ws + WS_VCMP) + (((size_t)b * 64 + (tid >> 3)) * 2 + g) * 64 + 8 * (tid & 7);
        const f32x4 k0 = *(const f32x4*)kc, k1 = *(const f32x4*)(kc + 4), v0 = *(const f32x4*)vc, v1 = *(const f32x4*)(vc + 4);
        kv_store_lds(lds, lds + KVT, __builtin_bit_cast(u32x4, pack8(k0, k1)), __builtin_bit_cast(u32x4, pack8(v0, v1)), tid);
    }
    __syncthreads();
    AttnSt sc; attn_init(sc);
    {
        f32x4 s[2][4]; attn_scores(s, qf, lds, c, q4);
#pragma unroll
        for (int qt2 = 0; qt2 < 2; ++qt2) { const int tok = 32 * th + 16 * qt2 + c, qpos = t0 + tok; float mx = -__builtin_inff();
#pragma unroll
            for (int kt4 = 0; kt4 < 4; ++kt4)
#pragma unroll
                for (int e = 0; e < 4; ++e) { const int dist = qpos - (64 * (16 * kt4 + 4 * q4 + e) + 63);
                    const float x = (dist >= 0) ? s[qt2][kt4][e] * SL2 - slope2 * (float)dist : -__builtin_inff(); s[qt2][kt4][e] = x; mx = fmaxf(mx, x); }
            mx = fmaxf(mx, __shfl_xor(mx, 16)); mx = fmaxf(mx, __shfl_xor(mx, 32));
            const float mu = (mx == -__builtin_inff()) ? 0.f : mx; float ls = 0.f;
#pragma unroll
            for (int kt4 = 0; kt4 < 4; ++kt4)
#pragma unroll
                for (int e = 0; e < 4; ++e) { const float p = __builtin_amdgcn_exp2f(s[qt2][kt4][e] - mu); s[qt2][kt4][e] = p; ls += p; }
            ls += __shfl_xor(ls, 16); ls += __shfl_xor(ls, 32);
            const float il = ls > 0.f ? 1.0f / ls : 0.f;
#pragma unroll
            for (int kt4 = 0; kt4 < 4; ++kt4) { s[qt2][kt4] = s[qt2][kt4] * il; *(LAS f32x4*)(PSLAB + (r * 64 + tok) * 64 + 16 * kt4 + 4 * q4) = s[qt2][kt4]; } }
        attn_pv(sc.o, s, lds + KVT, c, q4);
    }
    __syncthreads();
    {
        const int tok = tid >> 3, jg = tid & 7;
#pragma unroll
        for (int h2 = 0; h2 < 2; ++h2) { f32x4 a = (f32x4){0.f, 0.f, 0.f, 0.f};
#pragma unroll
            for (int rr = 0; rr < 4; ++rr) a = a + *(LAS const f32x4*)(PSLAB + (rr * 64 + tok) * 64 + 8 * jg + 4 * h2);
            *(LAS f32x4*)(IMP + tok * 64 + 8 * jg + 4 * h2) = a; }
    }
    __syncthreads();
    {
        const int tok = tid >> 3, jg = tid & 7; unsigned long long bits = 0ull;
        for (int jj = 0; jj < 8; ++jj) { const int j = 8 * jg + jj; bool sel = false;
            if (j == 0 || j == qblk) sel = true;
            else if (j < qblk) { const float vj = IMP[tok * 64 + j]; int cnt = 0;
                for (int i = 1; i < qblk; ++i) { const float vi = IMP[tok * 64 + i]; cnt += (vi > vj || (vi == vj && i < j)) ? 1 : 0; }
                sel = cnt < 14; }
            if (sel) bits |= 1ull << j; }
        bits |= __shfl_xor(bits, 1); bits |= __shfl_xor(bits, 2); bits |= __shfl_xor(bits, 4);
        if (jg == 0) MASK[tok] = bits;
    }
    __syncthreads();
    if (tid < 64) { unsigned long long u = MASK[tid];
#pragma unroll
        for (int o = 1; o < 64; o <<= 1) u |= __shfl_xor(u, o);
        if (tid == 0) *(LAS unsigned long long*)(lds + SL_UMASK) = u; }
    __syncthreads();
    unsigned long long um = *(LAS unsigned long long*)(lds + SL_UMASK);
    um = ((unsigned long long)__builtin_amdgcn_readfirstlane((unsigned)(um >> 32)) << 32) | (unsigned)__builtin_amdgcn_readfirstlane((unsigned)um);
    const unsigned long long msk0 = MASK[32 * th + c], msk1 = MASK[32 * th + 16 + c];
    const bf16* KS = (const bf16*)(ws + WS_KS);
    AttnSt st; attn_init(st);
    f32x4 kb[4];
#pragma unroll
    for (int kt4 = 0; kt4 < 4; ++kt4) kb[kt4] = (f32x4){slope2 * (float)(16 * kt4 + 4 * q4), slope2 * (float)(16 * kt4 + 4 * q4 + 1), slope2 * (float)(16 * kt4 + 4 * q4 + 2), slope2 * (float)(16 * kt4 + 4 * q4 + 3)};
    u32x4 kr, vr;
    int jcur = __builtin_ctzll(um); um &= um - 1;
    kv_load_regs(kr, vr, KS, rowb + 64 * jcur, 64 * g, tid);
    __syncthreads();
    kv_store_lds(lds, lds + KVT, kr, vr, tid);
    __syncthreads();
    for (int i = 0;; ++i) {
        LAS unsigned char* Kt = lds + (i & 1) * 2 * KVT; LAS unsigned char* Vt = Kt + KVT;
        const bool more = um != 0ull; int jn = 0;
        if (more) { jn = __builtin_ctzll(um); um &= um - 1; kv_load_regs(kr, vr, KS, rowb + 64 * jn, 64 * g, tid); }
        const bool s0 = (msk0 >> jcur) & 1ull, s1 = (msk1 >> jcur) & 1ull;
        if (__any(s0 || s1)) {
            f32x4 s[2][4]; attn_scores(s, qf, Kt, c, q4);
            const int kbase = 64 * jcur;
            if (jcur < qblk) {
#pragma unroll
                for (int qt2 = 0; qt2 < 2; ++qt2) { const float c0 = (qt2 ? s1 : s0) ? slope2 * (float)(kbase - (t0 + 32 * th + 16 * qt2 + c)) - MFIX : -__builtin_inff();
#pragma unroll
                    for (int kt4 = 0; kt4 < 4; ++kt4) s[qt2][kt4] = s[qt2][kt4] * SL2 + (kb[kt4] + c0); }
            } else {
#pragma unroll
                for (int qt2 = 0; qt2 < 2; ++qt2) { const int qpos = t0 + 32 * th + 16 * qt2 + c; const bool sq = qt2 ? s1 : s0;
#pragma unroll
                    for (int kt4 = 0; kt4 < 4; ++kt4)
#pragma unroll
                        for (int e = 0; e < 4; ++e) { const int dist = qpos - (kbase + 16 * kt4 + 4 * q4 + e);
                            s[qt2][kt4][e] = (sq && dist >= 0) ? s[qt2][kt4][e] * SL2 - slope2 * (float)dist - MFIX : -__builtin_inff(); } }
            }
            attn_update_fixed(st, s, Vt, c, q4);
        }
        if (more) { LAS unsigned char* Kn = lds + ((i + 1) & 1) * 2 * KVT; kv_store_lds(Kn, Kn + KVT, kr, vr, tid); }
        __syncthreads();
        if (!more) break;
        jcur = jn;
    }
    const float* GATES = (const float*)(ws + WS_GATES); const bf16* OW = (const bf16*)(ws + WS_OWIN); bf16* OA = (bf16*)(ws + WS_OA);
#pragma unroll
    for (int qt2 = 0; qt2 < 2; ++qt2) { const size_t row = rowb + t0 + 32 * th + 16 * qt2 + c;
        float l = st.l[qt2]; l += __shfl_xor(l, 16); l += __shfl_xor(l, 32); const float il = l > 0.f ? 1.0f / l : 0.f;
        const float g0 = GATES[row * 24 + head * 3 + 0], g1 = GATES[row * 24 + head * 3 + 1] * il, g2 = GATES[row * 24 + head * 3 + 2];
        f32x4 oa[4]; float ss = 0.f;
#pragma unroll
        for (int dt = 0; dt < 4; ++dt) { const u32x2 wv = *(const u32x2*)(OW + row * 512 + 64 * head + 16 * dt + 4 * q4);
            const f32x4 ow = (f32x4){__builtin_bit_cast(float, wv.x << 16), __builtin_bit_cast(float, wv.x & 0xffff0000u), __builtin_bit_cast(float, wv.y << 16), __builtin_bit_cast(float, wv.y & 0xffff0000u)};
            oa[dt] = sc.o[dt][qt2] * g0 + st.o[dt][qt2] * g1 + ow * g2;
            ss += (oa[dt].x * oa[dt].x + oa[dt].y * oa[dt].y) + (oa[dt].z * oa[dt].z + oa[dt].w * oa[dt].w); }
        ss += __shfl_xor(ss, 16); ss += __shfl_xor(ss, 32);
        const float rs = 1.0f / sqrtf(ss * (1.f / 64.f) + EPS);
#pragma unroll
        for (int dt = 0; dt < 4; ++dt) { const f32x4 gn = *(const f32x4*)(attn_gain + 64 * head + 16 * dt + 4 * q4); const f32x4 v = oa[dt] * rs * gn;
            u32x2 wv; wv.x = cvtpk(v.x, v.y); wv.y = cvtpk(v.z, v.w); *(u32x2*)(OA + row * 1024 + 64 * head + 16 * dt + 4 * q4) = wv; } }
    __syncthreads();
}

constexpr int CA_RS = 272, CA_BUF = 128 * CA_RS  , CL_H = 0, CH_RS = 272, CL_O = 128 * CH_RS  , CO_RS = 272;
constexpr int N_CMP_ITEMS = 136;
__device__ __forceinline__ void compress_item(LAS unsigned char* lds, unsigned char* ws, const float* cache_kv, const int* page_table, const float* pe, const float* k_gain, int item, int tid) {
    const int lane = tid & 63, w = __builtin_amdgcn_readfirstlane(tid >> 6), c = lane & 15, q4 = lane >> 4;
    const int kind = item & 1, ci = item >> 1;
    const bool prompt = ci < 4;
    const int l_pl = (tid >> 5) & 1, l_piece = tid & 31, l_g = l_piece >> 4, l_d = 4 * (l_piece & 15), l_blo = tid >> 6;
    unsigned soff[8];
    const bf16* const KCp = (const bf16*)(ws + WS_KC);
#pragma unroll
    for (int i = 0; i < 8; ++i) { const int bl = 8 * i + l_blo;
        if (prompt) soff[i] = (unsigned)(((size_t)ci * SEQ + 64 * bl + l_pl) * 256 + 128 * kind + 4 * l_piece);
        else { const int sb = 2 * (ci - 4) + (bl >> 5), blk = bl & 31; const int page = page_table[sb * NPAGES + (blk >> 1)];
               soff[i] = (unsigned)(((size_t)page * PAGE + (blk & 1) * 64 + l_pl) * 512 + 128 * kind + 4 * l_piece); } }
    const float* pep = pe + kind * 4096 + l_pl * 64 + l_d;
    const int l_dst = (2 * l_blo + l_g) * CA_RS + (l_pl * 64 + l_d) * 2;
    const bf16* W1 = (const bf16*)(ws + WS_W1) + (size_t)kind * 128 * 4096 + (size_t)(16 * w + c) * 4096 + 8 * q4;
    f32x4 acc[8];
#pragma unroll
    for (int mt = 0; mt < 8; ++mt) acc[mt] = (f32x4){0.f, 0.f, 0.f, 0.f};
    u32x4 ra0[8], ra1[8]; bf16x8 rb0[4], rb1[4];
#define CMP_ALOAD(R, st) do { if (prompt) { _Pragma("unroll") for (int i = 0; i < 8; ++i) { const u32x2 t_ = *(const u32x2*)(KCp + (size_t)soff[i] + (size_t)(2 * (st)) * 256); R[i] = (u32x4){t_.x, t_.y, 0u, 0u}; } } \
        else { _Pragma("unroll") for (int i = 0; i < 8; ++i) R[i] = __builtin_nontemporal_load((const u32x4*)(cache_kv + (size_t)soff[i] + (size_t)(2 * (st)) * 512)); } } while (0)
#define CMP_ASTORE(R, st, buf) do { LAS unsigned char* A_ = lds + (buf) * CA_BUF + l_dst; \
        if (prompt) { _Pragma("unroll") for (int i = 0; i < 8; ++i) { u32x2 w_; w_.x = R[i].x; w_.y = R[i].y; *(LAS u32x2*)(A_ + 16 * i * CA_RS) = w_; } } \
        else { const f32x4 pv_ = *(const f32x4*)(pep + (2 * (st)) * 64); _Pragma("unroll") for (int i = 0; i < 8; ++i) { const f32x4 v_ = __builtin_bit_cast(f32x4, R[i]) + pv_; u32x2 w_; w_.x = cvtpk(v_.x, v_.y); w_.y = cvtpk(v_.z, v_.w); *(LAS u32x2*)(A_ + 16 * i * CA_RS) = w_; } } } while (0)
#define CMP_BLOAD(R, st) do { _Pragma("unroll") for (int ks = 0; ks < 4; ++ks) R[ks] = *(const bf16x8*)(W1 + 128 * (st) + 32 * ks); } while (0)
#define CMP_COMPUTE(RB, buf) do { LAS const unsigned char* A_ = lds + (buf) * CA_BUF + c * CA_RS + 16 * q4; \
        _Pragma("unroll") for (int ks = 0; ks < 4; ++ks) _Pragma("unroll") for (int mt = 0; mt < 8; ++mt) acc[mt] = mfma16(*(LAS const bf16x8*)(A_ + 16 * mt * CA_RS + 64 * ks), RB[ks], acc[mt]); } while (0)
    CMP_BLOAD(rb0, 0); CMP_ALOAD(ra0, 0); CMP_ALOAD(ra1, 1);
    CMP_ASTORE(ra0, 0, 0);
    __syncthreads();
    for (int s2 = 0; s2 < 32; s2 += 2) {
        CMP_BLOAD(rb1, s2 + 1);
        if (s2 + 2 < 32) CMP_ALOAD(ra0, s2 + 2);
        CMP_COMPUTE(rb0, 0);
        CMP_ASTORE(ra1, s2 + 1, 1);
        __syncthreads();
        if (s2 + 2 < 32) CMP_BLOAD(rb0, s2 + 2);
        if (s2 + 3 < 32) CMP_ALOAD(ra1, s2 + 3);
        CMP_COMPUTE(rb1, 1);
        if (s2 + 2 < 32) CMP_ASTORE(ra0, s2 + 2, 0);
        __syncthreads();
    }
#undef CMP_ALOAD
#undef CMP_ASTORE
#undef CMP_BLOAD
#undef CMP_COMPUTE
    {
        LAS unsigned short* H = (LAS unsigned short*)(lds + CL_H);
#pragma unroll
        for (int mt = 0; mt < 8; ++mt)
#pragma unroll
            for (int e = 0; e < 4; ++e) { const float v = siluf_(acc[mt][e]); H[(16 * mt + 4 * q4 + e) * (CH_RS / 2) + 16 * w + c] = (unsigned short)(cvtpk(v, 0.f) & 0xffffu); }
    }
    __syncthreads();
    {
        const int ot = w & 3, mt0 = 4 * (w >> 2);
        const bf16* W2 = (const bf16*)(ws + WS_W2) + (size_t)kind * 64 * 128 + (size_t)(16 * ot + c) * 128 + 8 * q4;
        LAS const unsigned char* H = lds + CL_H + (16 * mt0 + c) * CH_RS + 16 * q4;
        f32x4 o[4];
#pragma unroll
        for (int mt = 0; mt < 4; ++mt) o[mt] = (f32x4){0.f, 0.f, 0.f, 0.f};
#pragma unroll
        for (int ks = 0; ks < 4; ++ks) { const bf16x8 bw = *(const bf16x8*)(W2 + 32 * ks);
#pragma unroll
            for (int mt = 0; mt < 4; ++mt) o[mt] = mfma16(*(LAS const bf16x8*)(H + 16 * mt * CH_RS + 64 * ks), bw, o[mt]); }
        LAS float* O = (LAS float*)(lds + CL_O);
#pragma unroll
        for (int mt = 0; mt < 4; ++mt)
#pragma unroll
            for (int e = 0; e < 4; ++e) O[(16 * (mt0 + mt) + 4 * q4 + e) * (CO_RS / 4) + 16 * ot + c] = o[mt][e];
    }
    __syncthreads();
#pragma unroll
    for (int rep = 0; rep < 2; ++rep) {
        const int id = rep * 512 + tid, row = id >> 3, seg = id & 7;
        LAS const float* O = (LAS const float*)(lds + CL_O) + row * (CO_RS / 4) + 8 * seg;
        f32x4 a = *(LAS const f32x4*)O, b = *(LAS const f32x4*)(O + 4);
        if (kind == 0) { float ss = (a.x * a.x + a.y * a.y) + (a.z * a.z + a.w * a.w) + (b.x * b.x + b.y * b.y) + (b.z * b.z + b.w * b.w);
            ss += __shfl_xor(ss, 1); ss += __shfl_xor(ss, 2); ss += __shfl_xor(ss, 4);
            const float rs = 1.0f / sqrtf(ss * (1.f / 64.f) + EPS);
            a = a * rs * *(const f32x4*)(k_gain + 8 * seg); b = b * rs * *(const f32x4*)(k_gain + 8 * seg + 4); }
        float* dst = (float*)(ws + (kind == 0 ? WS_KCMP : WS_VCMP)) + ((size_t)(64 * ci + (row >> 1)) * 2 + (row & 1)) * 64 + 8 * seg;
        *(f32x4*)dst = a; *(f32x4*)(dst + 4) = b;
    }
    __syncthreads();
}

constexpr int HG_QH = 0, HG_QT = KVT, HG_KT = 2 * KVT, HG_KH = 3 * KVT, HG_V = 4 * KVT, HG_CUM = 5 * KVT, HG_GRS = 272, HG_REF = HG_CUM + 64 * HG_GRS, HG_LASTV = HG_REF + 256, HG_LAST = HG_LASTV + 256, HG_HALF = HG_LAST + 256;
constexpr int HG_GLB = HG_QT;
static_assert(64 * HG_GRS <= 2 * KVT && 2 * HG_HALF <= LDS_CTLW, "hgrn LDS map");
__device__ __forceinline__ void hgrn_local_item(LAS unsigned char* lds_all, unsigned char* ws, int item, int tid) {
    const int half = tid >> 8, lt = tid & 255, lane = tid & 63, we = __builtin_amdgcn_readfirstlane((tid >> 6) & 3), c = lane & 15, q4 = lane >> 4;
    LAS unsigned char* lds = lds_all + half * HG_HALF;
    const int unit = 2 * item + half, b = unit >> 7, h = (unit >> 4) & 7, sc = unit & 15;
    const size_t T0 = (size_t)b * SEQ + 256 * sc; const int hc = 64 * h;
    const bf16* RQ = (const bf16*)(ws + WS_RQ); const bf16* RK = (const bf16*)(ws + WS_RK); const bf16* RV = (const bf16*)(ws + WS_RV); const float* GL = (const float*)(ws + WS_GL);
    bf16* OLOC = (bf16*)(ws + WS_OLOC); bf16* QH = (bf16*)(ws + WS_QH);
    LAS float* LASTE = (LAS float*)(lds + HG_LAST);
    const int gp = lt & 15, gtb = lt >> 4, op = lt & 7, otb = lt >> 3;
    const int pd = lt & 63, ptq = lt >> 6;
    f32x4 S[4];
#pragma unroll
    for (int dt = 0; dt < 4; ++dt) S[dt] = (f32x4){0.f, 0.f, 0.f, 0.f};
    float base8[8];
#pragma unroll
    for (int j = 0; j < 8; ++j) base8[j] = 0.f;
    f32x4 gl_r[4]; u32x4 q_r[2], k_r[2], v_r[2];
#define HG_PREFETCH(cc_) do { const size_t R_ = T0 + 64 * (cc_); \
        _Pragma("unroll") for (int i = 0; i < 4; ++i) gl_r[i] = *(const f32x4*)(GL + (R_ + gtb + 16 * i) * 512 + hc + 4 * gp); \
        _Pragma("unroll") for (int i = 0; i < 2; ++i) { const size_t g_ = (R_ + otb + 32 * i) * 512 + hc + 8 * op; q_r[i] = *(const u32x4*)(RQ + g_); k_r[i] = *(const u32x4*)(RK + g_); v_r[i] = *(const u32x4*)(RV + g_); } } while (0)
    HG_PREFETCH(0);
    for (int cc = 0; cc < 4; ++cc) {
        const size_t R0 = T0 + 64 * cc;
#pragma unroll
        for (int i = 0; i < 4; ++i) *(LAS f32x4*)(lds + HG_GLB + (gtb + 16 * i) * HG_GRS + 16 * gp) = gl_r[i];
#pragma unroll
        for (int i = 0; i < 2; ++i) *(LAS u32x4*)(lds + HG_V + (otb + 32 * i) * KVS + 16 * op) = v_r[i];
        u32x4 qc[2], kc[2];
#pragma unroll
        for (int i = 0; i < 2; ++i) { qc[i] = q_r[i]; kc[i] = k_r[i]; }
        if (cc + 1 < 4) HG_PREFETCH(cc + 1);
        __syncthreads();
        {
            float run = 0.f;
            for (int t = 0; t < 16 * ptq; ++t) run += *(LAS const float*)(lds + HG_GLB + t * HG_GRS + 4 * pd);
#pragma unroll
            for (int i = 0; i < 16; ++i) { const int t = 16 * ptq + i; run += *(LAS const float*)(lds + HG_GLB + t * HG_GRS + 4 * pd); *(LAS float*)(lds + HG_CUM + t * HG_GRS + 4 * pd) = run; }
            if (ptq == 1) *(LAS float*)(lds + HG_REF + 4 * pd) = run;
            if (ptq == 3) { *(LAS float*)(lds + HG_LASTV + 4 * pd) = run; LASTE[pd] = __expf(run); }
        }
        __syncthreads();
        {
            const f32x4 rf0 = *(LAS const f32x4*)(lds + HG_REF + 32 * op), rf1 = *(LAS const f32x4*)(lds + HG_REF + 32 * op + 16);
            const f32x4 la0 = *(LAS const f32x4*)(lds + HG_LASTV + 32 * op), la1 = *(LAS const f32x4*)(lds + HG_LASTV + 32 * op + 16);
#pragma unroll
            for (int i = 0; i < 2; ++i) { const int t = otb + 32 * i;
                const f32x4 cu0 = *(LAS const f32x4*)(lds + HG_CUM + t * HG_GRS + 32 * op), cu1 = *(LAS const f32x4*)(lds + HG_CUM + t * HG_GRS + 32 * op + 16);
                float qh[8], qt[8], kt[8], kh[8], qg[8];
#pragma unroll
                for (int j = 0; j < 8; ++j) { const float cum = j < 4 ? cu0[j] : cu1[j - 4], ref = j < 4 ? rf0[j] : rf1[j - 4], last = j < 4 ? la0[j] : la1[j - 4];
                    const unsigned qw = qc[i][j >> 1], kw = kc[i][j >> 1];
                    const float q = __builtin_bit_cast(float, (j & 1) ? (qw & 0xffff0000u) : (qw << 16)), k = __builtin_bit_cast(float, (j & 1) ? (kw & 0xffff0000u) : (kw << 16));
                    const float dq = fminf(fmaxf(cum - ref, -60.f), 60.f);
                    qh[j] = q * __expf(cum); qt[j] = q * __expf(dq); kt[j] = k * __expf(-dq); kh[j] = k * __expf(last - cum); qg[j] = q * __expf(base8[j] + cum); }
                const int lo = t * KVS + 16 * op;
                *(LAS bf16x8*)(lds + HG_QH + lo) = pack8((f32x4){qh[0], qh[1], qh[2], qh[3]}, (f32x4){qh[4], qh[5], qh[6], qh[7]});
                *(LAS bf16x8*)(lds + HG_QT + lo) = pack8((f32x4){qt[0], qt[1], qt[2], qt[3]}, (f32x4){qt[4], qt[5], qt[6], qt[7]});
                *(LAS bf16x8*)(lds + HG_KT + lo) = pack8((f32x4){kt[0], kt[1], kt[2], kt[3]}, (f32x4){kt[4], kt[5], kt[6], kt[7]});
                *(LAS bf16x8*)(lds + HG_KH + lo) = pack8((f32x4){kh[0], kh[1], kh[2], kh[3]}, (f32x4){kh[4], kh[5], kh[6], kh[7]});
                *(bf16x8*)(QH + (R0 + t) * 512 + hc + 8 * op) = pack8((f32x4){qg[0], qg[1], qg[2], qg[3]}, (f32x4){qg[4], qg[5], qg[6], qg[7]}); }
#pragma unroll
            for (int j = 0; j < 8; ++j) base8[j] += j < 4 ? la0[j] : la1[j - 4];
        }
        __syncthreads();
        f32x4 at[4][4];
#pragma unroll
        for (int tt = 0; tt < 4; ++tt) {
            const bf16x8 qa = *(LAS const bf16x8*)(lds + HG_QT + (16 * tt + c) * KVS + 16 * q4), qb = *(LAS const bf16x8*)(lds + HG_QT + (16 * tt + c) * KVS + 64 + 16 * q4);
#pragma unroll
            for (int st = 0; st < 4; ++st) {
                if (st <= tt) {
                    const bf16x8 ka = *(LAS const bf16x8*)(lds + HG_KT + (16 * st + c) * KVS + 16 * q4), kb = *(LAS const bf16x8*)(lds + HG_KT + (16 * st + c) * KVS + 64 + 16 * q4);
                    f32x4 a = mfma16(kb, qb, mfma16(ka, qa, (f32x4){0.f, 0.f, 0.f, 0.f}));
                    if (st == tt) {
#pragma unroll
                        for (int i = 0; i < 4; ++i) a[i] = (4 * q4 + i <= c) ? a[i] : 0.f; }
                    at[st][tt] = a;
                } else at[st][tt] = (f32x4){0.f, 0.f, 0.f, 0.f};
            }
        }
        const int vrow = 4 * q4 + (c >> 2), vcol = 8 * (c & 3);
        f32x4 o[4];
#pragma unroll
        for (int tt = 0; tt < 4; ++tt) o[tt] = (f32x4){0.f, 0.f, 0.f, 0.f};
#pragma unroll
        for (int s2 = 0; s2 < 2; ++s2) {
            const bf16x8 vf = cat44(ldtr(lds + HG_V + (32 * s2 + vrow) * KVS + 32 * we + vcol), ldtr(lds + HG_V + (32 * s2 + 16 + vrow) * KVS + 32 * we + vcol));
#pragma unroll
            for (int tt = 0; tt < 4; ++tt) if (2 * s2 <= tt) o[tt] = mfma16(vf, pack8(at[2 * s2][tt], at[2 * s2 + 1][tt]), o[tt]);
        }
#pragma unroll
        for (int ks = 0; ks < 2; ++ks) {
            const bf16x8 sf = pack8(S[2 * ks], S[2 * ks + 1]);
#pragma unroll
            for (int tt = 0; tt < 4; ++tt) {
                const bf16x8 qh = cat44(*(LAS const bf16x4*)(lds + HG_QH + (16 * tt + c) * KVS + 64 * ks + 8 * q4), *(LAS const bf16x4*)(lds + HG_QH + (16 * tt + c) * KVS + 64 * ks + 32 + 8 * q4));
                o[tt] = mfma16(sf, qh, o[tt]);
            }
        }
#pragma unroll
        for (int tt = 0; tt < 4; ++tt) { u32x2 ow; ow.x = cvtpk(o[tt].x, o[tt].y); ow.y = cvtpk(o[tt].z, o[tt].w); *(u32x2*)(OLOC + (R0 + 16 * tt + c) * 512 + hc + 16 * we + 4 * q4) = ow; }
        const int srow = 8 * q4 + (c >> 2);
#pragma unroll
        for (int dt = 0; dt < 4; ++dt) { const f32x4 dec = *(LAS const f32x4*)(LASTE + 16 * dt + 4 * q4); S[dt] = S[dt] * dec; }
#pragma unroll
        for (int s2 = 0; s2 < 2; ++s2) {
            const bf16x8 vb = cat44(ldtr(lds + HG_V + (32 * s2 + srow) * KVS + 32 * we + vcol), ldtr(lds + HG_V + (32 * s2 + 4 + srow) * KVS + 32 * we + vcol));
#pragma unroll
            for (int dt = 0; dt < 4; ++dt) {
                const bf16x8 ka = cat44(ldtr(lds + HG_KH + (32 * s2 + srow) * KVS + 32 * dt + vcol), ldtr(lds + HG_KH + (32 * s2 + 4 + srow) * KVS + 32 * dt + vcol));
                S[dt] = mfma16(ka, vb, S[dt]);
            }
        }
        __syncthreads();
    }
    float* TS = (float*)(ws + WS_TSC) + (size_t)unit * 4096;
#pragma unroll
    for (int dt = 0; dt < 4; ++dt)
#pragma unroll
        for (int i = 0; i < 4; ++i) TS[(16 * dt + 4 * q4 + i) * 64 + 16 * we + c] = S[dt][i];
    if (otb == 0) {
#pragma unroll
        for (int j = 0; j < 8; ++j) ((float*)(ws + WS_DSC))[unit * 64 + 8 * op + j] = __expf(base8[j]); }
#undef HG_PREFETCH
}

__device__ __forceinline__ void hgrn_combine_unit(LAS unsigned char* lds, unsigned char* ws, float* out, const float* rnn_gain, int unit, int tid) {
    const int lane = tid & 63, w = __builtin_amdgcn_readfirstlane(tid >> 6), c = lane & 15, q4 = lane >> 4;
    const int b = unit >> 7, h = (unit >> 4) & 7, sc = unit & 15, hc = 64 * h;
    const size_t T0 = (size_t)b * SEQ + 256 * sc;
    const float* TSC = (const float*)(ws + WS_TSC); const float* DSC = (const float*)(ws + WS_DSC);
    {
        const int d = tid >> 3, e0 = 8 * (tid & 7);
        f32x4 c0 = (f32x4){0.f, 0.f, 0.f, 0.f}, c1 = c0;
        for (int j0 = 0; j0 < sc; j0 += 8) {
            float dj[8]; f32x4 ta[8], tb[8];
#pragma unroll
            for (int q = 0; q < 8; ++q) { const int j = j0 + q < sc ? j0 + q : sc - 1; const int u = unit - sc + j; dj[q] = DSC[u * 64 + d]; const float* tp = TSC + (size_t)u * 4096 + d * 64 + e0; ta[q] = *(const f32x4*)tp; tb[q] = *(const f32x4*)(tp + 4); }
#pragma unroll
            for (int q = 0; q < 8; ++q) if (j0 + q < sc) { c0 = c0 * dj[q] + ta[q]; c1 = c1 * dj[q] + tb[q]; }
        }
        if (sc == 15) { const float dj = DSC[unit * 64 + d]; const float* tp = TSC + (size_t)unit * 4096 + d * 64 + e0; float* op = out + O_RNNP + (size_t)(b * 8 + h) * 4096 + d * 64 + e0;
            *(f32x4*)op = c0 * dj + *(const f32x4*)tp; *(f32x4*)(op + 4) = c1 * dj + *(const f32x4*)(tp + 4); }
        LAS unsigned short* CT = (LAS unsigned short*)lds;
#pragma unroll
        for (int i = 0; i < 4; ++i) { CT[(e0 + i) * (KVS / 2) + d] = (unsigned short)(cvtpk(c0[i], 0.f) & 0xffffu); CT[(e0 + 4 + i) * (KVS / 2) + d] = (unsigned short)(cvtpk(c1[i], 0.f) & 0xffffu); }
    }
    __syncthreads();
    const bf16* QH = (const bf16*)(ws + WS_QH); const bf16* OLOC = (const bf16*)(ws + WS_OLOC); const bf16* RG = (const bf16*)(ws + WS_RG); bf16* OA = (bf16*)(ws + WS_OA);
    bf16x8 ctf[4][2];
#pragma unroll
    for (int et = 0; et < 4; ++et)
#pragma unroll
        for (int ks = 0; ks < 2; ++ks) ctf[et][ks] = *(LAS const bf16x8*)(lds + (16 * et + c) * KVS + 64 * ks + 16 * q4);
    bf16x8 qh0[2], qh1[2]; u32x2 olw[2][4], rgw[2][4];
#pragma unroll
    for (int tt = 0; tt < 2; ++tt) { const size_t row = T0 + 32 * w + 16 * tt + c;
        qh0[tt] = *(const bf16x8*)(QH + row * 512 + hc + 8 * q4); qh1[tt] = *(const bf16x8*)(QH + row * 512 + hc + 32 + 8 * q4);
#pragma unroll
        for (int et = 0; et < 4; ++et) { olw[tt][et] = *(const u32x2*)(OLOC + row * 512 + hc + 16 * et + 4 * q4); rgw[tt][et] = *(const u32x2*)(RG + row * 512 + hc + 16 * et + 4 * q4); } }
    f32x4 gnv[4];
#pragma unroll
    for (int et = 0; et < 4; ++et) gnv[et] = *(const f32x4*)(rnn_gain + hc + 16 * et + 4 * q4);
#pragma unroll
    for (int tt = 0; tt < 2; ++tt) {
        const size_t row = T0 + 32 * w + 16 * tt + c;
        f32x4 o[4]; float ss = 0.f;
#pragma unroll
        for (int et = 0; et < 4; ++et) { const u32x2 lw = olw[tt][et];
            const f32x4 ol = (f32x4){__builtin_bit_cast(float, lw.x << 16), __builtin_bit_cast(float, lw.x & 0xffff0000u), __builtin_bit_cast(float, lw.y << 16), __builtin_bit_cast(float, lw.y & 0xffff0000u)};
            o[et] = mfma16(ctf[et][1], qh1[tt], mfma16(ctf[et][0], qh0[tt], ol));
            ss += (o[et].x * o[et].x + o[et].y * o[et].y) + (o[et].z * o[et].z + o[et].w * o[et].w); }
        ss += __shfl_xor(ss, 16); ss += __shfl_xor(ss, 32);
        const float rs = __builtin_amdgcn_rsqf(ss * (1.f / 64.f) + EPS);
#pragma unroll
        for (int et = 0; et < 4; ++et) { const int col = hc + 16 * et + 4 * q4; const u32x2 gw = rgw[tt][et];
            const f32x4 gg = (f32x4){__builtin_bit_cast(float, gw.x << 16), __builtin_bit_cast(float, gw.x & 0xffff0000u), __builtin_bit_cast(float, gw.y << 16), __builtin_bit_cast(float, gw.y & 0xffff0000u)};
            const f32x4 v = o[et] * rs * gnv[et] * gg;
            u32x2 wv; wv.x = cvtpk(v.x, v.y); wv.y = cvtpk(v.z, v.w); *(u32x2*)(OA + row * 1024 + 512 + col) = wv; }
    }
    __syncthreads();
}

__device__ __forceinline__ void rnn_sample_wave(unsigned char* ws, float* out, const float* state_rnn, const float* rnn_gain, int bh, int lane) {
    const int b = bh >> 3, h = bh & 7, hc = 64 * h;
    const float* sp = state_rnn + (size_t)bh * 4096 + lane; float* op = out + O_RNNS + (size_t)bh * 4096 + lane;
    float S[64];
#pragma unroll
    for (int d = 0; d < 64; ++d) S[d] = __builtin_nontemporal_load(sp + d * 64);
    const bf16* RQ = (const bf16*)(ws + WS_RQ); const bf16* RK = (const bf16*)(ws + WS_RK); const bf16* RV = (const bf16*)(ws + WS_RV); const bf16* RG = (const bf16*)(ws + WS_RG);
    const float* GL = (const float*)(ws + WS_GL); bf16* OA = (bf16*)(ws + WS_OA);
    float f8[DECT], k8[DECT], q8[DECT], v8[DECT], g8[DECT];
#pragma unroll
    for (int t = 0; t < DECT; ++t) { const size_t gi = ((size_t)MP + b * DECT + t) * 512 + hc + lane; f8[t] = GL[gi]; k8[t] = bf2f(RK[gi]); q8[t] = bf2f(RQ[gi]); v8[t] = bf2f(RV[gi]); g8[t] = bf2f(RG[gi]); }
    const float gn = rnn_gain[hc + lane];
#pragma unroll
    for (int t = 0; t < DECT; ++t) {
        const float f = __expf(f8[t]), k = k8[t], q = q8[t], v = v8[t];
        float o = 0.f;
#pragma unroll
        for (int d = 0; d < 64; ++d) { const float fd = __builtin_bit_cast(float, __builtin_amdgcn_readlane(__builtin_bit_cast(int, f), d)), kd = __builtin_bit_cast(float, __builtin_amdgcn_readlane(__builtin_bit_cast(int, k), d)),
                qd = __builtin_bit_cast(float, __builtin_amdgcn_readlane(__builtin_bit_cast(int, q), d)); S[d] = fd * S[d] + kd * v; o += qd * S[d]; }
        const float rs = __builtin_amdgcn_rsqf(wave_sum(o * o) * (1.f / 64.f) + EPS);
        const float y = o * rs * gn * g8[t];
        OA[((size_t)MP + b * DECT + t) * 1024 + 512 + hc + lane] = (unsigned short)(cvtpk(y, 0.f) & 0xffffu);
    }
#pragma unroll
    for (int d = 0; d < 64; ++d) __builtin_nontemporal_store(S[d], op + d * 64);
}


template <int RS, bool WINDOW>
__device__ __forceinline__ void samp_tile_f32(AttnSt& st, const bf16x8 (&qf)[2][2], const float* kp, int kpos0, int qpos, float sl0, float sl1, bool blocksel, LAS unsigned char* Vw, int lane, int c, int q4, float* cpy = nullptr, int row0 = 0) {
    f32x4 s[2][4];
    const float* vb = kp + (size_t)(lane >> 4) * RS + 128 + 4 * (lane & 15);
    const float* kb = kp + (size_t)c * RS + 8 * q4;
    LAS unsigned char* vd = Vw + (lane >> 4) * KVS + 8 * (lane & 15);
    f32x4 va[4];
#define SAMP_VLOAD(B) _Pragma("unroll") for (int it = 0; it < 4; ++it) va[it] = __builtin_nontemporal_load((const f32x4*)(vb + (size_t)(4 * (B) + it) * 4 * RS))
#define SAMP_VSTORE(B) _Pragma("unroll") for (int it = 0; it < 4; ++it) { u32x2 wv; wv.x = cvtpk(va[it].x, va[it].y); wv.y = cvtpk(va[it].z, va[it].w); *(LAS u32x2*)(vd + (4 * (B) + it) * 4 * KVS) = wv; \
        if (WINDOW && cpy) { const int r_ = row0 + 4 * (4 * (B) + it) + (lane >> 4) - 8; if (r_ >= 0) __builtin_nontemporal_store(va[it], (f32x4*)(cpy + (size_t)r_ * 256 + 128 + 4 * (lane & 15))); } }
#pragma unroll
    for (int kt4 = 0; kt4 < 4; ++kt4) {
        SAMP_VLOAD(kt4);
        f32x4 kl[2][2];
#pragma unroll
        for (int ks = 0; ks < 2; ++ks) { const float* p = kb + (size_t)(16 * kt4) * RS + 32 * ks; kl[ks][0] = __builtin_nontemporal_load((const f32x4*)p); kl[ks][1] = __builtin_nontemporal_load((const f32x4*)(p + 4)); }
        const bf16x8 k0 = pack8(kl[0][0], kl[0][1]), k1 = pack8(kl[1][0], kl[1][1]);
        if (WINDOW && cpy) { const int r_ = row0 + 16 * kt4 + c - 8; if (r_ >= 0) { float* d_ = cpy + (size_t)r_ * 256 + 8 * q4; __builtin_nontemporal_store(kl[0][0], (f32x4*)d_); __builtin_nontemporal_store(kl[0][1], (f32x4*)(d_ + 4)); __builtin_nontemporal_store(kl[1][0], (f32x4*)(d_ + 32)); __builtin_nontemporal_store(kl[1][1], (f32x4*)(d_ + 36)); } }
#pragma unroll
        for (int qt2 = 0; qt2 < 2; ++qt2) s[qt2][kt4] = mfma16(k1, qf[qt2][1], mfma16(k0, qf[qt2][0], (f32x4){0.f, 0.f, 0.f, 0.f}));
        SAMP_VSTORE(kt4);
        asm volatile("" ::: "memory");
    }
#undef SAMP_VLOAD
#undef SAMP_VSTORE
#pragma unroll
    for (int qt2 = 0; qt2 < 2; ++qt2)
#pragma unroll
        for (int kt4 = 0; kt4 < 4; ++kt4)
#pragma unroll
            for (int e = 0; e < 4; ++e) { const int dist = qpos - (kpos0 + 16 * kt4 + 4 * q4 + e);
                const bool ok = WINDOW ? (dist >= 0 && dist < 512) : (blocksel && dist >= 0);
                s[qt2][kt4][e] = ok ? s[qt2][kt4][e] * SL2 - (qt2 ? sl1 : sl0) * (float)dist - MFIX : -__builtin_inff(); }
    attn_update_fixed<true>(st, s, Vw, c, q4);
}
__device__ __forceinline__ void samp_tile_new(AttnSt& st, const bf16x8 (&qf)[2][2], const bf16* base  , int ti, float sl0, float sl1, bool blocksel, LAS unsigned char* Vw, int lane, int c, int q4) {
    bf16x8 kf[2]; const bf16x8 z8 = (bf16x8){0, 0, 0, 0, 0, 0, 0, 0};
#pragma unroll
    for (int ks = 0; ks < 2; ++ks) kf[ks] = (c < 8) ? *(const bf16x8*)(base + (size_t)c * 256 + 32 * ks + 8 * q4) : z8;
#pragma unroll
    for (int it = 0; it < 8; ++it) { const int idx = it * 64 + lane, row = idx >> 3, pc = idx & 7;
        const u32x4 v = (row < 8) ? *(const u32x4*)(base + (size_t)row * 256 + 128 + 8 * pc) : (u32x4){0u, 0u, 0u, 0u};
        *(LAS u32x4*)(Vw + row * KVS + 16 * pc) = v; }
    f32x4 s[2][4];
#pragma unroll
    for (int qt2 = 0; qt2 < 2; ++qt2) { s[qt2][0] = mfma16(kf[1], qf[qt2][1], mfma16(kf[0], qf[qt2][0], (f32x4){0.f, 0.f, 0.f, 0.f}));
#pragma unroll
        for (int kt4 = 1; kt4 < 4; ++kt4) s[qt2][kt4] = (f32x4){-__builtin_inff(), -__builtin_inff(), -__builtin_inff(), -__builtin_inff()};
#pragma unroll
        for (int e = 0; e < 4; ++e) { const int key = 4 * q4 + e, dist = ti - key;
            const bool ok = key < 8 && dist >= 0 && blocksel;
            s[qt2][0][e] = ok ? s[qt2][0][e] * SL2 - (qt2 ? sl1 : sl0) * (float)dist - MFIX : -__builtin_inff(); } }
    attn_update_fixed<true>(st, s, Vw, c, q4);
}

constexpr int SA_V = 0, SA_PART = 8 * KVT  , SA_ML = SA_PART + 65536, SA_IMP = SA_ML + 2048, SA_SM = SA_IMP + 1024, SA_END = SA_SM + 64;
static_assert(SA_END <= LDS_CTLW, "sample attention LDS");
__device__ __forceinline__ void samp_attn_unit(LAS unsigned char* lds, unsigned char* ws, const float* cache_kv, const float* cache_win, const int* page_table, const float* attn_gain, float* wout, int unit, int tid) {
    const int lane = tid & 63, w = __builtin_amdgcn_readfirstlane(tid >> 6), c = lane & 15, q4 = lane >> 4;
    const int b = unit >> 1, g = unit & 1, ti = c & 7;
    const size_t srow = (size_t)MP + (size_t)b * DECT;
    float slope2[2]; int headq[2];
#pragma unroll
    for (int qt2 = 0; qt2 < 2; ++qt2) { headq[qt2] = 4 * g + 2 * qt2 + (c >> 3); slope2[qt2] = __builtin_amdgcn_exp2f(-(float)(headq[qt2] + 1)) * LOG2E; }
    const int qpos = PAST + ti;
    bf16x8 qf[2][2];
    { const bf16* Q = (const bf16*)(ws + WS_Q);
#pragma unroll
      for (int qt2 = 0; qt2 < 2; ++qt2)
#pragma unroll
          for (int ks = 0; ks < 2; ++ks) qf[qt2][ks] = *(const bf16x8*)(Q + (srow + ti) * 512 + 64 * headq[qt2] + 32 * ks + 8 * q4); }
    LAS unsigned char* Vw = lds + SA_V + w * KVT;
    LAS float* PART = (LAS float*)(lds + SA_PART); LAS float* ML = (LAS float*)(lds + SA_ML); LAS float* IMP = (LAS float*)(lds + SA_IMP);
    LAS unsigned long long* SM = (LAS unsigned long long*)(lds + SA_SM);
    const int frow = tid >> 4, fseg = tid & 15;

    auto write_partial = [&](AttnSt& st) {
#pragma unroll
        for (int qt2 = 0; qt2 < 2; ++qt2) { float l = st.l[qt2]; l += __shfl_xor(l, 16); l += __shfl_xor(l, 32);
            if (q4 == 0) { ML[(w * 32 + 16 * qt2 + c) * 2] = st.m[qt2]; ML[(w * 32 + 16 * qt2 + c) * 2 + 1] = l; }
#pragma unroll
            for (int dt = 0; dt < 4; ++dt) *(LAS f32x4*)(PART + (w * 32 + 16 * qt2 + c) * 64 + 16 * dt + 4 * q4) = st.o[dt][qt2]; }
    };
    auto combine = [&]() -> f32x4 {
        float M = -__builtin_inff();
#pragma unroll
        for (int ww = 0; ww < 8; ++ww) M = fmaxf(M, ML[(ww * 32 + frow) * 2]);
        float L = 0.f; f32x4 o = (f32x4){0.f, 0.f, 0.f, 0.f};
#pragma unroll
        for (int ww = 0; ww < 8; ++ww) { const float mw = ML[(ww * 32 + frow) * 2]; const float wgt = (mw == -__builtin_inff()) ? 0.f : __builtin_amdgcn_exp2f(mw - M);
            L += ML[(ww * 32 + frow) * 2 + 1] * wgt; o = o + *(LAS const f32x4*)(PART + (ww * 32 + frow) * 64 + 4 * fseg) * wgt; }
        return o * (L > 0.f ? 1.0f / L : 0.f);
    };

    f32x4 o_cmp;
    {
        const float* kc = (const float*)(ws + WS_KCMP) + ((size_t)(256 + b * 32) * 2 + g) * 64;
        const float* vc = (const float*)(ws + WS_VCMP) + ((size_t)(256 + b * 32) * 2 + g) * 64;
        bf16x8 kf[2][2];
#pragma unroll
        for (int kt4 = 0; kt4 < 2; ++kt4)
#pragma unroll
            for (int ks = 0; ks < 2; ++ks) { const float* p = kc + (size_t)(16 * kt4 + c) * 128 + 32 * ks + 8 * q4; kf[kt4][ks] = pack8(*(const f32x4*)p, *(const f32x4*)(p + 4)); }
#pragma unroll
        for (int it = 0; it < 16; ++it) { const int idx = it * 64 + lane, row = idx >> 4, pc = idx & 15;
            const f32x4 v = (row < 32) ? *(const f32x4*)(vc + (size_t)row * 128 + 4 * pc) : (f32x4){0.f, 0.f, 0.f, 0.f};
            u32x2 wv; wv.x = cvtpk(v.x, v.y); wv.y = cvtpk(v.z, v.w); *(LAS u32x2*)(Vw + row * KVS + 8 * pc) = wv; }
        f32x4 s[2][4]; AttnSt sc; attn_init(sc);
#pragma unroll
        for (int qt2 = 0; qt2 < 2; ++qt2) { float mx = -__builtin_inff();
#pragma unroll
            for (int kt4 = 0; kt4 < 2; ++kt4) { s[qt2][kt4] = mfma16(kf[kt4][1], qf[qt2][1], mfma16(kf[kt4][0], qf[qt2][0], (f32x4){0.f, 0.f, 0.f, 0.f}));
#pragma unroll
                for (int e = 0; e < 4; ++e) { const int dist = qpos - (64 * (16 * kt4 + 4 * q4 + e) + 63); const float x = s[qt2][kt4][e] * SL2 - slope2[qt2] * (float)dist; s[qt2][kt4][e] = x; mx = fmaxf(mx, x); } }
            s[qt2][2] = (f32x4){0.f, 0.f, 0.f, 0.f}; s[qt2][3] = (f32x4){0.f, 0.f, 0.f, 0.f};
            mx = fmaxf(mx, __shfl_xor(mx, 16)); mx = fmaxf(mx, __shfl_xor(mx, 32)); float ls = 0.f;
#pragma unroll
            for (int kt4 = 0; kt4 < 2; ++kt4)
#pragma unroll
                for (int e = 0; e < 4; ++e) { const float p = __builtin_amdgcn_exp2f(s[qt2][kt4][e] - mx); s[qt2][kt4][e] = p; ls += p; }
            ls += __shfl_xor(ls, 16); ls += __shfl_xor(ls, 32); const float il = 1.0f / ls;
            s[qt2][0] = s[qt2][0] * il; s[qt2][1] = s[qt2][1] * il; }
#pragma unroll
        for (int kt4 = 0; kt4 < 2; ++kt4) { f32x4 a = s[0][kt4] + s[1][kt4];
#pragma unroll
            for (int e = 0; e < 4; ++e) a[e] += __shfl_xor(a[e], 8);
            if (w == 0 && c < 8) *(LAS f32x4*)(IMP + c * 32 + 16 * kt4 + 4 * q4) = a; }
        attn_pv_lean(sc.o, s, Vw, c, q4);
        if (w == 0) {
#pragma unroll
            for (int qt2 = 0; qt2 < 2; ++qt2)
#pragma unroll
                for (int dt = 0; dt < 4; ++dt) *(LAS f32x4*)(PART + (16 * qt2 + c) * 64 + 16 * dt + 4 * q4) = sc.o[dt][qt2]; }
    }
    __syncthreads();
    o_cmp = *(LAS const f32x4*)(PART + frow * 64 + 4 * fseg);
    {
        bool sel = false; const int j = lane;
        if (j == 0 || j == 32) sel = true;
        else if (j < 32) { const float vj = IMP[w * 32 + j]; int cnt = 0;
            for (int i = 1; i < 32; ++i) { const float vi = IMP[w * 32 + i]; cnt += (vi > vj || (vi == vj && i < j)) ? 1 : 0; }
            sel = cnt < 14; }
        const unsigned long long bm = __ballot(sel);
        if (lane == 0) SM[w] = bm;
    }
    __syncthreads();
    const unsigned long long mymask = SM[ti];
    unsigned long long um = 0ull;
#pragma unroll
    for (int i = 0; i < 8; ++i) um |= SM[i];
    um = ((unsigned long long)__builtin_amdgcn_readfirstlane((unsigned)(um >> 32)) << 32) | (unsigned)__builtin_amdgcn_readfirstlane((unsigned)um);
    f32x4 o_win, o_sel;
    {
        AttnSt st; attn_init(st);
        const float* wb = cache_win + (size_t)b * 512 * 256 + 64 * g;
        samp_tile_f32<256, true>(st, qf, wb + (size_t)(64 * w) * 256, PAST - 512 + 64 * w, qpos, slope2[0], slope2[1], true, Vw, lane, c, q4, wout + (size_t)b * 512 * 256 + 64 * g, 64 * w);
        if (w == 0) samp_tile_new(st, qf, (const bf16*)(ws + WS_KW) + srow * 256 + 64 * g, ti, slope2[0], slope2[1], true, Vw, lane, c, q4);
        write_partial(st);
    }
    __syncthreads();
    o_win = combine();
    __syncthreads();
    {
        AttnSt st; attn_init(st);
        unsigned long long rem = um; int idx = 0;
        while (rem) { const int j = __builtin_ctzll(rem); rem &= rem - 1;
            if ((idx & 7) == w) {
                const bool bit = (mymask >> j) & 1ull;
                if (j < 32) { const int page = page_table[b * NPAGES + (j >> 1)];
                    samp_tile_f32<512, false>(st, qf, cache_kv + ((size_t)page * PAGE + (j & 1) * 64) * 512 + 256 + 64 * g, 64 * j, qpos, slope2[0], slope2[1], bit, Vw, lane, c, q4); }
                else samp_tile_new(st, qf, (const bf16*)(ws + WS_KS) + srow * 256 + 64 * g, ti, slope2[0], slope2[1], bit, Vw, lane, c, q4);
            }
            ++idx; }
        write_partial(st);
    }
    __syncthreads();
    o_sel = combine();
    {
        const int qt2 = frow >> 4, cc = frow & 15, head = 4 * g + 2 * qt2 + (cc >> 3); const size_t row = srow + (cc & 7);
        const float* GATES = (const float*)(ws + WS_GATES);
        const float g0 = GATES[row * 24 + head * 3], g1 = GATES[row * 24 + head * 3 + 1], g2 = GATES[row * 24 + head * 3 + 2];
        const f32x4 oa = o_cmp * g0 + o_sel * g1 + o_win * g2;
        float ss = (oa.x * oa.x + oa.y * oa.y) + (oa.z * oa.z + oa.w * oa.w);
        ss += __shfl_xor(ss, 1); ss += __shfl_xor(ss, 2); ss += __shfl_xor(ss, 4); ss += __shfl_xor(ss, 8);
        const float rs = 1.0f / sqrtf(ss * (1.f / 64.f) + EPS);
        const f32x4 v = oa * rs * *(const f32x4*)(attn_gain + 64 * head + 4 * fseg);
        u32x2 wv; wv.x = cvtpk(v.x, v.y); wv.y = cvtpk(v.z, v.w); *(u32x2*)((bf16*)(ws + WS_OA) + row * 1024 + 64 * head + 4 * fseg) = wv;
    }
    __syncthreads();
}

#define EPI_ROWS _Pragma("unroll") for (int ai = 0; ai < 2; ++ai) _Pragma("unroll") for (int m = 0; m < 4; ++m)
#define EPI_COLS _Pragma("unroll") for (int bj = 0; bj < 2; ++bj) _Pragma("unroll") for (int n = 0; n < 2; ++n)
struct EpiOut {
    unsigned char* ws; const float *xp, *xs;
    __device__ __forceinline__ void operator()(const f32x4 (&acc)[2][2][4][2], const pg8::Unit& u, int wr, int wc, int fr, int fq) const {
        const int rowb = u.pm * 256 + wr * 64 + fr, colb = u.pn * 256 + 32 * wc + 8 * fq;
        bf16* const HB = (bf16*)(ws + WS_XN); float* const ssq = (float*)(ws + CTL_SSQ);
        EPI_ROWS { const int row = rowb + 128 * ai + 16 * m; const float* xr = (row < MP) ? xp + (size_t)row * DM : xs + (size_t)(row - MP) * DM; float ss = 0.f;
#pragma unroll
            for (int bj = 0; bj < 2; ++bj) { const int col = colb + 128 * bj;
                const f32x4 h0 = acc[ai][bj][m][0] + __builtin_nontemporal_load((const f32x4*)(xr + col)), h1 = acc[ai][bj][m][1] + __builtin_nontemporal_load((const f32x4*)(xr + col + 4));
                ss += (h0.x * h0.x + h0.y * h0.y) + (h0.z * h0.z + h0.w * h0.w) + (h1.x * h1.x + h1.y * h1.y) + (h1.z * h1.z + h1.w * h1.w);
                u32x4 w; w.x = cvtpk(h0.x, h0.y); w.y = cvtpk(h0.z, h0.w); w.z = cvtpk(h1.x, h1.y); w.w = cvtpk(h1.z, h1.w); *(u32x4*)(HB + (size_t)row * DM + col) = w; }
            ss += __shfl_xor(ss, 16); ss += __shfl_xor(ss, 32);
            if (fq == 0) atomicAdd(ssq + row, ss); }
    }
};
struct EpiUp {
    unsigned char* ws;
    __device__ __forceinline__ void operator()(const f32x4 (&acc)[2][2][4][2], const pg8::Unit& u, int wr, int wc, int fr, int fq) const {
        const int rowb = u.pm * 256 + wr * 64 + fr, colb = u.pn * 256 + 32 * wc + 8 * fq;
        bf16* const U = (bf16*)(ws + WS_U);
        EPI_ROWS { const int row = rowb + 128 * ai + 16 * m;
#pragma unroll
            for (int bj = 0; bj < 2; ++bj) { f32x4 v0 = acc[ai][bj][m][0], v1 = acc[ai][bj][m][1];
                v0.x = fmaxf(v0.x, 0.f); v0.y = fmaxf(v0.y, 0.f); v0.z = fmaxf(v0.z, 0.f); v0.w = fmaxf(v0.w, 0.f); v0 = v0 * v0;
                v1.x = fmaxf(v1.x, 0.f); v1.y = fmaxf(v1.y, 0.f); v1.z = fmaxf(v1.z, 0.f); v1.w = fmaxf(v1.w, 0.f); v1 = v1 * v1;
                u32x4 w; w.x = cvtpk(v0.x, v0.y); w.y = cvtpk(v0.z, v0.w); w.z = cvtpk(v1.x, v1.y); w.w = cvtpk(v1.z, v1.w);
                *(u32x4*)(U + (size_t)row * DFF + colb + 128 * bj) = w; } }
    }
};
struct EpiDown {
    float* out; unsigned char* ws;
    __device__ __forceinline__ void operator()(const f32x4 (&acc)[2][2][4][2], const pg8::Unit& u, int wr, int wc, int fr, int fq) const {
        const int rowb = u.pm * 256 + wr * 64 + fr, colb = u.pn * 256 + 32 * wc + 8 * fq;
        const bf16* const HB = (const bf16*)(ws + WS_XN); const float* const ssq = (const float*)(ws + CTL_SSQ);
        EPI_ROWS { const int row = rowb + 128 * ai + 16 * m; const float rs2 = __builtin_amdgcn_rcpf(ssq[row] * (1.f / DM) + EPS);
#pragma unroll
            for (int bj = 0; bj < 2; ++bj) { const size_t o = (size_t)row * DM + colb + 128 * bj; const u32x4 hw = *(const u32x4*)(HB + o);
                const f32x4 h0 = (f32x4){__builtin_bit_cast(float, hw.x << 16), __builtin_bit_cast(float, hw.x & 0xffff0000u), __builtin_bit_cast(float, hw.y << 16), __builtin_bit_cast(float, hw.y & 0xffff0000u)};
                const f32x4 h1 = (f32x4){__builtin_bit_cast(float, hw.z << 16), __builtin_bit_cast(float, hw.z & 0xffff0000u), __builtin_bit_cast(float, hw.w << 16), __builtin_bit_cast(float, hw.w & 0xffff0000u)};
                __builtin_nontemporal_store(h0 + acc[ai][bj][m][0] * rs2, (f32x4*)(out + o)); __builtin_nontemporal_store(h1 + acc[ai][bj][m][1] * rs2, (f32x4*)(out + o + 4)); } }
    }
};
#undef EPI_ROWS
#undef EPI_COLS

template <int TN, int NH, int KS, class Epi>
__device__ __forceinline__ void small_gemm_tile(LAS unsigned char* lds, const bf16* A, int lda, const bf16* Bt, int ldb, int K, int row0, int col0, const Epi& E, int tid) {
    constexpr int WN = TN / NH / 16, PRS = (TN + 4) * 4;
    static_assert(NH * KS == 8 && KS * 64 * PRS <= LDS_CTLW, "small gemm geometry");
    const int lane = tid & 63, w = __builtin_amdgcn_readfirstlane(tid >> 6), nh = w % NH, ks = w / NH, fr = lane & 15, fq = lane >> 4;
    const int Kw = K / KS;
    const bf16* ap = A + (size_t)(row0 + fr) * lda + (size_t)ks * Kw + 8 * fq;
    const bf16* bp = Bt + (size_t)(col0 + 16 * WN * nh + fr) * ldb + (size_t)ks * Kw + 8 * fq;
    f32x4 acc[4][WN];
#pragma unroll
    for (int mt = 0; mt < 4; ++mt)
#pragma unroll
        for (int nt = 0; nt < WN; ++nt) acc[mt][nt] = (f32x4){0.f, 0.f, 0.f, 0.f};
    bf16x8 a0[2][4], b0[2][WN], a1[2][4], b1[2][WN];
#define SG_LOAD(A_, B_, kk) do { _Pragma("unroll") for (int u = 0; u < 2; ++u) { \
        _Pragma("unroll") for (int mt = 0; mt < 4; ++mt) A_[u][mt] = *(const bf16x8*)(ap + (size_t)(16 * mt) * lda + (kk) + 32 * u); \
        _Pragma("unroll") for (int nt = 0; nt < WN; ++nt) B_[u][nt] = *(const bf16x8*)(bp + (size_t)(16 * nt) * ldb + (kk) + 32 * u); } } while (0)
#define SG_MMA(A_, B_) do { _Pragma("unroll") for (int u = 0; u < 2; ++u) _Pragma("unroll") for (int mt = 0; mt < 4; ++mt) _Pragma("unroll") for (int nt = 0; nt < WN; ++nt) \
        acc[mt][nt] = mfma16(B_[u][nt], A_[u][mt], acc[mt][nt]); } while (0)
    SG_LOAD(a0, b0, 0);
    for (int k = 0; k < Kw; k += 128) {
        SG_LOAD(a1, b1, k + 64);
        SG_MMA(a0, b0);
        if (k + 128 < Kw) SG_LOAD(a0, b0, k + 128);
        SG_MMA(a1, b1);
    }
#undef SG_LOAD
#undef SG_MMA
    {
        LAS unsigned char* P = lds + ks * 64 * PRS + fr * PRS + (16 * WN * nh + 4 * fq) * 4;
#pragma unroll
        for (int mt = 0; mt < 4; ++mt)
#pragma unroll
            for (int nt = 0; nt < WN; ++nt) *(LAS f32x4*)(P + 16 * mt * PRS + 64 * nt) = acc[mt][nt];
    }
    __syncthreads();
    constexpr int C4 = TN / 4, ITEMS = 64 * C4;
#pragma unroll
    for (int rep = 0; rep < ITEMS / 512; ++rep) {
        const int id = rep * 512 + tid, r = id / C4, c4 = id % C4;
        f32x4 v = *(LAS const f32x4*)(lds + r * PRS + 16 * c4);
#pragma unroll
        for (int k2 = 1; k2 < KS; ++k2) v = v + *(LAS const f32x4*)(lds + k2 * 64 * PRS + r * PRS + 16 * c4);
        E.template run<C4>(v, row0 + r, col0 + 4 * c4);
    }
    __syncthreads();
}
struct SEpiOut {
    unsigned char* ws; const float* xs;
    template <int C4> __device__ __forceinline__ void run(const f32x4 v, int r, int cc) const {
        bf16* const HB = (bf16*)(ws + WS_XN); float* const ssq = (float*)(ws + CTL_SSQ);
        const int lc = (cc & ~31) + 8 * ((cc >> 2) & 3) + 4 * ((cc >> 4) & 1);
        const f32x4 h = v + *(const f32x4*)(xs + (size_t)(r - MP) * DM + lc);
        float ss = (h.x * h.x + h.y * h.y) + (h.z * h.z + h.w * h.w);
        u32x2 wv; wv.x = cvtpk(h.x, h.y); wv.y = cvtpk(h.z, h.w); *(u32x2*)(HB + (size_t)r * DM + lc) = wv;
#pragma unroll
        for (int o = 1; o < C4; o <<= 1) ss += __shfl_xor(ss, o);
        if ((threadIdx.x & (C4 - 1)) == 0) atomicAdd(ssq + r, ss);
    }
};
struct SEpiUp {
    unsigned char* ws;
    template <int C4> __device__ __forceinline__ void run(f32x4 v, int r, int cc) const {
        bf16* const U = (bf16*)(ws + WS_U);
        const int lc = (cc & ~31) + 8 * ((cc >> 2) & 3) + 4 * ((cc >> 4) & 1);
        v.x = fmaxf(v.x, 0.f); v.y = fmaxf(v.y, 0.f); v.z = fmaxf(v.z, 0.f); v.w = fmaxf(v.w, 0.f); v = v * v;
        u32x2 wv; wv.x = cvtpk(v.x, v.y); wv.y = cvtpk(v.z, v.w); *(u32x2*)(U + (size_t)r * DFF + lc) = wv;
    }
};
struct SEpiDown {
    float* out; unsigned char* ws;
    template <int C4> __device__ __forceinline__ void run(const f32x4 v, int r, int cc) const { const int lc = (cc & ~31) + 8 * ((cc >> 2) & 3) + 4 * ((cc >> 4) & 1); const size_t o = (size_t)r * DM + lc; const u32x2 hw = *(const u32x2*)((const bf16*)(ws + WS_XN) + o);
        const f32x4 h = (f32x4){__builtin_bit_cast(float, hw.x << 16), __builtin_bit_cast(float, hw.x & 0xffff0000u), __builtin_bit_cast(float, hw.y << 16), __builtin_bit_cast(float, hw.y & 0xffff0000u)};
        const float rs2 = __builtin_amdgcn_rcpf(((const float*)(ws + CTL_SSQ))[r] * (1.f / DM) + EPS);
        *(f32x4*)(out + o) = h + v * rs2; }
};

#ifdef MK_DEBUG
constexpr size_t CTL_DBG = 256 * 1024;
__device__ __forceinline__ void dbg_report(unsigned char* ws, float num, float den) { if (!(num >= 0.f)) num = 1e30f; atomicAdd((float*)(ws + CTL_DBG), num); atomicAdd((float*)(ws + CTL_DBG) + 1, den); }
__global__ void dbg_final(Args a) { const float n = *(const float*)(a.ws + CTL_DBG), d = *((const float*)(a.ws + CTL_DBG) + 1); a.out[O_RNNP] = 100.f + 1e7f * (n / (d + 1e-30f)); }
__global__ void __launch_bounds__(256) dbg_check_p1(Args a) {
    __shared__ float xs[1024]; __shared__ float z[3352]; __shared__ float red[256];
    const int nsamp = gridDim.x; const int tid = threadIdx.x;
    const int row = (int)(((long)blockIdx.x * 7919 * 131 + 37 * blockIdx.x) % MT);
    const float* x = row < MP ? a.in[0] + (size_t)row * DM : a.in[1] + (size_t)(row - MP) * DM;
    float ss = 0.f; for (int i = tid; i < 1024; i += 256) { const float v = x[i]; ss += v * v; }
    red[tid] = ss; __syncthreads(); for (int o = 128; o > 0; o >>= 1) { if (tid < o) red[tid] += red[tid + o]; __syncthreads(); }
    const float rs = 1.0f / sqrtf(red[0] / 1024.f + EPS);
    for (int i = tid; i < 1024; i += 256) xs[i] = x[i] * rs * a.in[6][i];
    __syncthreads();
    const float* w = a.in[7];
    for (int c = tid; c < 3352; c += 256) { float acc = 0.f; for (int k = 0; k < 1024; ++k) acc += xs[k] * w[(size_t)k * 3352 + c]; z[c] = acc; }
    __syncthreads();
    unsigned char* ws = a.ws; float num = 0.f, den = 0.f;
    auto cmp = [&](float got, float exp) { const float e = got - exp; num += e * e; den += exp * exp; };
    auto headrs = [&](int c0) { float s = 0.f; for (int d = 0; d < 64; ++d) s += z[c0 + d] * z[c0 + d]; return 1.0f / sqrtf(s / 64.f + EPS); };
    const float* kvout = row < MP ? a.out + O_KVP + (size_t)row * 512 : a.out + O_KVS + (size_t)(row - MP) * 512;
    const float* lbp = (const float*)(ws + WS_LB);
    for (int c = tid; c < 3352; c += 256) {
        if (c < 512) { const float r = headrs(c & ~63); cmp(bf2f(((const bf16*)(ws + WS_Q))[(size_t)row * 512 + c]), z[c] * r * a.in[8][c & 63]); }
        else if (c < 768) { cmp(kvout[c - 512], z[c]); if (row < MP) cmp(bf2f(((const bf16*)(ws + WS_KC))[(size_t)row * 256 + c - 512]), z[c] + a.in[10][((c - 512) >> 7) * 4096 + (row & 63) * 64 + (c & 63)]); }
        else if (c < 1024) { float e = z[c]; if (c < 896) e *= headrs(c & ~63) * a.in[9][64 + (c & 63)]; cmp(kvout[c - 512], e); cmp(bf2f(((const bf16*)(ws + WS_KS))[(size_t)row * 256 + c - 768]), e); }
        else if (c < 1280) { float e = z[c]; if (c < 1152) e *= headrs(c & ~63) * a.in[9][128 + (c & 63)]; cmp(bf2f(((const bf16*)(ws + WS_KW))[(size_t)row * 256 + c - 1024]), e);
            if (row >= MP) { const int r_ = row - MP; cmp(a.out[O_WINS + ((size_t)(r_ >> 3) * 512 + 504 + (r_ & 7)) * 256 + c - 1024], e); }
            else if ((row & 4095) >= 3584) cmp(a.out[O_WINP + ((size_t)(row >> 12) * 512 + (row & 4095) - 3584) * 256 + c - 1024], e); }
        else if (c < 1304) cmp(((const float*)(ws + WS_GATES))[(size_t)row * 24 + c - 1280], 1.f / (1.f + expf(-z[c])));
        else if (c < 1816) cmp(bf2f(((const bf16*)(ws + WS_RQ))[(size_t)row * 512 + c - 1304]), z[c] / (1.f + expf(-z[c])));
        else if (c < 2328) { const float l = lbp[c - 1816], f = l + (1.f - l) / (1.f + expf(-z[c])); cmp(((const float*)(ws + WS_GL))[(size_t)row * 512 + c - 1816], logf(f)); cmp(bf2f(((const bf16*)(ws + WS_RK))[(size_t)row * 512 + c - 1816]), 1.f - f); }
        else if (c < 2840) cmp(bf2f(((const bf16*)(ws + WS_RV))[(size_t)row * 512 + c - 2328]), z[c]);
        else cmp(bf2f(((const bf16*)(ws + WS_RG))[(size_t)row * 512 + c - 2840]), z[c] / (1.f + expf(-z[c])));
    }
    if (tid < 512 && blockIdx.x == 0) { const float l0 = a.in[14][tid], l1 = a.in[14][512 + tid]; const float e0 = expf(l0), e1 = expf(l1); cmp(lbp[tid], e0 / (e0 + e1)); if (tid + 256 < 512) { const float m0 = a.in[14][tid + 256], m1 = a.in[14][768 + tid]; cmp(lbp[tid + 256], expf(m0) / (expf(m0) + expf(m1))); } }
    (void)nsamp;
    red[tid] = num; __syncthreads(); for (int o = 128; o > 0; o >>= 1) { if (tid < o) red[tid] += red[tid + o]; __syncthreads(); } num = red[0]; __syncthreads();
    red[tid] = den; __syncthreads(); for (int o = 128; o > 0; o >>= 1) { if (tid < o) red[tid] += red[tid + o]; __syncthreads(); } den = red[0];
    if (tid == 0) dbg_report(ws, num, den);
}
__global__ void __launch_bounds__(256) dbg_check_cmp(Args a, int mode) {
    __shared__ float xin[4096]; __shared__ float hid[128]; __shared__ float outv[64]; __shared__ float red[256];
    const int tid = threadIdx.x; unsigned char* ws = a.ws;
    const int sidx = blockIdx.x; const int kind = sidx & 1, g = (sidx >> 1) & 1; int gb = (int)(((long)(sidx >> 2) * 977 + 13) % 4352);
    if (mode == 3) gb = gb % 256; if (mode == 4) gb = 256 + gb % 4096;
    if ((mode == 5 && kind != 0) || (mode == 6 && kind != 1)) return;
    const float* pe = a.in[10] + kind * 4096;
    for (int i = tid; i < 4096; i += 256) { const int p = i >> 6, d = i & 63; float v;
        if (gb < 256) { const int b = gb >> 6, blk = gb & 63; const int row = b * SEQ + 64 * blk + p; v = (a.out + O_KVP)[(size_t)row * 512 + kind * 128 + g * 64 + d]; }
        else { const int sb = (gb - 256) >> 5, blk = (gb - 256) & 31; const int page = ((const int*)a.in[5])[sb * NPAGES + (blk >> 1)]; v = a.in[2][((size_t)page * PAGE + (blk & 1) * 64 + p) * 512 + kind * 128 + g * 64 + d]; }
        xin[i] = v + pe[p * 64 + d]; }
    __syncthreads();
    if (tid < 128) { const float* w1 = a.in[11] + (size_t)kind * 4096 * 128; float acc = 0.f; for (int k = 0; k < 4096; ++k) acc += xin[k] * w1[(size_t)k * 128 + tid]; hid[tid] = acc / (1.f + expf(-acc)); }
    __syncthreads();
    if (tid < 64) { const float* w2 = a.in[12] + (size_t)kind * 128 * 64; float acc = 0.f; for (int k = 0; k < 128; ++k) acc += hid[k] * w2[k * 64 + tid]; outv[tid] = acc; }
    __syncthreads();
    float num = 0.f, den = 0.f;
    if (tid < 64) { float e = outv[tid];
        if (kind == 0) { float ss = 0.f; for (int d = 0; d < 64; ++d) ss += outv[d] * outv[d]; e = e / sqrtf(ss / 64.f + EPS) * a.in[9][tid]; }
        const float got = ((const float*)(ws + (kind == 0 ? WS_KCMP : WS_VCMP)))[((size_t)gb * 2 + g) * 64 + tid];
        num = (got - e) * (got - e); den = e * e; }
    red[tid] = num; __syncthreads(); for (int o = 128; o > 0; o >>= 1) { if (tid < o) red[tid] += red[tid + o]; __syncthreads(); } num = red[0]; __syncthreads();
    red[tid] = den; __syncthreads(); for (int o = 128; o > 0; o >>= 1) { if (tid < o) red[tid] += red[tid + o]; __syncthreads(); } den = red[0];
    if (tid == 0) dbg_report(ws, num, den);
}
#endif


constexpr int NPHASE = 7;
__global__ void __launch_bounds__(512, 2) mega(Args args) {
    extern __shared__ __attribute__((aligned(16))) unsigned char lds_raw[];
    LAS unsigned char* lds = (LAS unsigned char*)lds_raw;
    const int tid = threadIdx.x, lane = tid & 63, wave = __builtin_amdgcn_readfirstlane(tid >> 6);
    const int G = gridDim.x, bx = blockIdx.x;
    unsigned char* ws = args.ws;
    const int lo = args.ph_lo, hi = args.ph_hi;
#define IN(k) (lo <= (k) && (k) < hi)
#define GRID_BAR_CG() do { cg::this_grid().sync(); } while (0)
#define GRID_BAR() do { xcd_barrier(xbar); } while (0)
    if (tid < 16) ((LAS unsigned*)(lds + LDS_CTLW))[tid] = 0u;
    __syncthreads();
    if (tid == 0) { const unsigned xcc_ = xb_xcc_id(); LAS unsigned* lw_ = (LAS unsigned*)(lds + LDS_CTLW);
        lw_[4] = xcc_; lw_[5] = __hip_atomic_fetch_add((unsigned*)(ws + WS_CTL + CTL_XCEN) + 64 * xcc_, 1u, __ATOMIC_RELAXED, __HIP_MEMORY_SCOPE_AGENT); }
    XcdBarrier xbar; xbar.bar = (unsigned*)(ws + WS_CTL + CTL_BAR); xbar.x = 0; xbar.st = (volatile LAS unsigned*)(lds + LDS_CTLW);
    if (hi - lo > 1) xbar = xcd_barrier_post((unsigned*)(ws + WS_CTL + CTL_BAR), (volatile LAS unsigned*)(lds + LDS_CTLW));

#define STAMP(k) do { if (PROBE_A >= 0 && tid == 0) ((LAS unsigned long long*)(lds + LDS_STAMPS))[k] = __builtin_amdgcn_s_memrealtime(); } while (0)
    STAMP(0);
    if (IN(0)) {
        LAS float* scr = (LAS float*)(lds + wave * 16384);
        const int gw = bx * 8 + wave, NGW = G * 8;
        const float* w_in = args.in[7];
        const float* cw1 = args.in[11]; const float* cw2 = args.in[12];
        const float* xp = args.in[0]; const float* xs = args.in[1]; const float* ln_mix = args.in[6];
        {
#define P0_ROWP(m_) ((const f32x4*)((m_) < MP ? xp + (size_t)(m_) * DM : xs + (size_t)((m_) - MP) * DM) + lane)
#define P0_LOAD(A0, A1, m_) do { const int ma_ = (m_), mb_ = ma_ + NGW < MT ? ma_ + NGW : ma_; const f32x4* x0_ = P0_ROWP(ma_); const f32x4* x1_ = P0_ROWP(mb_); \
            _Pragma("unroll") for (int j = 0; j < 4; ++j) { A0[j] = __builtin_nontemporal_load(x0_ + 64 * j); A1[j] = __builtin_nontemporal_load(x1_ + 64 * j); } } while (0)
            const f32x4* gr = (const f32x4*)ln_mix + lane;
            f32x4 v0[4], v1[4], n0[4], n1[4];
            P0_LOAD(v0, v1, gw);
            for (int m = gw; m < MT; m += 2 * NGW) {
                const int m2 = m + NGW;
                if (m + 2 * NGW < MT) P0_LOAD(n0, n1, m + 2 * NGW);
                float s0 = 0.f, s1 = 0.f;
#pragma unroll
                for (int j = 0; j < 4; ++j) { s0 += (v0[j].x * v0[j].x + v0[j].y * v0[j].y) + (v0[j].z * v0[j].z + v0[j].w * v0[j].w); s1 += (v1[j].x * v1[j].x + v1[j].y * v1[j].y) + (v1[j].z * v1[j].z + v1[j].w * v1[j].w); }
                const float r0 = 1.0f / sqrtf(wave_sum(s0) * (1.f / DM) + EPS), r1 = 1.0f / sqrtf(wave_sum(s1) * (1.f / DM) + EPS);
                u32x2* o0 = (u32x2*)((bf16*)(ws + WS_XN) + (size_t)m * DM) + lane; u32x2* o1 = (u32x2*)((bf16*)(ws + WS_XN) + (size_t)m2 * DM) + lane;
#pragma unroll
                for (int j = 0; j < 4; ++j) { const f32x4 g = gr[64 * j]; u32x2 w0, w1; w0.x = cvtpk(v0[j].x * r0 * g.x, v0[j].y * r0 * g.y); w0.y = cvtpk(v0[j].z * r0 * g.z, v0[j].w * r0 * g.w);
                    w1.x = cvtpk(v1[j].x * r1 * g.x, v1[j].y * r1 * g.y); w1.y = cvtpk(v1[j].z * r1 * g.z, v1[j].w * r1 * g.w); o0[64 * j] = w0; if (m2 < MT) o1[64 * j] = w1; }
#pragma unroll
                for (int j = 0; j < 4; ++j) { v0[j] = n0[j]; v1[j] = n1[j]; }
            }
#undef P0_LOAD
#undef P0_ROWP
        }
        STAMP(25);
        constexpr int I_IN = 16 * 105, I_1 = 64 * 4, I_2 = 2 * 2;
        constexpr int NITEMS = I_IN + 2 * I_1 + 2 * I_2;
        for (int it = (gw + NGW / 2) % NGW; it < NITEMS; it += NGW) {
            int r = it;
            if (r < I_IN) { p0_transpose_item<1>(w_in, DM, INW, (bf16*)(ws + WS_WIN), scr, r, lane); continue; } r -= I_IN;
            if (r < 2 * I_1) { const int kv = r / I_1; p0_transpose_item<0>(cw1 + (size_t)kv * 4096 * 128, 4096, 128, (bf16*)(ws + WS_W1) + (size_t)kv * 128 * 4096, scr, r % I_1, lane); continue; } r -= 2 * I_1;
            { const int kv = r / I_2; p0_transpose_item<0>(cw2 + (size_t)kv * 128 * 64, 128, 64, (bf16*)(ws + WS_W2) + (size_t)kv * 64 * 128, scr, r % I_2, lane); }
        }
        STAMP(26);
        if (bx == 0) { const float* lg = args.in[14]; float* lbp = (float*)(ws + WS_LB); const float l0 = lg[tid], l1 = lg[512 + tid]; lbp[tid] = 1.0f / (1.0f + __expf(l1 - l0)); }
        if (hi > 1) GRID_BAR();
        if (tid == 0) { bool ok_ = (G % 8) == 0; LAS unsigned* lw_ = (LAS unsigned*)(lds + LDS_CTLW);
            for (int j = 0; j < 8; ++j) ok_ = ok_ && (__hip_atomic_load((unsigned*)(ws + WS_CTL + CTL_XCEN) + 64 * j, __ATOMIC_RELAXED, __HIP_MEMORY_SCOPE_AGENT) == (unsigned)(G / 8));
            lw_[6] = (ok_ && lw_[4] < 8u) ? (lw_[4] + 8u * lw_[5]) : (unsigned)bx; }
        __syncthreads();
        STAMP(1);
    }
    if (IN(1)) {
        pg8::Gemm g{(const bf16*)(ws + WS_XN), (const bf16*)(ws + WS_WIN), MT, INP, DM};
        const int vcu = (hi - lo > 1) ? (int)__builtin_amdgcn_readfirstlane(((LAS unsigned*)(lds + LDS_CTLW))[6]) : bx;
        pg8::StaticOrder S; S.init(MT, INP, G, vcu);
        EpiIn E{args.out, ws, args.in[8], args.in[9], args.in[10]};
        pg8::gemm_phase<EpiIn, true>(lds, g, S, E);
        {
            constexpr int N_WCV = (16 * 32 + 16 * 128 + 64 * 32) / 8, I_O = 16 * 32, I_U = 16 * 128;
            unsigned* qc = (unsigned*)(ws + WS_CTL + CTL_Q) + 128; LAS int* qslot = (LAS int*)(lds + LDS_CTLW + 32);
            for (;;) {
                if (tid == 0) *qslot = (int)atomicAdd(qc, 1u);
                __syncthreads();
                const int it = __builtin_amdgcn_readfirstlane(*qslot);
                __syncthreads();
                if (it >= N_WCV) break;
                int t_ = tid; asm volatile("" : "+v"(t_));
                const int r = it * 8 + __builtin_amdgcn_readfirstlane(t_ >> 6);
                LAS float* scr = (LAS float*)(lds + __builtin_amdgcn_readfirstlane(t_ >> 6) * 16384);
                if (r < I_O) p0_transpose_item<3>(args.in[16], DM, DM, (bf16*)(ws + WS_WO), scr, r, t_ & 63);
                else if (r < I_O + I_U) p0_transpose_item<3>(args.in[18], DM, DFF, (bf16*)(ws + WS_WU), scr, r - I_O, t_ & 63, args.in[17]);
                else p0_transpose_item<3>(args.in[19], DFF, DM, (bf16*)(ws + WS_WD), scr, r - I_O - I_U, t_ & 63);
            }
        }
        if (hi > 2) GRID_BAR();
        STAMP(2);
    }
    if (IN(2)) {
        constexpr int N_CMP = N_CMP_ITEMS, N_HG = 256, N_WIN = 512, N_RNN = 0, N_CPY = 0, N2 = N_CMP + N_HG + N_WIN + N_RNN + N_CPY;
        unsigned* qc = (unsigned*)(ws + WS_CTL + CTL_Q); LAS int* qslot = (LAS int*)(lds + LDS_CTLW + 32);
        if (bx == PROBE_BLK) { STAMP(14); STAMP(8); STAMP(9); STAMP(10); STAMP(11); STAMP(12); STAMP(13); }
        for (int rep = 0; rep < REP_P2; ++rep)
        for (int seq = 0;; ++seq) {
            if (tid == 0) *qslot = (int)atomicAdd(qc, 1u);
            __syncthreads();
            const int it = __builtin_amdgcn_readfirstlane(*qslot) - rep * (N2 + (int)G);
            __syncthreads();
            if (it >= N2) break;
            if (bx == PROBE_BLK) STAMP(8 + (seq < 5 ? seq : 5));
            int t_ = tid; asm volatile("" : "+v"(t_));
            constexpr int N_HEAVY = N_CMP + N_HG;
            if (it < 2 * N_HEAVY && !(it & 1)) { const int j = it >> 1; if (j < N_CMP) compress_item(lds, ws, args.in[2], (const int*)args.in[5], args.in[10], args.in[9], j, t_); else hgrn_local_item(lds, ws, j - N_CMP, t_); }
            else if (it < 2 * N_HEAVY) win_prompt_unit(lds, ws, it >> 1, t_);
            else if (it < N_CMP + N_HG + N_WIN) win_prompt_unit(lds, ws, it - N_HEAVY, t_);
            else if (it < N_CMP + N_HG + N_WIN + N_RNN) rnn_sample_wave(ws, args.out, args.in[4], args.in[15], (it - N_CMP - N_HG - N_WIN) * 8 + __builtin_amdgcn_readfirstlane(t_ >> 6), t_ & 63);
            else {
                const int ci_ = it - (N_CMP + N_HG + N_WIN + N_RNN), b = ci_ >> 3, e = ci_ & 7;
                const f32x4* src = (const f32x4*)args.in[3] + (size_t)b * (512 * 64) + 8 * 64; f32x4* dst = (f32x4*)(args.out + O_WINS) + (size_t)b * (512 * 64);
                f32x4 v[8];
#pragma unroll
                for (int j = 0; j < 8; ++j) { const int ch = e + 8 * j; if (ch < 63) v[j] = src[ch * 512 + t_]; }
#pragma unroll
                for (int j = 0; j < 8; ++j) { const int ch = e + 8 * j; if (ch < 63) dst[ch * 512 + t_] = v[j]; }
            }
        }
        if (bx == PROBE_BLK) STAMP(15);
        if (hi > 3) GRID_BAR();
        STAMP(3);
    }
    if (IN(3)) {
        constexpr int N_SEL1 = 256, N_SA = 256, N_RNN = 128, N_SEL0 = 256, N_HC = 512, Q_RNN = N_SEL1 + N_SA, Q_SEL0 = Q_RNN + N_RNN, Q_HC = Q_SEL0 + N_SEL0, N3 = Q_HC + N_HC;
        unsigned* qc = (unsigned*)(ws + WS_CTL + CTL_Q) + 64; LAS int* qslot = (LAS int*)(lds + LDS_CTLW + 32);
        if (bx == PROBE_BLK) { STAMP(22); STAMP(16); STAMP(17); STAMP(18); STAMP(19); STAMP(20); STAMP(21); }
        for (int rep = 0; rep < REP_P3; ++rep)
        for (int seq = 0;; ++seq) {
            if (tid == 0) *qslot = (int)atomicAdd(qc, 1u);
            __syncthreads();
            const int it = __builtin_amdgcn_readfirstlane(*qslot) - rep * (N3 + (int)G);
            __syncthreads();
            if (it >= N3) break;
            if (bx == PROBE_BLK) STAMP(16 + (seq < 5 ? seq : 5));
            int t_ = tid; asm volatile("" : "+v"(t_));
            if (it < Q_RNN && !(it & 1)) { const int j = it >> 1; sel_prompt_unit(lds, ws, args.in[13], ((j & 3) << 7) | (1 << 6) | (63 - (j >> 2)), t_); }
            else if (it < Q_RNN) samp_attn_unit(lds, ws, args.in[2], args.in[3], (const int*)args.in[5], args.in[13], args.out + O_WINS, it >> 1, t_);
            else if (it < Q_SEL0) rnn_sample_wave(ws, args.out, args.in[4], args.in[15], (it - Q_RNN) * 8 + __builtin_amdgcn_readfirstlane(t_ >> 6), t_ & 63);
            else if (it < Q_HC) { const int j = it - Q_SEL0; sel_prompt_unit(lds, ws, args.in[13], ((j & 3) << 7) | (63 - (j >> 2)), t_); }
            else hgrn_combine_unit(lds, ws, args.out, args.in[15], it - Q_HC, t_);
        }
        if (bx == PROBE_BLK) STAMP(23);
        if (hi > 4) {
            const int vcu = (hi - lo > 1) ? (int)__builtin_amdgcn_readfirstlane(((LAS unsigned*)(lds + LDS_CTLW))[6]) : bx;
            int pm_ = 0, pn_ = 0;
            {   constexpr int nM = MP / 256, nN = DM / 256, nwg = nM * nN, q = nwg / pg8::NXCD, r = nwg % pg8::NXCD, nig = pg8::WGM * nN;
                if (vcu < nwg) { const int xcd = vcu % pg8::NXCD, off = vcu / pg8::NXCD, wgid = (xcd < r ? xcd * (q + 1) : r * (q + 1) + (xcd - r) * q) + off;
                    const int gid = wgid / nig, fm = gid * pg8::WGM, gsz = (nM - fm) < pg8::WGM ? (nM - fm) : pg8::WGM; pm_ = fm + ((wgid % nig) % gsz); pn_ = (wgid % nig) / gsz; } }
            const float pf = xcd_barrier_prefetch(xbar, args.in[0] + (size_t)pm_ * 256 * DM + pn_ * 256, DM);
            if (pf == 123456.789f) ((float*)(ws + WS_CTL + CTL_XCEN))[4096] = pf;
        }
        STAMP(4);
    }
    if (IN(4)) {
        pg8::Gemm g{(const bf16*)(ws + WS_OA), (const bf16*)(ws + WS_WO), MP, DM, DM};
        const int vcu = (hi - lo > 1) ? (int)__builtin_amdgcn_readfirstlane(((LAS unsigned*)(lds + LDS_CTLW))[6]) : bx;
        pg8::StaticOrder S; S.init(MP, DM, G, vcu);
        EpiOut E{ws, args.in[0], args.in[1]};
#define SMALL_TILES() do { SEpiOut SE{ws, args.in[1]};   \
            for (int t = bx; t < 256; t += G) small_gemm_tile<64, 1, 8, SEpiOut>(lds, (const bf16*)(ws + WS_OA), DM, (const bf16*)(ws + WS_WO), DM, DM, MP + 64 * (t >> 4), 64 * (t & 15), SE, tid); } while (0)
        if (bx & 1) SMALL_TILES();
        pg8::gemm_phase<EpiOut, true>(lds, g, S, E);
        if (!(bx & 1)) SMALL_TILES();
#undef SMALL_TILES
        if (hi > 5) GRID_BAR();
        STAMP(5);
    }
    if (IN(5)) {
        pg8::Gemm g{(const bf16*)(ws + WS_XN), (const bf16*)(ws + WS_WU), MP, DFF, DM};
        const int vcu = (hi - lo > 1) ? (int)__builtin_amdgcn_readfirstlane(((LAS unsigned*)(lds + LDS_CTLW))[6]) : bx;
        pg8::StaticOrder S; S.init(MP, DFF, G, vcu);
        EpiUp E{ws};
#define SMALL_TILES() do { SEpiUp SE{ws};   \
            for (int t = bx; t < 256; t += G) small_gemm_tile<256, 4, 2, SEpiUp>(lds, (const bf16*)(ws + WS_XN), DM, (const bf16*)(ws + WS_WU), DM, DM, MP + 64 * (t >> 4), 256 * (t & 15), SE, tid); } while (0)
        if (bx & 1) SMALL_TILES();
        pg8::gemm_phase<EpiUp, true>(lds, g, S, E);
        if (!(bx & 1)) SMALL_TILES();
#undef SMALL_TILES
        if (hi > 6) GRID_BAR();
        STAMP(6);
    }
    if (IN(6)) {
        pg8::Gemm g{(const bf16*)(ws + WS_U), (const bf16*)(ws + WS_WD), MP, DM, DFF};
        const int vcu = (hi - lo > 1) ? (int)__builtin_amdgcn_readfirstlane(((LAS unsigned*)(lds + LDS_CTLW))[6]) : bx;
        pg8::StaticOrder S; S.init(MP, DM, G, vcu);
        EpiDown E{args.out, ws};
#define SMALL_TILES() do { SEpiDown SE{args.out, ws};   \
            for (int t = bx; t < 256; t += G) small_gemm_tile<64, 1, 8, SEpiDown>(lds, (const bf16*)(ws + WS_U), DFF, (const bf16*)(ws + WS_WD), DFF, DFF, MP + 64 * (t >> 4), 64 * (t & 15), SE, tid); } while (0)
        if (bx & 1) SMALL_TILES();
        pg8::gemm_phase<EpiDown, true>(lds, g, S, E);
        if (!(bx & 1)) SMALL_TILES();
#undef SMALL_TILES
    }
    if (PROBE_A >= 0) {
        asm volatile("s_waitcnt vmcnt(0)" ::: "memory");
        const unsigned long long tend = __builtin_amdgcn_s_memrealtime();
        if ((bx == PROBE_BLK || PROBE_A < 8) && tid == 0) {
            const int pa = PROBE_A, pb = PROBE_B; LAS unsigned long long* stamp_ = (LAS unsigned long long*)(lds + LDS_STAMPS); stamp_[7] = tend;
            unsigned long long ta = (pa == 24) ? (tend - stamp_[0]) : (stamp_[PROBE_E >= 0 ? PROBE_E : pa + 1] - stamp_[pa]); if (ta > 100000000ull) ta = 0ull;
            const unsigned long long tb = pb >= 0 ? (stamp_[pb + 1] - stamp_[pb]) : 0ull;
            const unsigned long long extra = ta + 100000ull * ((tb + 400ull) / 800ull);
            while (__builtin_amdgcn_s_memrealtime() - tend < extra) __builtin_amdgcn_s_sleep(16);
        }
    }
#undef IN
#undef GRID_BAR
#undef GRID_BAR_CG
}

extern "C" void kernel_launch(void* const* d_in, const int* in_sizes, int n_in, void* d_out, int out_size, void* d_ws, size_t ws_size, hipStream_t stream) {
    static int grid = 0;
    if (grid == 0) {
        int dev = 0, cus = 0, per_cu = 0;
        (void)hipGetDevice(&dev);
        (void)hipDeviceGetAttribute(&cus, hipDeviceAttributeMultiprocessorCount, dev);
        (void)hipFuncSetAttribute((const void*)mega, hipFuncAttributeMaxDynamicSharedMemorySize, LDS_BYTES);
        (void)hipOccupancyMaxActiveBlocksPerMultiprocessor(&per_cu, (const void*)mega, 512, LDS_BYTES);
        if (per_cu < 1) per_cu = 1;
        grid = cus * 1;
        if (n_in != 20 || (size_t)out_size != O_END) fprintf(stderr, "kernel_launch: unexpected shapes n_in %d out %d\n", n_in, out_size);
        (void)hipGetLastError();
    }
    (void)hipMemsetAsync((char*)d_ws + WS_CTL, 0, CTL_BYTES, stream);
    Args a{};
    for (int i = 0; i < 20; ++i) a.in[i] = (const float*)d_in[i];
    a.out = (float*)d_out; a.ws = (unsigned char*)d_ws;
#if MK_N_LAUNCHES == 1
    a.ph_lo = 0; a.ph_hi = NPHASE;
    void* kargs[] = {&a};
    hipError_t e = hipLaunchCooperativeKernel((const void*)mega, dim3(grid), dim3(512), kargs, LDS_BYTES, stream);
    if (e != hipSuccess) fprintf(stderr, "cooperative launch failed: %s (grid %d)\n", hipGetErrorString(e), grid);
#ifdef MK_DEBUG
    if (MK_DEBUG == 1) hipLaunchKernelGGL(dbg_check_p1, dim3(192), dim3(256), 0, stream, a);
    if (MK_DEBUG >= 2) hipLaunchKernelGGL(dbg_check_cmp, dim3(1024), dim3(256), 0, stream, a, (int)MK_DEBUG);
    hipLaunchKernelGGL(dbg_final, dim3(1), dim3(1), 0, stream, a);
#endif
#else
    for (int p = 0; p < NPHASE; ++p) { a.ph_lo = p; a.ph_hi = p + 1; hipLaunchKernelGGL(mega, dim3(grid), dim3(512), LDS_BYTES, stream, a);
#ifdef MK_DEBUG
        if (p == 1 && MK_DEBUG == 1) hipLaunchKernelGGL(dbg_check_p1, dim3(192), dim3(256), 0, stream, a);
#endif
    }
#ifdef MK_DEBUG
    hipLaunchKernelGGL(dbg_final, dim3(1), dim3(1), 0, stream, a);
#endif
#endif
}
```

```cpp
#include <hip/hip_runtime.h>
#include <hip/hip_cooperative_groups.h>
#include <cstdio>
#include <cstdint>
namespace cg = cooperative_groups;

#ifndef PROBE_A
#define PROBE_A -1
#define PROBE_B -1
#define PROBE_BLK 0
#define PROBE_E -1
#endif
#ifndef REP_P2
#define REP_P2 1
#endif
#ifndef REP_P3
#define REP_P3 1
#endif
#ifndef MK_N_LAUNCHES
#define MK_N_LAUNCHES 1
#endif

#define LAS __attribute__((address_space(3)))
typedef unsigned short bf16;
typedef short bf16x8 __attribute__((ext_vector_type(8)));
typedef short bf16x4 __attribute__((ext_vector_type(4)));
typedef float f32x4 __attribute__((ext_vector_type(4)));
typedef float f32x2 __attribute__((ext_vector_type(2)));
typedef unsigned u32x4 __attribute__((ext_vector_type(4)));
typedef unsigned u32x2 __attribute__((ext_vector_type(2)));
typedef __bf16 bf16x2_t __attribute__((ext_vector_type(2)));

constexpr int DM = 1024, BATCH = 4, SEQ = 4096, DECB = 128, DECT = 8, PAST = 2048, PAGE = 128;
constexpr int NPAGES = PAST / PAGE;
constexpr int MP = BATCH * SEQ;
constexpr int MS = DECB * DECT;
constexpr int MT = MP + MS;
constexpr int INW = 3352, INP = 3584;
constexpr int DFF = 4096;
constexpr float EPS = 1e-6f;

constexpr size_t O_YP = 0, O_YS = (size_t)MP * DM, O_KVP = O_YS + (size_t)MS * DM, O_KVS = O_KVP + (size_t)MP * 512,
                 O_WINP = O_KVS + (size_t)MS * 512, O_WINS = O_WINP + (size_t)BATCH * 512 * 256, O_RNNP = O_WINS + (size_t)DECB * 512 * 256,
                 O_RNNS = O_RNNP + (size_t)BATCH * 8 * 4096, O_END = O_RNNS + (size_t)DECB * 8 * 4096;

constexpr size_t MiB = 1u << 20;
constexpr size_t WS_CTL = 0, CTL_BYTES = 1 * MiB;
constexpr size_t CTL_SSQ = 512 * 1024;
constexpr size_t WS_WIN = 1 * MiB;
constexpr size_t WS_WO = WS_WIN + 7 * MiB;
constexpr size_t WS_WU = WS_WO + 2 * MiB;
constexpr size_t WS_WD = WS_WU + 8 * MiB;
constexpr size_t WS_W1 = WS_WD + 8 * MiB;
constexpr size_t WS_W2 = WS_W1 + 2 * MiB;
constexpr size_t WS_LB = WS_W2 + 64 * 1024;
constexpr size_t WS_XN = 32 * MiB;
constexpr size_t WS_Q = 68 * MiB;
constexpr size_t WS_KC = 86 * MiB;
constexpr size_t WS_KS = 95 * MiB;
constexpr size_t WS_KW = 104 * MiB;
constexpr size_t WS_RQ = 113 * MiB, WS_RK = 131 * MiB, WS_RV = 149 * MiB, WS_RG = 167 * MiB;   static_assert(WS_RV - WS_RK == WS_RK - WS_RQ && WS_RG - WS_RV == WS_RK - WS_RQ, "equal spacing");
constexpr size_t WS_GL = 185 * MiB;
constexpr size_t WS_GATES = 220 * MiB;
constexpr size_t WS_OWIN = 224 * MiB;
constexpr size_t WS_OA = 242 * MiB;
constexpr size_t WS_U = 280 * MiB;
constexpr size_t WS_KCMP = 420 * MiB;
constexpr size_t WS_VCMP = 424 * MiB;
constexpr size_t WS_OLOC = 428 * MiB;
constexpr size_t WS_QH = 462 * MiB;
constexpr size_t WS_TSC = 480 * MiB;
constexpr size_t WS_DSC = 489 * MiB;
constexpr size_t WS_END1 = 490 * MiB;

constexpr int RING_BYTES = 131072;
constexpr int LDS_BYTES = 147456;
constexpr int LDS_CTLW = LDS_BYTES - 320; constexpr int LDS_STAMPS = LDS_BYTES - 256;

__device__ __forceinline__ unsigned cvtpk(float lo, float hi) { f32x2 v = {lo, hi}; bf16x2_t b = __builtin_convertvector(v, bf16x2_t); return __builtin_bit_cast(unsigned, b); }
__device__ __forceinline__ float bf2f(unsigned short b) { return __builtin_bit_cast(float, ((unsigned)b) << 16); }
__device__ __forceinline__ float wave_sum(float v) {
#pragma unroll
    for (int o = 1; o < 64; o <<= 1) v += __shfl_xor(v, o);
    return v;
}
__device__ __forceinline__ float sigmoidf_(float x) { return __builtin_amdgcn_rcpf(1.0f + __expf(-x)); }
__device__ __forceinline__ float siluf_(float x) { return x * __builtin_amdgcn_rcpf(1.0f + __expf(-x)); }
#define LDS_WAIT() asm volatile("s_waitcnt lgkmcnt(0)" ::: "memory")

namespace pg8 {
constexpr int BM = 256, BK = 64, HALF = 128, HTB = HALF * BK * 2, STAGE_BYTES = 8 * HTB, NXCD = 8, WGM = 8;
__host__ __device__ __forceinline__ int lds_byte(int r, int c) { const int st = (r >> 4) * 2 + (c >> 5), rr = r & 15, cc = c & 31, ob = rr * 64 + cc * 2; return st * 1024 + (ob ^ (((ob >> 9) & 1) << 5)); }
__host__ __device__ __forceinline__ void stage_rc(int b, int& R, int& C) { const int st = b / 1024, sb = b % 1024, swz = sb ^ (((sb >> 9) & 1) << 5); R = (st >> 1) * 16 + swz / 64; C = (st & 1) * 32 + (swz % 64) / 2; }
struct Unit { int pm, pn; };
struct Gemm { const bf16* A; const bf16* Bt; int M, N, K; };
struct StaticOrder {
    int nM, nN, nwg, G, c;
    __host__ __device__ void init(int M, int N, int G_, int c_) { nM = M / BM; nN = N / BM; nwg = nM * nN; G = G_; c = c_; }
    __host__ __device__ bool next(int i, Unit& u) const {
        const long L = (long)i * G + c; if (L >= nwg) return false;
        int wgid = (int)L; { const int q = nwg / NXCD, r = nwg % NXCD, xcd = wgid % NXCD, off = wgid / NXCD; wgid = (xcd < r ? xcd * (q + 1) : r * (q + 1) + (xcd - r) * q) + off; }
        const int nig = WGM * nN, gid = wgid / nig, fm = gid * WGM, gsz = (nM - fm) < WGM ? (nM - fm) : WGM;
        u.pm = fm + ((wgid % nig) % gsz); u.pn = (wgid % nig) / gsz; return true;
    }
};
template <class Epi, bool ALIGN_EPI = true>
__device__ __forceinline__ void gemm_phase(LAS unsigned char* lds, const Gemm g, const StaticOrder& S, const Epi& E) {
    const int tid = threadIdx.x, wid = __builtin_amdgcn_readfirstlane(tid >> 6), lane = tid & 63, wr = wid >> 2, wc = wid & 3, fr = lane & 15, fq = lane >> 4;
    const int K = g.K, nt = K / BK;
    unsigned voffA[2], voffB[2];
#pragma unroll
    for (int i = 0; i < 2; ++i) { int R, C; stage_rc(tid * 16 + i * 8192, R, C); voffA[i] = (unsigned)(R * K + C) * 2u; voffB[i] = voffA[i]; }
    const size_t kstep = (size_t)(BK * 2);
    const size_t hstep = (size_t)HALF * K * 2;
    const size_t tstep = 2 * hstep;
    const unsigned ldsw = (unsigned)wid * 1024u;
    const int aoff = lds_byte(wr * 64 + fr, fq * 8), boff = lds_byte(wc * 32 + fr, fq * 8);
#define PG8_SA(b, h) (((b) * 2 + (h)) * HTB)
#define PG8_SB(b, h) ((4 + (b) * 2 + (h)) * HTB)
#define PG8_STAGE(bufoff, gbase, voff) do { _Pragma("unroll") for (int _i = 0; _i < 2; ++_i) \
        __builtin_amdgcn_global_load_lds((const unsigned*)((const char*)(gbase) + (voff)[_i]), (LAS unsigned*)(lds + (bufoff) + ldsw + _i * 8192), 16, 0, 0); } while (0)
#define PG8_LDA(dst, b, h) do { _Pragma("unroll") for (int m = 0; m < 4; ++m) _Pragma("unroll") for (int k = 0; k < 2; ++k) dst[m][k] = *(const LAS bf16x8*)(lds + PG8_SA(b, h) + aoff + m * 2048 + k * 1024); } while (0)
#define PG8_LDB(dst, b, h) do { _Pragma("unroll") for (int n = 0; n < 2; ++n) _Pragma("unroll") for (int k = 0; k < 2; ++k) dst[n][k] = *(const LAS bf16x8*)(lds + PG8_SB(b, h) + boff + n * 2048 + k * 1024); } while (0)
#define PG8_MMA(ai, bj, At, Bt) do { __builtin_amdgcn_s_setprio(1); _Pragma("unroll") for (int m = 0; m < 4; ++m) _Pragma("unroll") for (int n = 0; n < 2; ++n) _Pragma("unroll") for (int k = 0; k < 2; ++k) \
        acc[ai][bj][m][n] = __builtin_amdgcn_mfma_f32_16x16x32_bf16(Bt[n][k], At[m][k], acc[ai][bj][m][n], 0, 0, 0); __builtin_amdgcn_s_setprio(0); } while (0)
#define PG8_WAIT_V(n) asm volatile("s_waitcnt vmcnt(" #n ")" ::: "memory")
#define PG8_WAIT_L(n) asm volatile("s_waitcnt lgkmcnt(" #n ")" ::: "memory")
#define PG8_BAR __builtin_amdgcn_s_barrier()
#define PG8_SCHED __builtin_amdgcn_sched_barrier(0)
    Unit cur, nxt; int ui = 0;
    if (!S.next(0, cur)) return;
    f32x4 acc[2][2][4][2];
#pragma unroll
    for (int a = 0; a < 2; ++a)
#pragma unroll
        for (int b = 0; b < 2; ++b)
#pragma unroll
            for (int m = 0; m < 4; ++m)
#pragma unroll
                for (int n = 0; n < 2; ++n) acc[a][b][m][n] = (f32x4){0.f, 0.f, 0.f, 0.f};
    bf16x8 At[4][2], B0[2][2], B1[2][2];
    const char* cA = (const char*)g.A + (size_t)cur.pm * tstep; const char* cB = (const char*)g.Bt + (size_t)cur.pn * tstep;
    PG8_STAGE(PG8_SB(0, 0), cB, voffB); PG8_STAGE(PG8_SB(0, 1), cB + hstep, voffB); PG8_STAGE(PG8_SA(0, 0), cA, voffA); PG8_STAGE(PG8_SA(0, 1), cA + hstep, voffA);
    if (wr == 1) PG8_BAR;
    PG8_WAIT_V(2); PG8_BAR;
    PG8_STAGE(PG8_SB(1, 0), cB + kstep, voffB); PG8_STAGE(PG8_SA(1, 0), cA + kstep, voffA); PG8_STAGE(PG8_SB(1, 1), cB + hstep + kstep, voffB);
    PG8_WAIT_V(6); PG8_BAR;
    for (;;) {
        const bool has_next = S.next(ui + 1, nxt);
        const char* nA = has_next ? (const char*)g.A + (size_t)nxt.pm * tstep : cA; const char* nB = has_next ? (const char*)g.Bt + (size_t)nxt.pn * tstep : cB;
        for (int t = 0; t < nt; t += 2) {
            const bool last = (t == nt - 2);
            const char* a1 = cA + (size_t)(t + 1) * kstep;
            const char* a2 = last ? nA : cA + (size_t)(t + 2) * kstep; const char* b2 = last ? nB : cB + (size_t)(t + 2) * kstep;
            const char* a3 = a2 + kstep; const char* b3 = b2 + kstep;
            PG8_LDB(B0, 0, 0); PG8_LDB(B1, 0, 1); PG8_SCHED; PG8_LDA(At, 0, 0); PG8_STAGE(PG8_SA(1, 1), a1 + hstep, voffA);
            PG8_WAIT_V(8); PG8_WAIT_L(0); PG8_BAR; PG8_MMA(0, 0, At, B0); PG8_MMA(0, 1, At, B1); PG8_BAR; PG8_SCHED;
            PG8_LDA(At, 0, 1); PG8_STAGE(PG8_SB(0, 0), b2, voffB); PG8_STAGE(PG8_SB(0, 1), b2 + hstep, voffB); PG8_STAGE(PG8_SA(0, 0), a2, voffA);
            PG8_WAIT_V(8); PG8_WAIT_L(0); PG8_BAR; PG8_MMA(1, 0, At, B0); PG8_MMA(1, 1, At, B1); PG8_BAR; PG8_SCHED;
            PG8_LDB(B0, 1, 0); PG8_LDB(B1, 1, 1); PG8_SCHED; PG8_LDA(At, 1, 0); PG8_STAGE(PG8_SA(0, 1), a2 + hstep, voffA);
            PG8_WAIT_V(8); PG8_WAIT_L(0); PG8_BAR; PG8_MMA(0, 0, At, B0); PG8_MMA(0, 1, At, B1); PG8_BAR; PG8_SCHED;
            PG8_LDA(At, 1, 1); PG8_STAGE(PG8_SB(1, 0), b3, voffB); PG8_STAGE(PG8_SB(1, 1), b3 + hstep, voffB); PG8_STAGE(PG8_SA(1, 0), a3, voffA);
            PG8_WAIT_V(8); PG8_WAIT_L(0); PG8_BAR; PG8_MMA(1, 0, At, B0); PG8_MMA(1, 1, At, B1); PG8_BAR; PG8_SCHED;
        }
        if constexpr (ALIGN_EPI) { if (wr == 0) PG8_BAR; }
        E(acc, cur, wr, wc, fr, fq);
        if (!has_next) break;
#pragma unroll
        for (int a = 0; a < 2; ++a)
#pragma unroll
            for (int b = 0; b < 2; ++b)
#pragma unroll
                for (int m = 0; m < 4; ++m)
#pragma unroll
                    for (int n = 0; n < 2; ++n) acc[a][b][m][n] = (f32x4){0.f, 0.f, 0.f, 0.f};
        cur = nxt; cA = nA; cB = nB; ++ui;
        if constexpr (ALIGN_EPI) { if (wr == 1) PG8_BAR; }
    }
    PG8_WAIT_V(0);
    if constexpr (!ALIGN_EPI) { if (wr == 0) PG8_BAR; }
    PG8_BAR;
#undef PG8_SA
#undef PG8_SB
#undef PG8_STAGE
#undef PG8_LDA
#undef PG8_LDB
#undef PG8_MMA
#undef PG8_WAIT_V
#undef PG8_WAIT_L
#undef PG8_BAR
#undef PG8_SCHED
}
}

#define XB_TMO      128
#define XB_XCNT(j)  (256  + 64 * (j))
#define XB_XSUB(j)  (1280 + 64 * (j))
#define XB_XGEN(j)  (2304 + 64 * (j))
#define XB_TOP      3328
#define XB_TOPGEN   3392
#define XCD_BAR_WORDS 3456
#define XB_SPIN_CAP (1u << 18)
constexpr size_t CTL_XCEN = 160 * 1024;
constexpr size_t CTL_Q = 128 * 1024;
constexpr size_t CTL_BAR = 64 * 1024;
__device__ __forceinline__ unsigned xb_ld(unsigned* p)              { return __hip_atomic_load(p, __ATOMIC_RELAXED, __HIP_MEMORY_SCOPE_AGENT); }
__device__ __forceinline__ unsigned xb_add(unsigned* p, unsigned v) { return __hip_atomic_fetch_add(p, v, __ATOMIC_RELAXED, __HIP_MEMORY_SCOPE_AGENT); }
__device__ __forceinline__ unsigned xb_xcc_id() { return (unsigned)__builtin_amdgcn_s_getreg((3 << 11) | 20) & 0xFu; }
#define XB_SPIN(cond, bar) do { unsigned _sp = 0; while (cond) { __builtin_amdgcn_s_sleep(1); \
    if ((++_sp & 255u) == 0u) { if (xb_ld(&(bar)[XB_TMO])) break; if (_sp > XB_SPIN_CAP) { atomicAdd(&(bar)[XB_TMO], 1u); break; } } } } while (0)
struct XcdBarrier { unsigned* bar; unsigned x; volatile LAS unsigned* st; };
__device__ __forceinline__ XcdBarrier xcd_barrier_post(unsigned* bar, volatile LAS unsigned* st) {
    XcdBarrier b; b.bar = bar; b.x = xb_xcc_id(); b.st = st;
    if (threadIdx.x == 0) (void)xb_add(&bar[XB_XCNT(b.x)], 1u);
    return b;
}
__device__ __forceinline__ void xcd_barrier_complete(unsigned* bar, unsigned x, unsigned& nloc, unsigned& nx) {
    const unsigned G = gridDim.x * gridDim.y * gridDim.z;
    unsigned sum, cnt, mine, sp = 0u;
    for (;;) {
        sum = 0u; cnt = 0u; mine = 0u;
#pragma unroll
        for (unsigned j = 0; j < 16; ++j) { const unsigned c = xb_ld(&bar[XB_XCNT(j)]); sum += c; cnt += (c > 0u) ? 1u : 0u; mine = (j == x) ? c : mine; }
        if (sum == G) break;
        __builtin_amdgcn_s_sleep(1);
        if ((++sp & 255u) == 0u) { if (xb_ld(&bar[XB_TMO])) break; if (sp > XB_SPIN_CAP) { atomicAdd(&bar[XB_TMO], 1u); break; } }
    }
    nloc = mine > 0u ? mine : 1u; nx = cnt > 0u ? cnt : 1u;
}
__device__ __forceinline__ void xcd_barrier(const XcdBarrier& b) {
    asm volatile("s_waitcnt vmcnt(0)" ::: "memory");
    __syncthreads();
    if (threadIdx.x == 0) {
        unsigned* bar = b.bar;
        __builtin_amdgcn_s_waitcnt(0);
        unsigned nloc = b.st[0], nx = b.st[1];
        if (nloc == 0u) { xcd_barrier_complete(bar, b.x, nloc, nx); b.st[0] = nloc; b.st[1] = nx; }
        const unsigned old = xb_add(&bar[XB_XSUB(b.x)], 1u);
        const unsigned gen = old / nloc;
        if (old + 1u == (gen + 1u) * nloc) {
            __builtin_amdgcn_fence(__ATOMIC_RELEASE, "agent");
            asm volatile("s_waitcnt vmcnt(0)" ::: "memory");
            const unsigned og = xb_add(&bar[XB_TOP], 1u);
            const unsigned tg = og / nx;
            if (og + 1u == (tg + 1u) * nx) xb_add(&bar[XB_TOPGEN], 1u);
            else XB_SPIN(xb_ld(&bar[XB_TOPGEN]) == tg, bar);
            __builtin_amdgcn_fence(__ATOMIC_ACQUIRE, "agent");
            xb_add(&bar[XB_XGEN(b.x)], 1u);
            asm volatile("s_waitcnt vmcnt(0)" ::: "memory");
        } else {
            XB_SPIN(xb_ld(&bar[XB_XGEN(b.x)]) == gen, bar);
            __builtin_amdgcn_fence(__ATOMIC_ACQUIRE, "agent");
            asm volatile("s_waitcnt vmcnt(0)" ::: "memory");
        }
    }
    __syncthreads();
}

struct Args {
    const float* in[20];
    float* out;
    unsigned char* ws;
    int ph_lo, ph_hi;
};

__host__ __device__ __forceinline__ int win_logical(int c) { return (c < 1280) ? c : (c < 1304 ? 3328 + (c - 1280) : c - 24); }
__host__ __device__ __forceinline__ int tile_perm_row(int L) { const int Lc = L & 255, lo = Lc & 31; return (L & ~255) + 128 * ((Lc >> 5) & 1) + 32 * (Lc >> 6) + 16 * ((lo >> 2) & 1) + 4 * (lo >> 3) + (lo & 3); }

__host__ __device__ __forceinline__ int perm32_row(int col) { const int cg = col & 31; return (col & ~31) + 16 * ((cg >> 2) & 1) + 4 * (cg >> 3) + (cg & 3); }
template <int MAPKIND>
__device__ __forceinline__ void p0_transpose_item(const float* W, int K, int N, bf16* WT, LAS float* scr, int item, int lane, const float* kscale = nullptr) {
    const int nblk = (N + 31) / 32, kb = item / nblk, nb = item % nblk, k0 = 64 * kb, n0 = 32 * nb;
    const int c4 = lane & 7, colr = n0 + 4 * c4;
    f32x4 wv[8];
#pragma unroll
    for (int i = 0; i < 8; ++i) { const int kk = (lane >> 3) + 8 * i; wv[i] = (colr < N) ? *(const f32x4*)(W + (size_t)(k0 + kk) * N + colr) : (f32x4){0.f, 0.f, 0.f, 0.f}; }
#pragma unroll
    for (int i = 0; i < 8; ++i) { const int kk = (lane >> 3) + 8 * i; const float ksc = kscale ? kscale[k0 + kk] : 1.0f; LAS float* d = scr + kk * 33 + 4 * c4;
        d[0] = wv[i].x * ksc; d[1] = wv[i].y * ksc; d[2] = wv[i].z * ksc; d[3] = wv[i].w * ksc; }
    LDS_WAIT(); asm volatile("" ::: "memory");
    const int c = lane & 7;
#pragma unroll
    for (int j = 0; j < 4; ++j) { const int n = (lane >> 3) + 8 * j; const LAS float* s = scr + (8 * c) * 33 + n; const int col = n0 + n;
        if (col < N) {
            u32x4 o; o.x = cvtpk(s[0 * 33], s[1 * 33]); o.y = cvtpk(s[2 * 33], s[3 * 33]); o.z = cvtpk(s[4 * 33], s[5 * 33]); o.w = cvtpk(s[6 * 33], s[7 * 33]);
            const int row = (MAPKIND == 1) ? tile_perm_row(win_logical(col)) : (MAPKIND == 2 ? tile_perm_row(col) : (MAPKIND == 3 ? perm32_row(col) : col));
            *(u32x4*)(WT + (size_t)row * K + k0 + 8 * c) = o; } }
    LDS_WAIT(); asm volatile("" ::: "memory");
}

__device__ __forceinline__ void rms_row_to_bf16(const float* xrow, const float* gain, bf16* orow, int lane) {
    const f32x4* xr = (const f32x4*)xrow + lane; const f32x4* gr = (const f32x4*)gain + lane;
    f32x4 v[4]; float s = 0.f;
#pragma unroll
    for (int j = 0; j < 4; ++j) { v[j] = xr[64 * j]; s += (v[j].x * v[j].x + v[j].y * v[j].y) + (v[j].z * v[j].z + v[j].w * v[j].w); }
    const float rs = 1.0f / sqrtf(wave_sum(s) * (1.f / DM) + EPS);
    u32x2* o8 = (u32x2*)orow + lane;
#pragma unroll
    for (int j = 0; j < 4; ++j) { const f32x4 g = gr[64 * j]; u32x2 w; w.x = cvtpk(v[j].x * rs * g.x, v[j].y * rs * g.y); w.y = cvtpk(v[j].z * rs * g.z, v[j].w * rs * g.w); o8[64 * j] = w; }
}

struct EpiIn {
    float* out; unsigned char* ws;
    const float *q_gain, *k_gain, *pe;
    __device__ __forceinline__ void operator()(const f32x4 (&acc)[2][2][4][2], const pg8::Unit& u, int wr, int wc, int fr, int fq) const {
        const int pn = u.pn;
        bf16* const Q = (bf16*)(ws + WS_Q); bf16* const KC = (bf16*)(ws + WS_KC); bf16* const KS = (bf16*)(ws + WS_KS); bf16* const KW = (bf16*)(ws + WS_KW);
        float* const GL = (float*)(ws + WS_GL); float* const GATES = (float*)(ws + WS_GATES); const float* const lb = (const float*)(ws + WS_LB);
        const int rowb = u.pm * 256 + wr * 64 + fr;
        const int lo8 = 8 * fq;
#define EPI_ROWS _Pragma("unroll") for (int ai = 0; ai < 2; ++ai) _Pragma("unroll") for (int m = 0; m < 4; ++m)
#define EPI_COLS _Pragma("unroll") for (int bj = 0; bj < 2; ++bj) _Pragma("unroll") for (int n = 0; n < 2; ++n)
#define EPI_BJ _Pragma("unroll") for (int bj = 0; bj < 2; ++bj)
#define PACK16(v0_, v1_) (u32x4){cvtpk((v0_).x, (v0_).y), cvtpk((v0_).z, (v0_).w), cvtpk((v1_).x, (v1_).y), cvtpk((v1_).z, (v1_).w)}
        if (pn < 2) {
            f32x4 g[2][2];
            EPI_COLS g[bj][n] = *(const f32x4*)(q_gain + 32 * bj + lo8 + 4 * n);
            EPI_ROWS { const int row = rowb + 128 * ai + 16 * m; float ss = 0.f;
                EPI_COLS { const f32x4 v = acc[ai][bj][m][n]; ss += (v.x * v.x + v.y * v.y) + (v.z * v.z + v.w * v.w); }
                ss += __shfl_xor(ss, 16); ss += __shfl_xor(ss, 32);
                const float rs = __builtin_amdgcn_rsqf(ss * (1.f / 64.f) + EPS);
                bf16* dst = Q + (size_t)row * 512 + pn * 256 + 64 * wc + lo8;
                EPI_BJ { const f32x4 v0 = acc[ai][bj][m][0] * rs * g[bj][0], v1 = acc[ai][bj][m][1] * rs * g[bj][1]; *(u32x4*)(dst + 32 * bj) = PACK16(v0, v1); } }
        } else if (pn < 5) {
            const bool norm = (pn > 2) && (wc < 2);
            f32x4 g[2][2];
            EPI_COLS g[bj][n] = norm ? *(const f32x4*)(k_gain + (pn - 2) * 64 + 32 * bj + lo8 + 4 * n) : (f32x4){1.f, 1.f, 1.f, 1.f};
            EPI_ROWS { const int row = rowb + 128 * ai + 16 * m; float rs = 1.f;
                if (norm) { float ss = 0.f;
                    EPI_COLS { const f32x4 v = acc[ai][bj][m][n]; ss += (v.x * v.x + v.y * v.y) + (v.z * v.z + v.w * v.w); }
                    ss += __shfl_xor(ss, 16); ss += __shfl_xor(ss, 32);
                    rs = __builtin_amdgcn_rsqf(ss * (1.f / 64.f) + EPS); }
                float* fdst = nullptr; bf16* bdst = nullptr; const float* pep = nullptr;
                if (pn == 2) { fdst = (row < MP) ? out + O_KVP + (size_t)row * 512 : out + O_KVS + (size_t)(row - MP) * 512;
                               if (row < MP) { bdst = KC + (size_t)row * 256; pep = pe + (wc >> 1) * 4096 + (row & 63) * 64; } }
                else if (pn == 3) { fdst = ((row < MP) ? out + O_KVP + (size_t)row * 512 : out + O_KVS + (size_t)(row - MP) * 512) + 256; bdst = KS + (size_t)row * 256; }
                else { bdst = KW + (size_t)row * 256;
                       if (row < MP) { const int t = row & (SEQ - 1), b = row >> 12; if (t >= SEQ - 512) fdst = out + O_WINP + ((size_t)b * 512 + (t - (SEQ - 512))) * 256; }
                       else { const int rs_ = row - MP, b = rs_ >> 3, t = rs_ & 7; fdst = out + O_WINS + ((size_t)b * 512 + 504 + t) * 256; } }
                const int cb = 64 * wc + lo8;
                EPI_BJ { f32x4 v0 = acc[ai][bj][m][0] * rs * g[bj][0], v1 = acc[ai][bj][m][1] * rs * g[bj][1];
                    if (fdst) { __builtin_nontemporal_store(v0, (f32x4*)(fdst + cb + 32 * bj)); __builtin_nontemporal_store(v1, (f32x4*)(fdst + cb + 32 * bj + 4)); }
                    if (bdst) { if (pep) { v0 = v0 + *(const f32x4*)(pep + lo8 + 32 * bj); v1 = v1 + *(const f32x4*)(pep + lo8 + 32 * bj + 4); } *(u32x4*)(bdst + cb + 32 * bj) = PACK16(v0, v1); } } }
        } else if (pn < 13) {
            const int kind = (pn - 5) >> 1, cbase = ((pn - 5) & 1) * 256 + 64 * wc + lo8;
            bf16* B = (bf16*)(ws + WS_RQ + (size_t)kind * (WS_RK - WS_RQ));
            f32x4 lbv[2][2];
            EPI_COLS lbv[bj][n] = (kind == 1) ? *(const f32x4*)(lb + cbase + 32 * bj + 4 * n) : (f32x4){0.f, 0.f, 0.f, 0.f};
            EPI_ROWS { const int row = rowb + 128 * ai + 16 * m;
                EPI_BJ { f32x4 v[2];
#pragma unroll
                    for (int n = 0; n < 2; ++n) { v[n] = acc[ai][bj][m][n];
                        if (kind == 0 || kind == 3) { v[n].x = siluf_(v[n].x); v[n].y = siluf_(v[n].y); v[n].z = siluf_(v[n].z); v[n].w = siluf_(v[n].w); }
                        if (kind == 1) { f32x4 gl, kk; const f32x4 l = lbv[bj][n];
#pragma unroll
                            for (int i = 0; i < 4; ++i) { const float e = __expf(-v[n][i]); const float sg = __builtin_amdgcn_rcpf(1.0f + e); const float f = l[i] + (1.0f - l[i]) * sg; gl[i] = __logf(f); kk[i] = (1.0f - l[i]) * (e * sg); }
                            *(f32x4*)(GL + (size_t)row * 512 + cbase + 32 * bj + 4 * n) = gl; v[n] = kk; } }
                    *(u32x4*)(B + (size_t)row * 512 + cbase + 32 * bj) = PACK16(v[0], v[1]); } }
        } else {
            if (wc == 0 && fq < 3) {
                EPI_ROWS { const int row = rowb + 128 * ai + 16 * m;
#pragma unroll
                    for (int n = 0; n < 2; ++n) { f32x4 v = acc[ai][0][m][n];
                        v.x = sigmoidf_(v.x); v.y = sigmoidf_(v.y); v.z = sigmoidf_(v.z); v.w = sigmoidf_(v.w); *(f32x4*)(GATES + (size_t)row * 24 + lo8 + 4 * n) = v; } }
            }
        }
#undef EPI_ROWS
#undef EPI_COLS
#undef EPI_BJ
#undef PACK16
    }
};

typedef short v4i16_t __attribute__((ext_vector_type(4)));
constexpr int KVS = 144;
constexpr int KVT = 64 * KVS;
constexpr float LOG2E = 1.4426950408889634f;
constexpr float SL2 = 0.125f * LOG2E;
__device__ __forceinline__ f32x4 mfma16(bf16x8 a, bf16x8 b, f32x4 c) { return __builtin_amdgcn_mfma_f32_16x16x32_bf16(a, b, c, 0, 0, 0); }
__device__ __forceinline__ bf16x4 ldtr(LAS const unsigned char* p) { return __builtin_bit_cast(bf16x4, __builtin_amdgcn_ds_read_tr16_b64_v4i16((LAS v4i16_t*)p)); }
__device__ __forceinline__ bf16x8 pack8(f32x4 a, f32x4 b) { u32x4 w; w.x = cvtpk(a.x, a.y); w.y = cvtpk(a.z, a.w); w.z = cvtpk(b.x, b.y); w.w = cvtpk(b.z, b.w); return __builtin_bit_cast(bf16x8, w); }
__device__ __forceinline__ bf16x8 cat44(bf16x4 a, bf16x4 b) { return (bf16x8){a[0], a[1], a[2], a[3], b[0], b[1], b[2], b[3]}; }
struct AttnSt { f32x4 o[4][2]; float m[2], l[2]; };
__device__ __forceinline__ void attn_init(AttnSt& st) {
#pragma unroll
    for (int dt = 0; dt < 4; ++dt) { st.o[dt][0] = (f32x4){0.f, 0.f, 0.f, 0.f}; st.o[dt][1] = (f32x4){0.f, 0.f, 0.f, 0.f}; }
    st.m[0] = st.m[1] = 0.f; st.l[0] = st.l[1] = 0.f;
}
__device__ __forceinline__ void attn_scores(f32x4 (&s)[2][4], const bf16x8 (&qf)[2][2], LAS const unsigned char* Kt, int c, int q4) {
    bf16x8 kf[4][2];
#pragma unroll
    for (int kt4 = 0; kt4 < 4; ++kt4) { kf[kt4][0] = *(LAS const bf16x8*)(Kt + (16 * kt4 + c) * KVS + 16 * q4); kf[kt4][1] = *(LAS const bf16x8*)(Kt + (16 * kt4 + c) * KVS + 64 + 16 * q4); }
    __builtin_amdgcn_sched_barrier(0);
#pragma unroll
    for (int kt4 = 0; kt4 < 4; ++kt4)
#pragma unroll
        for (int qt2 = 0; qt2 < 2; ++qt2) s[qt2][kt4] = mfma16(kf[kt4][0], qf[qt2][0], (f32x4){0.f, 0.f, 0.f, 0.f});
#pragma unroll
    for (int kt4 = 0; kt4 < 4; ++kt4)
#pragma unroll
        for (int qt2 = 0; qt2 < 2; ++qt2) s[qt2][kt4] = mfma16(kf[kt4][1], qf[qt2][1], s[qt2][kt4]);
}
__device__ __forceinline__ void attn_pv(f32x4 (&o)[4][2], const f32x4 (&p)[2][4], LAS const unsigned char* Vt, int c, int q4) {
    const int vrow = 4 * q4 + (c >> 2), vcol = 8 * (c & 3);
    bf16x4 lo[2][4], hi[2][4];
#pragma unroll
    for (int s2 = 0; s2 < 2; ++s2)
#pragma unroll
        for (int dt = 0; dt < 4; ++dt) { lo[s2][dt] = ldtr(Vt + (32 * s2 + vrow) * KVS + 32 * dt + vcol); hi[s2][dt] = ldtr(Vt + (32 * s2 + 16 + vrow) * KVS + 32 * dt + vcol); }
    bf16x8 pb[2][2];
#pragma unroll
    for (int s2 = 0; s2 < 2; ++s2) { pb[s2][0] = pack8(p[0][2 * s2], p[0][2 * s2 + 1]); pb[s2][1] = pack8(p[1][2 * s2], p[1][2 * s2 + 1]); }
    __builtin_amdgcn_sched_barrier(0);
#pragma unroll
    for (int s2 = 0; s2 < 2; ++s2)
#pragma unroll
        for (int dt = 0; dt < 4; ++dt) { const bf16x8 vf = cat44(lo[s2][dt], hi[s2][dt]); o[dt][0] = mfma16(vf, pb[s2][0], o[dt][0]); o[dt][1] = mfma16(vf, pb[s2][1], o[dt][1]); }
}
__device__ __forceinline__ void attn_pv_lean(f32x4 (&o)[4][2], const f32x4 (&p)[2][4], LAS const unsigned char* Vt, int c, int q4) {
    const int vrow = 4 * q4 + (c >> 2), vcol = 8 * (c & 3);
#pragma unroll
    for (int s2 = 0; s2 < 2; ++s2) {
        const bf16x8 pb0 = pack8(p[0][2 * s2], p[0][2 * s2 + 1]), pb1 = pack8(p[1][2 * s2], p[1][2 * s2 + 1]);
#pragma unroll
        for (int dt = 0; dt < 4; ++dt) {
            const bf16x4 lo = ldtr(Vt + (32 * s2 + vrow) * KVS + 32 * dt + vcol);
            const bf16x4 hi = ldtr(Vt + (32 * s2 + 16 + vrow) * KVS + 32 * dt + vcol);
            const bf16x8 vf = cat44(lo, hi);
            o[dt][0] = mfma16(vf, pb0, o[dt][0]); o[dt][1] = mfma16(vf, pb1, o[dt][1]);
        }
    }
}
template <bool LEAN = false>
__device__ __forceinline__ void attn_update(AttnSt& st, f32x4 (&x)[2][4], LAS const unsigned char* Vt, int c, int q4) {
#pragma unroll
    for (int qt2 = 0; qt2 < 2; ++qt2) {
        float mx = -__builtin_inff();
#pragma unroll
        for (int kt4 = 0; kt4 < 4; ++kt4) mx = fmaxf(mx, fmaxf(fmaxf(x[qt2][kt4].x, x[qt2][kt4].y), fmaxf(x[qt2][kt4].z, x[qt2][kt4].w)));
        mx = fmaxf(mx, __shfl_xor(mx, 16)); mx = fmaxf(mx, __shfl_xor(mx, 32));
        const float mn = fmaxf(st.m[qt2], mx), mu = (mn == -__builtin_inff()) ? 0.f : mn;
        const float alpha = __builtin_amdgcn_exp2f(st.m[qt2] - mu);
        float ls = 0.f;
#pragma unroll
        for (int kt4 = 0; kt4 < 4; ++kt4) { f32x4 e;
#pragma unroll
            for (int i = 0; i < 4; ++i) e[i] = __builtin_amdgcn_exp2f(x[qt2][kt4][i] - mu);
            x[qt2][kt4] = e; ls += (e.x + e.y) + (e.z + e.w); }
        st.l[qt2] = st.l[qt2] * alpha + ls; st.m[qt2] = mn;
#pragma unroll
        for (int dt = 0; dt < 4; ++dt) st.o[dt][qt2] = st.o[dt][qt2] * alpha;
    }
    if (LEAN) attn_pv_lean(st.o, x, Vt, c, q4); else attn_pv(st.o, x, Vt, c, q4);
}
constexpr float MFIX = 17.0f;
template <bool LEAN = false>
__device__ __forceinline__ void attn_update_fixed(AttnSt& st, f32x4 (&x)[2][4], LAS const unsigned char* Vt, int c, int q4) {
#pragma unroll
    for (int qt2 = 0; qt2 < 2; ++qt2) { float ls = 0.f;
#pragma unroll
        for (int kt4 = 0; kt4 < 4; ++kt4) { f32x4 e;
#pragma unroll
            for (int i = 0; i < 4; ++i) e[i] = __builtin_amdgcn_exp2f(x[qt2][kt4][i]);
            x[qt2][kt4] = e; ls += (e.x + e.y) + (e.z + e.w); }
        st.l[qt2] += ls; }
    if (LEAN) attn_pv_lean(st.o, x, Vt, c, q4); else attn_pv(st.o, x, Vt, c, q4);
}
__device__ __forceinline__ void kv_load_regs(u32x4& kr, u32x4& vr, const bf16* base, size_t row0, int kcol, int tid) {
    const bf16* p = base + (row0 + (tid >> 3)) * 256 + kcol + 8 * (tid & 7);
    kr = *(const u32x4*)p; vr = *(const u32x4*)(p + 128);
}
__device__ __forceinline__ void kv_store_lds(LAS unsigned char* Kt, LAS unsigned char* Vt, u32x4 kr, u32x4 vr, int tid) {
    const int off = (tid >> 3) * KVS + 16 * (tid & 7);
    *(LAS u32x4*)(Kt + off) = kr; *(LAS u32x4*)(Vt + off) = vr;
}
__device__ __forceinline__ void load_qfrags(bf16x8 (&qf)[2][2], const bf16* Q, size_t row0, int hcol, int c, int q4) {
#pragma unroll
    for (int qt2 = 0; qt2 < 2; ++qt2)
#pragma unroll
        for (int ks = 0; ks < 2; ++ks) qf[qt2][ks] = *(const bf16x8*)(Q + (row0 + 16 * qt2 + c) * 512 + hcol + 32 * ks + 8 * q4);
}

__device__ __forceinline__ void win_prompt_unit(LAS unsigned char* lds, unsigned char* ws, int unit, int tid) {
    const int lane = tid & 63, w = __builtin_amdgcn_readfirstlane(tid >> 6), c = lane & 15, q4 = lane >> 4;
    const int b = unit >> 7, g = (unit >> 6) & 1, qblk = unit & 63, t0 = 64 * qblk, r = w & 3, th = w >> 2, head = 4 * g + r;
    const float slope2 = __builtin_amdgcn_exp2f(-(float)(head + 1)) * LOG2E;
    const bf16* KW = (const bf16*)(ws + WS_KW);
    const size_t rowb = (size_t)b * SEQ;
    bf16x8 qf[2][2]; load_qfrags(qf, (const bf16*)(ws + WS_Q), rowb + t0 + 32 * th, 64 * head, c, q4);
    AttnSt st; attn_init(st);
    f32x4 kb[4];
#pragma unroll
    for (int kt4 = 0; kt4 < 4; ++kt4) kb[kt4] = (f32x4){slope2 * (float)(16 * kt4 + 4 * q4), slope2 * (float)(16 * kt4 + 4 * q4 + 1), slope2 * (float)(16 * kt4 + 4 * q4 + 2), slope2 * (float)(16 * kt4 + 4 * q4 + 3)};
    const int j0 = qblk >= 8 ? qblk - 8 : 0, nt = qblk - j0 + 1;
    u32x4 kr, vr;
    kv_load_regs(kr, vr, KW, rowb + 64 * j0, 64 * g, tid);
    kv_store_lds(lds, lds + KVT, kr, vr, tid);
    __syncthreads();
    for (int i = 0; i < nt; ++i) {
        LAS unsigned char* Kt = lds + (i & 1) * 2 * KVT; LAS unsigned char* Vt = Kt + KVT;
        if (i + 1 < nt) kv_load_regs(kr, vr, KW, rowb + 64 * (j0 + i + 1), 64 * g, tid);
        f32x4 s[2][4]; attn_scores(s, qf, Kt, c, q4);
        const int kbase = 64 * (j0 + i), jt = j0 + i;
        if (jt > qblk - 8 && jt < qblk) {
#pragma unroll
            for (int qt2 = 0; qt2 < 2; ++qt2) { const float c0 = slope2 * (float)(kbase - (t0 + 32 * th + 16 * qt2 + c)) - MFIX;
#pragma unroll
                for (int kt4 = 0; kt4 < 4; ++kt4) s[qt2][kt4] = s[qt2][kt4] * SL2 + (kb[kt4] + c0); }
        } else {
#pragma unroll
            for (int qt2 = 0; qt2 < 2; ++qt2) { const int qpos = t0 + 32 * th + 16 * qt2 + c;
#pragma unroll
                for (int kt4 = 0; kt4 < 4; ++kt4)
#pragma unroll
                    for (int e = 0; e < 4; ++e) { const int dist = qpos - (kbase + 16 * kt4 + 4 * q4 + e);
                        s[qt2][kt4][e] = (dist >= 0 && dist < 512) ? s[qt2][kt4][e] * SL2 - slope2 * (float)dist - MFIX : -__builtin_inff(); } }
        }
        attn_update_fixed(st, s, Vt, c, q4);
        if (i + 1 < nt) { LAS unsigned char* Kn = lds + ((i + 1) & 1) * 2 * KVT; kv_store_lds(Kn, Kn + KVT, kr, vr, tid); }
        __syncthreads();
    }
    bf16* OW = (bf16*)(ws + WS_OWIN);
#pragma unroll
    for (int qt2 = 0; qt2 < 2; ++qt2) { float l = st.l[qt2]; l += __shfl_xor(l, 16); l += __shfl_xor(l, 32); const float il = 1.0f / l;
        bf16* dst = OW + (rowb + t0 + 32 * th + 16 * qt2 + c) * 512 + 64 * head + 4 * q4;
#pragma unroll
        for (int dt = 0; dt < 4; ++dt) { const f32x4 v = st.o[dt][qt2] * il; u32x2 wv; wv.x = cvtpk(v.x, v.y); wv.y = cvtpk(v.z, v.w); *(u32x2*)(dst + 16 * dt) = wv; } }
}

constexpr int SL_KV = 0, SL_PSLAB = 4 * KVT  , SL_IMP = SL_PSLAB + 65536, SL_MASK = SL_IMP + 16384, SL_UMASK = SL_MASK + 512;
__device__ __forceinline__ void sel_prompt_unit(LAS unsigned char* lds, unsigned char* ws, const float* attn_gain, int unit, int tid) {
    const int lane = tid & 63, w = __builtin_amdgcn_readfirstlane(tid >> 6), c = lane & 15, q4 = lane >> 4;
    const int b = unit >> 7, g = (unit >> 6) & 1, qblk = unit & 63, t0 = 64 * qblk, r = w & 3, th = w >> 2, head = 4 * g + r;
    const float slope2 = __builtin_amdgcn_exp2f(-(float)(head + 1)) * LOG2E;
    const size_t rowb = (size_t)b * SEQ;
    bf16x8 qf[2][2]; load_qfrags(qf, (const bf16*)(ws + WS_Q), rowb + t0 + 32 * th, 64 * head, c, q4);
    LAS float* PSLAB = (LAS float*)(lds + SL_PSLAB); LAS float* IMP = (LAS float*)(lds + SL_IMP);
    LAS unsigned long long* MASK = (LAS unsigned long long*)(lds + SL_MASK);
    {
        const float* kc = (const float*)(ws + WS_KCMP) + (((size_t)b * 64 + (tid >> 3)) * 2 + g) * 64 + 8 * (tid & 7);
        const float* vc = (const float*)(ws + WS_VCMP) + (((size_t)b * 64 + (tid >> 3)) * 2 + g) * 64 + 8 * (tid & 7);
        const f32x4 k0 = *(const f32x4*)kc, k1 = *(const f32x4*)(kc + 4), v0 = *(const f32x4*)vc, v1 = *(const f32x4*)(vc + 4);
        kv_store_lds(lds, lds + KVT, __builtin_bit_cast(u32x4, pack8(k0, k1)), __builtin_bit_cast(u32x4, pack8(v0, v1)), tid);
    }
    __syncthreads();
    AttnSt sc; attn_init(sc);
    {
        f32x4 s[2][4]; attn_scores(s, qf, lds, c, q4);
#pragma unroll
        for (int qt2 = 0; qt2 < 2; ++qt2) { const int tok = 32 * th + 16 * qt2 + c, qpos = t0 + tok; float mx = -__builtin_inff();
#pragma unroll
            for (int kt4 = 0; kt4 < 4; ++kt4)
#pragma unroll
                for (int e = 0; e < 4; ++e) { const int dist = qpos - (64 * (16 * kt4 + 4 * q4 + e) + 63);
                    const float x = (dist >= 0) ? s[qt2][kt4][e] * SL2 - slope2 * (float)dist : -__builtin_inff(); s[qt2][kt4][e] = x; mx = fmaxf(mx, x); }
            mx = fmaxf(mx, __shfl_xor(mx, 16)); mx = fmaxf(mx, __shfl_xor(mx, 32));
            const float mu = (mx == -__builtin_inff()) ? 0.f : mx; float ls = 0.f;
#pragma unroll
            for (int kt4 = 0; kt4 < 4; ++kt4)
#pragma unroll
                for (int e = 0; e < 4; ++e) { const float p = __builtin_amdgcn_exp2f(s[qt2][kt4][e] - mu); s[qt2][kt4][e] = p; ls += p; }
            ls += __shfl_xor(ls, 16); ls += __shfl_xor(ls, 32);
            const float il = ls > 0.f ? 1.0f / ls : 0.f;
#pragma unroll
            for (int kt4 = 0; kt4 < 4; ++kt4) { s[qt2][kt4] = s[qt2][kt4] * il; *(LAS f32x4*)(PSLAB + (r * 64 + tok) * 64 + 16 * kt4 + 4 * q4) = s[qt2][kt4]; } }
        attn_pv(sc.o, s, lds + KVT, c, q4);
    }
    __syncthreads();
    {
        const int tok = tid >> 3, jg = tid & 7;
#pragma unroll
        for (int h2 = 0; h2 < 2; ++h2) { f32x4 a = (f32x4){0.f, 0.f, 0.f, 0.f};
#pragma unroll
            for (int rr = 0; rr < 4; ++rr) a = a + *(LAS const f32x4*)(PSLAB + (rr * 64 + tok) * 64 + 8 * jg + 4 * h2);
            *(LAS f32x4*)(IMP + tok * 64 + 8 * jg + 4 * h2) = a; }
    }
    __syncthreads();
    {
        const int tok = tid >> 3, jg = tid & 7; unsigned long long bits = 0ull;
        for (int jj = 0; jj < 8; ++jj) { const int j = 8 * jg + jj; bool sel = false;
            if (j == 0 || j == qblk) sel = true;
            else if (j < qblk) { const float vj = IMP[tok * 64 + j]; int cnt = 0;
                for (int i = 1; i < qblk; ++i) { const float vi = IMP[tok * 64 + i]; cnt += (vi > vj || (vi == vj && i < j)) ? 1 : 0; }
                sel = cnt < 14; }
            if (sel) bits |= 1ull << j; }
        bits |= __shfl_xor(bits, 1); bits |= __shfl_xor(bits, 2); bits |= __shfl_xor(bits, 4);
        if (jg == 0) MASK[tok] = bits;
    }
    __syncthreads();
    if (tid < 64) { unsigned long long u = MASK[tid];
#pragma unroll
        for (int o = 1; o < 64; o <<= 1) u |= __shfl_xor(u, o);
        if (tid == 0) *(LAS unsigned long long*)(lds + SL_UMASK) = u; }
    __syncthreads();
    unsigned long long um = *(LAS unsigned long long*)(lds + SL_UMASK);
    um = ((unsigned long long)__builtin_amdgcn_readfirstlane((unsigned)(um >> 32)) << 32) | (unsigned)__builtin_amdgcn_readfirstlane((unsigned)um);
    const unsigned long long msk0 = MASK[32 * th + c], msk1 = MASK[32 * th + 16 + c];
    const bf16* KS = (const bf16*)(ws + WS_KS);
    AttnSt st; attn_init(st);
    f32x4 kb[4];
#pragma unroll
    for (int kt4 = 0; kt4 < 4; ++kt4) kb[kt4] = (f32x4){slope2 * (float)(16 * kt4 + 4 * q4), slope2 * (float)(16 * kt4 + 4 * q4 + 1), slope2 * (float)(16 * kt4 + 4 * q4 + 2), slope2 * (float)(16 * kt4 + 4 * q4 + 3)};
    u32x4 kr, vr;
    int jcur = __builtin_ctzll(um); um &= um - 1;
    kv_load_regs(kr, vr, KS, rowb + 64 * jcur, 64 * g, tid);
    __syncthreads();
    kv_store_lds(lds, lds + KVT, kr, vr, tid);
    __syncthreads();
    for (int i = 0;; ++i) {
        LAS unsigned char* Kt = lds + (i & 1) * 2 * KVT; LAS unsigned char* Vt = Kt + KVT;
        const bool more = um != 0ull; int jn = 0;
        if (more) { jn = __builtin_ctzll(um); um &= um - 1; kv_load_regs(kr, vr, KS, rowb + 64 * jn, 64 * g, tid); }
        const bool s0 = (msk0 >> jcur) & 1ull, s1 = (msk1 >> jcur) & 1ull;
        if (__any(s0 || s1)) {
            f32x4 s[2][4]; attn_scores(s, qf, Kt, c, q4);
            const int kbase = 64 * jcur;
            if (jcur < qblk) {
#pragma unroll
                for (int qt2 = 0; qt2 < 2; ++qt2) { const float c0 = (qt2 ? s1 : s0) ? slope2 * (float)(kbase - (t0 + 32 * th + 16 * qt2 + c)) - MFIX : -__builtin_inff();
#pragma unroll
                    for (int kt4 = 0; kt4 < 4; ++kt4) s[qt2][kt4] = s[qt2][kt4] * SL2 + (kb[kt4] + c0); }
            } else {
#pragma unroll
                for (int qt2 = 0; qt2 < 2; ++qt2) { const int qpos = t0 + 32 * th + 16 * qt2 + c; const bool sq = qt2 ? s1 : s0;
#pragma unroll
                    for (int kt4 = 0; kt4 < 4; ++kt4)
#pragma unroll
                        for (int e = 0; e < 4; ++e) { const int dist = qpos - (kbase + 16 * kt4 + 4 * q4 + e);
                            s[qt2][kt4][e] = (sq && dist >= 0) ? s[qt2][kt4][e] * SL2 - slope2 * (float)dist - MFIX : -__builtin_inff(); } }
            }
            attn_update_fixed(st, s, Vt, c, q4);
        }
        if (more) { LAS unsigned char* Kn = lds + ((i + 1) & 1) * 2 * KVT; kv_store_lds(Kn, Kn + KVT, kr, vr, tid); }
        __syncthreads();
        if (!more) break;
        jcur = jn;
    }
    const float* GATES = (const float*)(ws + WS_GATES); const bf16* OW = (const bf16*)(ws + WS_OWIN); bf16* OA = (bf16*)(ws + WS_OA);
#pragma unroll
    for (int qt2 = 0; qt2 < 2; ++qt2) { const size_t row = rowb + t0 + 32 * th + 16 * qt2 + c;
        float l = st.l[qt2]; l += __shfl_xor(l, 16); l += __shfl_xor(l, 32); const float il = l > 0.f ? 1.0f / l : 0.f;
        const float g0 = GATES[row * 24 + head * 3 + 0], g1 = GATES[row * 24 + head * 3 + 1] * il, g2 = GATES[row * 24 + head * 3 + 2];
        f32x4 oa[4]; float ss = 0.f;
#pragma unroll
        for (int dt = 0; dt < 4; ++dt) { const u32x2 wv = *(const u32x2*)(OW + row * 512 + 64 * head + 16 * dt + 4 * q4);
            const f32x4 ow = (f32x4){__builtin_bit_cast(float, wv.x << 16), __builtin_bit_cast(float, wv.x & 0xffff0000u), __builtin_bit_cast(float, wv.y << 16), __builtin_bit_cast(float, wv.y & 0xffff0000u)};
            oa[dt] = sc.o[dt][qt2] * g0 + st.o[dt][qt2] * g1 + ow * g2;
            ss += (oa[dt].x * oa[dt].x + oa[dt].y * oa[dt].y) + (oa[dt].z * oa[dt].z + oa[dt].w * oa[dt].w); }
        ss += __shfl_xor(ss, 16); ss += __shfl_xor(ss, 32);
        const float rs = 1.0f / sqrtf(ss * (1.f / 64.f) + EPS);
#pragma unroll
        for (int dt = 0; dt < 4; ++dt) { const f32x4 gn = *(const f32x4*)(attn_gain + 64 * head + 16 * dt + 4 * q4); const f32x4 v = oa[dt] * rs * gn;
            u32x2 wv; wv.x = cvtpk(v.x, v.y); wv.y = cvtpk(v.z, v.w); *(u32x2*)(OA + row * 1024 + 64 * head + 16 * dt + 4 * q4) = wv; } }
    __syncthreads();
}

constexpr int CA_RS = 272, CA_BUF = 128 * CA_RS  , CL_H = 0, CH_RS = 272, CL_O = 128 * CH_RS  , CO_RS = 272;
constexpr int N_CMP_ITEMS = 136;
__device__ __forceinline__ void compress_item(LAS unsigned char* lds, unsigned char* ws, const float* cache_kv, const int* page_table, const float* pe, const float* k_gain, int item, int tid) {
    const int lane = tid & 63, w = __builtin_amdgcn_readfirstlane(tid >> 6), c = lane & 15, q4 = lane >> 4;
    const int kind = item & 1, ci = item >> 1;
    const bool prompt = ci < 4;
    const int l_pl = (tid >> 5) & 1, l_piece = tid & 31, l_g = l_piece >> 4, l_d = 4 * (l_piece & 15), l_blo = tid >> 6;
    unsigned soff[8];
    const bf16* const KCp = (const bf16*)(ws + WS_KC);
#pragma unroll
    for (int i = 0; i < 8; ++i) { const int bl = 8 * i + l_blo;
        if (prompt) soff[i] = (unsigned)(((size_t)ci * SEQ + 64 * bl + l_pl) * 256 + 128 * kind + 4 * l_piece);
        else { const int sb = 2 * (ci - 4) + (bl >> 5), blk = bl & 31; const int page = page_table[sb * NPAGES + (blk >> 1)];
               soff[i] = (unsigned)(((size_t)page * PAGE + (blk & 1) * 64 + l_pl) * 512 + 128 * kind + 4 * l_piece); } }
    const float* pep = pe + kind * 4096 + l_pl * 64 + l_d;
    const int l_dst = (2 * l_blo + l_g) * CA_RS + (l_pl * 64 + l_d) * 2;
    const bf16* W1 = (const bf16*)(ws + WS_W1) + (size_t)kind * 128 * 4096 + (size_t)(16 * w + c) * 4096 + 8 * q4;
    f32x4 acc[8];
#pragma unroll
    for (int mt = 0; mt < 8; ++mt) acc[mt] = (f32x4){0.f, 0.f, 0.f, 0.f};
    u32x4 ra0[8], ra1[8]; bf16x8 rb0[4], rb1[4];
#define CMP_ALOAD(R, st) do { if (prompt) { _Pragma("unroll") for (int i = 0; i < 8; ++i) { const u32x2 t_ = *(const u32x2*)(KCp + (size_t)soff[i] + (size_t)(2 * (st)) * 256); R[i] = (u32x4){t_.x, t_.y, 0u, 0u}; } } \
        else { _Pragma("unroll") for (int i = 0; i < 8; ++i) R[i] = __builtin_nontemporal_load((const u32x4*)(cache_kv + (size_t)soff[i] + (size_t)(2 * (st)) * 512)); } } while (0)
#define CMP_ASTORE(R, st, buf) do { LAS unsigned char* A_ = lds + (buf) * CA_BUF + l_dst; \
        if (prompt) { _Pragma("unroll") for (int i = 0; i < 8; ++i) { u32x2 w_; w_.x = R[i].x; w_.y = R[i].y; *(LAS u32x2*)(A_ + 16 * i * CA_RS) = w_; } } \
        else { const f32x4 pv_ = *(const f32x4*)(pep + (2 * (st)) * 64); _Pragma("unroll") for (int i = 0; i < 8; ++i) { const f32x4 v_ = __builtin_bit_cast(f32x4, R[i]) + pv_; u32x2 w_; w_.x = cvtpk(v_.x, v_.y); w_.y = cvtpk(v_.z, v_.w); *(LAS u32x2*)(A_ + 16 * i * CA_RS) = w_; } } } while (0)
#define CMP_BLOAD(R, st) do { _Pragma("unroll") for (int ks = 0; ks < 4; ++ks) R[ks] = *(const bf16x8*)(W1 + 128 * (st) + 32 * ks); } while (0)
#define CMP_COMPUTE(RB, buf) do { LAS const unsigned char* A_ = lds + (buf) * CA_BUF + c * CA_RS + 16 * q4; \
        _Pragma("unroll") for (int ks = 0; ks < 4; ++ks) _Pragma("unroll") for (int mt = 0; mt < 8; ++mt) acc[mt] = mfma16(*(LAS const bf16x8*)(A_ + 16 * mt * CA_RS + 64 * ks), RB[ks], acc[mt]); } while (0)
    CMP_BLOAD(rb0, 0); CMP_ALOAD(ra0, 0); CMP_ALOAD(ra1, 1);
    CMP_ASTORE(ra0, 0, 0);
    __syncthreads();
    for (int s2 = 0; s2 < 32; s2 += 2) {
        CMP_BLOAD(rb1, s2 + 1);
        if (s2 + 2 < 32) CMP_ALOAD(ra0, s2 + 2);
        CMP_COMPUTE(rb0, 0);
        CMP_ASTORE(ra1, s2 + 1, 1);
        __syncthreads();
        if (s2 + 2 < 32) CMP_BLOAD(rb0, s2 + 2);
        if (s2 + 3 < 32) CMP_ALOAD(ra1, s2 + 3);
        CMP_COMPUTE(rb1, 1);
        if (s2 + 2 < 32) CMP_ASTORE(ra0, s2 + 2, 0);
        __syncthreads();
    }
#undef CMP_ALOAD
#undef CMP_ASTORE
#undef CMP_BLOAD
#undef CMP_COMPUTE
    {
        LAS unsigned short* H = (LAS unsigned short*)(lds + CL_H);
#pragma unroll
        for (int mt = 0; mt < 8; ++mt)
#pragma unroll
            for (int e = 0; e < 4; ++e) { const float v = siluf_(acc[mt][e]); H[(16 * mt + 4 * q4 + e) * (CH_RS / 2) + 16 * w + c] = (unsigned short)(cvtpk(v, 0.f) & 0xffffu); }
    }
    __syncthreads();
    {
        const int ot = w & 3, mt0 = 4 * (w >> 2);
        const bf16* W2 = (const bf16*)(ws + WS_W2) + (size_t)kind * 64 * 128 + (size_t)(16 * ot + c) * 128 + 8 * q4;
        LAS const unsigned char* H = lds + CL_H + (16 * mt0 + c) * CH_RS + 16 * q4;
        f32x4 o[4];
#pragma unroll
        for (int mt = 0; mt < 4; ++mt) o[mt] = (f32x4){0.f, 0.f, 0.f, 0.f};
#pragma unroll
        for (int ks = 0; ks < 4; ++ks) { const bf16x8 bw = *(const bf16x8*)(W2 + 32 * ks);
#pragma unroll
            for (int mt = 0; mt < 4; ++mt) o[mt] = mfma16(*(LAS const bf16x8*)(H + 16 * mt * CH_RS + 64 * ks), bw, o[mt]); }
        LAS float* O = (LAS float*)(lds + CL_O);
#pragma unroll
        for (int mt = 0; mt < 4; ++mt)
#pragma unroll
            for (int e = 0; e < 4; ++e) O[(16 * (mt0 + mt) + 4 * q4 + e) * (CO_RS / 4) + 16 * ot + c] = o[mt][e];
    }
    __syncthreads();
#pragma unroll
    for (int rep = 0; rep < 2; ++rep) {
        const int id = rep * 512 + tid, row = id >> 3, seg = id & 7;
        LAS const float* O = (LAS const float*)(lds + CL_O) + row * (CO_RS / 4) + 8 * seg;
        f32x4 a = *(LAS const f32x4*)O, b = *(LAS const f32x4*)(O + 4);
        if (kind == 0) { float ss = (a.x * a.x + a.y * a.y) + (a.z * a.z + a.w * a.w) + (b.x * b.x + b.y * b.y) + (b.z * b.z + b.w * b.w);
            ss += __shfl_xor(ss, 1); ss += __shfl_xor(ss, 2); ss += __shfl_xor(ss, 4);
            const float rs = 1.0f / sqrtf(ss * (1.f / 64.f) + EPS);
            a = a * rs * *(const f32x4*)(k_gain + 8 * seg); b = b * rs * *(const f32x4*)(k_gain + 8 * seg + 4); }
        float* dst = (float*)(ws + (kind == 0 ? WS_KCMP : WS_VCMP)) + ((size_t)(64 * ci + (row >> 1)) * 2 + (row & 1)) * 64 + 8 * seg;
        *(f32x4*)dst = a; *(f32x4*)(dst + 4) = b;
    }
    __syncthreads();
}

constexpr int HG_QH = 0, HG_QT = KVT, HG_KT = 2 * KVT, HG_KH = 3 * KVT, HG_V = 4 * KVT, HG_CUM = 5 * KVT, HG_GRS = 272, HG_REF = HG_CUM + 64 * HG_GRS, HG_LASTV = HG_REF + 256, HG_LAST = HG_LASTV + 256, HG_HALF = HG_LAST + 256;
constexpr int HG_GLB = HG_QT;
static_assert(64 * HG_GRS <= 2 * KVT && 2 * HG_HALF <= LDS_CTLW, "hgrn LDS map");
__device__ __forceinline__ void hgrn_local_item(LAS unsigned char* lds_all, unsigned char* ws, int item, int tid) {
    const int half = tid >> 8, lt = tid & 255, lane = tid & 63, we = __builtin_amdgcn_readfirstlane((tid >> 6) & 3), c = lane & 15, q4 = lane >> 4;
    LAS unsigned char* lds = lds_all + half * HG_HALF;
    const int unit = 2 * item + half, b = unit >> 7, h = (unit >> 4) & 7, sc = unit & 15;
    const size_t T0 = (size_t)b * SEQ + 256 * sc; const int hc = 64 * h;
    const bf16* RQ = (const bf16*)(ws + WS_RQ); const bf16* RK = (const bf16*)(ws + WS_RK); const bf16* RV = (const bf16*)(ws + WS_RV); const float* GL = (const float*)(ws + WS_GL);
    bf16* OLOC = (bf16*)(ws + WS_OLOC); bf16* QH = (bf16*)(ws + WS_QH);
    LAS float* LASTE = (LAS float*)(lds + HG_LAST);
    const int gp = lt & 15, gtb = lt >> 4, op = lt & 7, otb = lt >> 3;
    const int pd = lt & 63, ptq = lt >> 6;
    f32x4 S[4];
#pragma unroll
    for (int dt = 0; dt < 4; ++dt) S[dt] = (f32x4){0.f, 0.f, 0.f, 0.f};
    float base8[8];
#pragma unroll
    for (int j = 0; j < 8; ++j) base8[j] = 0.f;
    f32x4 gl_r[4]; u32x4 q_r[2], k_r[2], v_r[2];
#define HG_PREFETCH(cc_) do { const size_t R_ = T0 + 64 * (cc_); \
        _Pragma("unroll") for (int i = 0; i < 4; ++i) gl_r[i] = *(const f32x4*)(GL + (R_ + gtb + 16 * i) * 512 + hc + 4 * gp); \
        _Pragma("unroll") for (int i = 0; i < 2; ++i) { const size_t g_ = (R_ + otb + 32 * i) * 512 + hc + 8 * op; q_r[i] = *(const u32x4*)(RQ + g_); k_r[i] = *(const u32x4*)(RK + g_); v_r[i] = *(const u32x4*)(RV + g_); } } while (0)
    HG_PREFETCH(0);
    for (int cc = 0; cc < 4; ++cc) {
        const size_t R0 = T0 + 64 * cc;
#pragma unroll
        for (int i = 0; i < 4; ++i) *(LAS f32x4*)(lds + HG_GLB + (gtb + 16 * i) * HG_GRS + 16 * gp) = gl_r[i];
#pragma unroll
        for (int i = 0; i < 2; ++i) *(LAS u32x4*)(lds + HG_V + (otb + 32 * i) * KVS + 16 * op) = v_r[i];
        u32x4 qc[2], kc[2];
#pragma unroll
        for (int i = 0; i < 2; ++i) { qc[i] = q_r[i]; kc[i] = k_r[i]; }
        if (cc + 1 < 4) HG_PREFETCH(cc + 1);
        __syncthreads();
        {
            float run = 0.f;
            for (int t = 0; t < 16 * ptq; ++t) run += *(LAS const float*)(lds + HG_GLB + t * HG_GRS + 4 * pd);
#pragma unroll
            for (int i = 0; i < 16; ++i) { const int t = 16 * ptq + i; run += *(LAS const float*)(lds + HG_GLB + t * HG_GRS + 4 * pd); *(LAS float*)(lds + HG_CUM + t * HG_GRS + 4 * pd) = run; }
            if (ptq == 1) *(LAS float*)(lds + HG_REF + 4 * pd) = run;
            if (ptq == 3) { *(LAS float*)(lds + HG_LASTV + 4 * pd) = run; LASTE[pd] = __expf(run); }
        }
        __syncthreads();
        {
            const f32x4 rf0 = *(LAS const f32x4*)(lds + HG_REF + 32 * op), rf1 = *(LAS const f32x4*)(lds + HG_REF + 32 * op + 16);
            const f32x4 la0 = *(LAS const f32x4*)(lds + HG_LASTV + 32 * op), la1 = *(LAS const f32x4*)(lds + HG_LASTV + 32 * op + 16);
#pragma unroll
            for (int i = 0; i < 2; ++i) { const int t = otb + 32 * i;
                const f32x4 cu0 = *(LAS const f32x4*)(lds + HG_CUM + t * HG_GRS + 32 * op), cu1 = *(LAS const f32x4*)(lds + HG_CUM + t * HG_GRS + 32 * op + 16);
                float qh[8], qt[8], kt[8], kh[8], qg[8];
#pragma unroll
                for (int j = 0; j < 8; ++j) { const float cum = j < 4 ? cu0[j] : cu1[j - 4], ref = j < 4 ? rf0[j] : rf1[j - 4], last = j < 4 ? la0[j] : la1[j - 4];
                    const unsigned qw = qc[i][j >> 1], kw = kc[i][j >> 1];
                    const float q = __builtin_bit_cast(float, (j & 1) ? (qw & 0xffff0000u) : (qw << 16)), k = __builtin_bit_cast(float, (j & 1) ? (kw & 0xffff0000u) : (kw << 16));
                    const float dq = fminf(fmaxf(cum - ref, -60.f), 60.f);
                    qh[j] = q * __expf(cum); qt[j] = q * __expf(dq); kt[j] = k * __expf(-dq); kh[j] = k * __expf(last - cum); qg[j] = q * __expf(base8[j] + cum); }
                const int lo = t * KVS + 16 * op;
                *(LAS bf16x8*)(lds + HG_QH + lo) = pack8((f32x4){qh[0], qh[1], qh[2], qh[3]}, (f32x4){qh[4], qh[5], qh[6], qh[7]});
                *(LAS bf16x8*)(lds + HG_QT + lo) = pack8((f32x4){qt[0], qt[1], qt[2], qt[3]}, (f32x4){qt[4], qt[5], qt[6], qt[7]});
                *(LAS bf16x8*)(lds + HG_KT + lo) = pack8((f32x4){kt[0], kt[1], kt[2], kt[3]}, (f32x4){kt[4], kt[5], kt[6], kt[7]});
                *(LAS bf16x8*)(lds + HG_KH + lo) = pack8((f32x4){kh[0], kh[1], kh[2], kh[3]}, (f32x4){kh[4], kh[5], kh[6], kh[7]});
                *(bf16x8*)(QH + (R0 + t) * 512 + hc + 8 * op) = pack8((f32x4){qg[0], qg[1], qg[2], qg[3]}, (f32x4){qg[4], qg[5], qg[6], qg[7]}); }
#pragma unroll
            for (int j = 0; j < 8; ++j) base8[j] += j < 4 ? la0[j] : la1[j - 4];
        }
        __syncthreads();
        f32x4 at[4][4];
#pragma unroll
        for (int tt = 0; tt < 4; ++tt) {
            const bf16x8 qa = *(LAS const bf16x8*)(lds + HG_QT + (16 * tt + c) * KVS + 16 * q4), qb = *(LAS const bf16x8*)(lds + HG_QT + (16 * tt + c) * KVS + 64 + 16 * q4);
#pragma unroll
            for (int st = 0; st < 4; ++st) {
                if (st <= tt) {
                    const bf16x8 ka = *(LAS const bf16x8*)(lds + HG_KT + (16 * st + c) * KVS + 16 * q4), kb = *(LAS const bf16x8*)(lds + HG_KT + (16 * st + c) * KVS + 64 + 16 * q4);
                    f32x4 a = mfma16(kb, qb, mfma16(ka, qa, (f32x4){0.f, 0.f, 0.f, 0.f}));
                    if (st == tt) {
#pragma unroll
                        for (int i = 0; i < 4; ++i) a[i] = (4 * q4 + i <= c) ? a[i] : 0.f; }
                    at[st][tt] = a;
                } else at[st][tt] = (f32x4){0.f, 0.f, 0.f, 0.f};
            }
        }
        const int vrow = 4 * q4 + (c >> 2), vcol = 8 * (c & 3);
        f32x4 o[4];
#pragma unroll
        for (int tt = 0; tt < 4; ++tt) o[tt] = (f32x4){0.f, 0.f, 0.f, 0.f};
#pragma unroll
        for (int s2 = 0; s2 < 2; ++s2) {
            const bf16x8 vf = cat44(ldtr(lds + HG_V + (32 * s2 + vrow) * KVS + 32 * we + vcol), ldtr(lds + HG_V + (32 * s2 + 16 + vrow) * KVS + 32 * we + vcol));
#pragma unroll
            for (int tt = 0; tt < 4; ++tt) if (2 * s2 <= tt) o[tt] = mfma16(vf, pack8(at[2 * s2][tt], at[2 * s2 + 1][tt]), o[tt]);
        }
#pragma unroll
        for (int ks = 0; ks < 2; ++ks) {
            const bf16x8 sf = pack8(S[2 * ks], S[2 * ks + 1]);
#pragma unroll
            for (int tt = 0; tt < 4; ++tt) {
                const bf16x8 qh = cat44(*(LAS const bf16x4*)(lds + HG_QH + (16 * tt + c) * KVS + 64 * ks + 8 * q4), *(LAS const bf16x4*)(lds + HG_QH + (16 * tt + c) * KVS + 64 * ks + 32 + 8 * q4));
                o[tt] = mfma16(sf, qh, o[tt]);
            }
        }
#pragma unroll
        for (int tt = 0; tt < 4; ++tt) { u32x2 ow; ow.x = cvtpk(o[tt].x, o[tt].y); ow.y = cvtpk(o[tt].z, o[tt].w); *(u32x2*)(OLOC + (R0 + 16 * tt + c) * 512 + hc + 16 * we + 4 * q4) = ow; }
        const int srow = 8 * q4 + (c >> 2);
#pragma unroll
        for (int dt = 0; dt < 4; ++dt) { const f32x4 dec = *(LAS const f32x4*)(LASTE + 16 * dt + 4 * q4); S[dt] = S[dt] * dec; }
#pragma unroll
        for (int s2 = 0; s2 < 2; ++s2) {
            const bf16x8 vb = cat44(ldtr(lds + HG_V + (32 * s2 + srow) * KVS + 32 * we + vcol), ldtr(lds + HG_V + (32 * s2 + 4 + srow) * KVS + 32 * we + vcol));
#pragma unroll
            for (int dt = 0; dt < 4; ++dt) {
                const bf16x8 ka = cat44(ldtr(lds + HG_KH + (32 * s2 + srow) * KVS + 32 * dt + vcol), ldtr(lds + HG_KH + (32 * s2 + 4 + srow) * KVS + 32 * dt + vcol));
                S[dt] = mfma16(ka, vb, S[dt]);
            }
        }
        __syncthreads();
    }
    float* TS = (float*)(ws + WS_TSC) + (size_t)unit * 4096;
#pragma unroll
    for (int dt = 0; dt < 4; ++dt)
#pragma unroll
        for (int i = 0; i < 4; ++i) TS[(16 * dt + 4 * q4 + i) * 64 + 16 * we + c] = S[dt][i];
    if (otb == 0) {
#pragma unroll
        for (int j = 0; j < 8; ++j) ((float*)(ws + WS_DSC))[unit * 64 + 8 * op + j] = __expf(base8[j]); }
#undef HG_PREFETCH
}

__device__ __forceinline__ void hgrn_combine_unit(LAS unsigned char* lds, unsigned char* ws, float* out, const float* rnn_gain, int unit, int tid) {
    const int lane = tid & 63, w = __builtin_amdgcn_readfirstlane(tid >> 6), c = lane & 15, q4 = lane >> 4;
    const int b = unit >> 7, h = (unit >> 4) & 7, sc = unit & 15, hc = 64 * h;
    const size_t T0 = (size_t)b * SEQ + 256 * sc;
    const float* TSC = (const float*)(ws + WS_TSC); const float* DSC = (const float*)(ws + WS_DSC);
    {
        const int d = tid >> 3, e0 = 8 * (tid & 7);
        f32x4 c0 = (f32x4){0.f, 0.f, 0.f, 0.f}, c1 = c0;
        for (int j0 = 0; j0 < sc; j0 += 8) {
            float dj[8]; f32x4 ta[8], tb[8];
#pragma unroll
            for (int q = 0; q < 8; ++q) { const int j = j0 + q < sc ? j0 + q : sc - 1; const int u = unit - sc + j; dj[q] = DSC[u * 64 + d]; const float* tp = TSC + (size_t)u * 4096 + d * 64 + e0; ta[q] = *(const f32x4*)tp; tb[q] = *(const f32x4*)(tp + 4); }
#pragma unroll
            for (int q = 0; q < 8; ++q) if (j0 + q < sc) { c0 = c0 * dj[q] + ta[q]; c1 = c1 * dj[q] + tb[q]; }
        }
        if (sc == 15) { const float dj = DSC[unit * 64 + d]; const float* tp = TSC + (size_t)unit * 4096 + d * 64 + e0; float* op = out + O_RNNP + (size_t)(b * 8 + h) * 4096 + d * 64 + e0;
            *(f32x4*)op = c0 * dj + *(const f32x4*)tp; *(f32x4*)(op + 4) = c1 * dj + *(const f32x4*)(tp + 4); }
        LAS unsigned short* CT = (LAS unsigned short*)lds;
#pragma unroll
        for (int i = 0; i < 4; ++i) { CT[(e0 + i) * (KVS / 2) + d] = (unsigned short)(cvtpk(c0[i], 0.f) & 0xffffu); CT[(e0 + 4 + i) * (KVS / 2) + d] = (unsigned short)(cvtpk(c1[i], 0.f) & 0xffffu); }
    }
    __syncthreads();
    const bf16* QH = (const bf16*)(ws + WS_QH); const bf16* OLOC = (const bf16*)(ws + WS_OLOC); const bf16* RG = (const bf16*)(ws + WS_RG); bf16* OA = (bf16*)(ws + WS_OA);
    bf16x8 ctf[4][2];
#pragma unroll
    for (int et = 0; et < 4; ++et)
#pragma unroll
        for (int ks = 0; ks < 2; ++ks) ctf[et][ks] = *(LAS const bf16x8*)(lds + (16 * et + c) * KVS + 64 * ks + 16 * q4);
    bf16x8 qh0[2], qh1[2]; u32x2 olw[2][4], rgw[2][4];
#pragma unroll
    for (int tt = 0; tt < 2; ++tt) { const size_t row = T0 + 32 * w + 16 * tt + c;
        qh0[tt] = *(const bf16x8*)(QH + row * 512 + hc + 8 * q4); qh1[tt] = *(const bf16x8*)(QH + row * 512 + hc + 32 + 8 * q4);
#pragma unroll
        for (int et = 0; et < 4; ++et) { olw[tt][et] = *(const u32x2*)(OLOC + row * 512 + hc + 16 * et + 4 * q4); rgw[tt][et] = *(const u32x2*)(RG + row * 512 + hc + 16 * et + 4 * q4); } }
    f32x4 gnv[4];
#pragma unroll
    for (int et = 0; et < 4; ++et) gnv[et] = *(const f32x4*)(rnn_gain + hc + 16 * et + 4 * q4);
#pragma unroll
    for (int tt = 0; tt < 2; ++tt) {
        const size_t row = T0 + 32 * w + 16 * tt + c;
        f32x4 o[4]; float ss = 0.f;
#pragma unroll
        for (int et = 0; et < 4; ++et) { const u32x2 lw = olw[tt][et];
            const f32x4 ol = (f32x4){__builtin_bit_cast(float, lw.x << 16), __builtin_bit_cast(float, lw.x & 0xffff0000u), __builtin_bit_cast(float, lw.y << 16), __builtin_bit_cast(float, lw.y & 0xffff0000u)};
            o[et] = mfma16(ctf[et][1], qh1[tt], mfma16(ctf[et][0], qh0[tt], ol));
            ss += (o[et].x * o[et].x + o[et].y * o[et].y) + (o[et].z * o[et].z + o[et].w * o[et].w); }
        ss += __shfl_xor(ss, 16); ss += __shfl_xor(ss, 32);
        const float rs = __builtin_amdgcn_rsqf(ss * (1.f / 64.f) + EPS);
#pragma unroll
        for (int et = 0; et < 4; ++et) { const int col = hc + 16 * et + 4 * q4; const u32x2 gw = rgw[tt][et];
            const f32x4 gg = (f32x4){__builtin_bit_cast(float, gw.x << 16), __builtin_bit_cast(float, gw.x & 0xffff0000u), __builtin_bit_cast(float, gw.y << 16), __builtin_bit_cast(float, gw.y & 0xffff0000u)};
            const f32x4 v = o[et] * rs * gnv[et] * gg;
            u32x2 wv; wv.x = cvtpk(v.x, v.y); wv.y = cvtpk(v.z, v.w); *(u32x2*)(OA + row * 1024 + 512 + col) = wv; }
    }
    __syncthreads();
}

__device__ __forceinline__ void rnn_sample_wave(unsigned char* ws, float* out, const float* state_rnn, const float* rnn_gain, int bh, int lane) {
    const int b = bh >> 3, h = bh & 7, hc = 64 * h;
    const float* sp = state_rnn + (size_t)bh * 4096 + lane; float* op = out + O_RNNS + (size_t)bh * 4096 + lane;
    float S[64];
#pragma unroll
    for (int d = 0; d < 64; ++d) S[d] = __builtin_nontemporal_load(sp + d * 64);
    const bf16* RQ = (const bf16*)(ws + WS_RQ); const bf16* RK = (const bf16*)(ws + WS_RK); const bf16* RV = (const bf16*)(ws + WS_RV); const bf16* RG = (const bf16*)(ws + WS_RG);
    const float* GL = (const float*)(ws + WS_GL); bf16* OA = (bf16*)(ws + WS_OA);
    float f8[DECT], k8[DECT], q8[DECT], v8[DECT], g8[DECT];
#pragma unroll
    for (int t = 0; t < DECT; ++t) { const size_t gi = ((size_t)MP + b * DECT + t) * 512 + hc + lane; f8[t] = GL[gi]; k8[t] = bf2f(RK[gi]); q8[t] = bf2f(RQ[gi]); v8[t] = bf2f(RV[gi]); g8[t] = bf2f(RG[gi]); }
    const float gn = rnn_gain[hc + lane];
#pragma unroll
    for (int t = 0; t < DECT; ++t) {
        const float f = __expf(f8[t]), k = k8[t], q = q8[t], v = v8[t];
        float o = 0.f;
#pragma unroll
        for (int d = 0; d < 64; ++d) { const float fd = __builtin_bit_cast(float, __builtin_amdgcn_readlane(__builtin_bit_cast(int, f), d)), kd = __builtin_bit_cast(float, __builtin_amdgcn_readlane(__builtin_bit_cast(int, k), d)),
                qd = __builtin_bit_cast(float, __builtin_amdgcn_readlane(__builtin_bit_cast(int, q), d)); S[d] = fd * S[d] + kd * v; o += qd * S[d]; }
        const float rs = __builtin_amdgcn_rsqf(wave_sum(o * o) * (1.f / 64.f) + EPS);
        const float y = o * rs * gn * g8[t];
        OA[((size_t)MP + b * DECT + t) * 1024 + 512 + hc + lane] = (unsigned short)(cvtpk(y, 0.f) & 0xffffu);
    }
#pragma unroll
    for (int d = 0; d < 64; ++d) __builtin_nontemporal_store(S[d], op + d * 64);
}


template <int RS, bool WINDOW>
__device__ __forceinline__ void samp_tile_f32(AttnSt& st, const bf16x8 (&qf)[2][2], const float* kp, int kpos0, int qpos, float sl0, float sl1, bool blocksel, LAS unsigned char* Vw, int lane, int c, int q4, float* cpy = nullptr, int row0 = 0) {
    f32x4 s[2][4];
    const float* vb = kp + (size_t)(lane >> 4) * RS + 128 + 4 * (lane & 15);
    const float* kb = kp + (size_t)c * RS + 8 * q4;
    LAS unsigned char* vd = Vw + (lane >> 4) * KVS + 8 * (lane & 15);
    f32x4 va[4];
#define SAMP_VLOAD(B) _Pragma("unroll") for (int it = 0; it < 4; ++it) va[it] = __builtin_nontemporal_load((const f32x4*)(vb + (size_t)(4 * (B) + it) * 4 * RS))
#define SAMP_VSTORE(B) _Pragma("unroll") for (int it = 0; it < 4; ++it) { u32x2 wv; wv.x = cvtpk(va[it].x, va[it].y); wv.y = cvtpk(va[it].z, va[it].w); *(LAS u32x2*)(vd + (4 * (B) + it) * 4 * KVS) = wv; \
        if (WINDOW && cpy) { const int r_ = row0 + 4 * (4 * (B) + it) + (lane >> 4) - 8; if (r_ >= 0) __builtin_nontemporal_store(va[it], (f32x4*)(cpy + (size_t)r_ * 256 + 128 + 4 * (lane & 15))); } }
#pragma unroll
    for (int kt4 = 0; kt4 < 4; ++kt4) {
        SAMP_VLOAD(kt4);
        f32x4 kl[2][2];
#pragma unroll
        for (int ks = 0; ks < 2; ++ks) { const float* p = kb + (size_t)(16 * kt4) * RS + 32 * ks; kl[ks][0] = __builtin_nontemporal_load((const f32x4*)p); kl[ks][1] = __builtin_nontemporal_load((const f32x4*)(p + 4)); }
        const bf16x8 k0 = pack8(kl[0][0], kl[0][1]), k1 = pack8(kl[1][0], kl[1][1]);
        if (WINDOW && cpy) { const int r_ = row0 + 16 * kt4 + c - 8; if (r_ >= 0) { float* d_ = cpy + (size_t)r_ * 256 + 8 * q4; __builtin_nontemporal_store(kl[0][0], (f32x4*)d_); __builtin_nontemporal_store(kl[0][1], (f32x4*)(d_ + 4)); __builtin_nontemporal_store(kl[1][0], (f32x4*)(d_ + 32)); __builtin_nontemporal_store(kl[1][1], (f32x4*)(d_ + 36)); } }
#pragma unroll
        for (int qt2 = 0; qt2 < 2; ++qt2) s[qt2][kt4] = mfma16(k1, qf[qt2][1], mfma16(k0, qf[qt2][0], (f32x4){0.f, 0.f, 0.f, 0.f}));
        SAMP_VSTORE(kt4);
        asm volatile("" ::: "memory");
    }
#undef SAMP_VLOAD
#undef SAMP_VSTORE
#pragma unroll
    for (int qt2 = 0; qt2 < 2; ++qt2)
#pragma unroll
        for (int kt4 = 0; kt4 < 4; ++kt4)
#pragma unroll
            for (int e = 0; e < 4; ++e) { const int dist = qpos - (kpos0 + 16 * kt4 + 4 * q4 + e);
                const bool ok = WINDOW ? (dist >= 0 && dist < 512) : (blocksel && dist >= 0);
                s[qt2][kt4][e] = ok ? s[qt2][kt4][e] * SL2 - (qt2 ? sl1 : sl0) * (float)dist - MFIX : -__builtin_inff(); }
    attn_update_fixed<true>(st, s, Vw, c, q4);
}
__device__ __forceinline__ void samp_tile_new(AttnSt& st, const bf16x8 (&qf)[2][2], const bf16* base  , int ti, float sl0, float sl1, bool blocksel, LAS unsigned char* Vw, int lane, int c, int q4) {
    bf16x8 kf[2]; const bf16x8 z8 = (bf16x8){0, 0, 0, 0, 0, 0, 0, 0};
#pragma unroll
    for (int ks = 0; ks < 2; ++ks) kf[ks] = (c < 8) ? *(const bf16x8*)(base + (size_t)c * 256 + 32 * ks + 8 * q4) : z8;
#pragma unroll
    for (int it = 0; it < 8; ++it) { const int idx = it * 64 + lane, row = idx >> 3, pc = idx & 7;
        const u32x4 v = (row < 8) ? *(const u32x4*)(base + (size_t)row * 256 + 128 + 8 * pc) : (u32x4){0u, 0u, 0u, 0u};
        *(LAS u32x4*)(Vw + row * KVS + 16 * pc) = v; }
    f32x4 s[2][4];
#pragma unroll
    for (int qt2 = 0; qt2 < 2; ++qt2) { s[qt2][0] = mfma16(kf[1], qf[qt2][1], mfma16(kf[0], qf[qt2][0], (f32x4){0.f, 0.f, 0.f, 0.f}));
#pragma unroll
        for (int kt4 = 1; kt4 < 4; ++kt4) s[qt2][kt4] = (f32x4){-__builtin_inff(), -__builtin_inff(), -__builtin_inff(), -__builtin_inff()};
#pragma unroll
        for (int e = 0; e < 4; ++e) { const int key = 4 * q4 + e, dist = ti - key;
            const bool ok = key < 8 && dist >= 0 && blocksel;
            s[qt2][0][e] = ok ? s[qt2][0][e] * SL2 - (qt2 ? sl1 : sl0) * (float)dist - MFIX : -__builtin_inff(); } }
    attn_update_fixed<true>(st, s, Vw, c, q4);
}

constexpr int SA_V = 0, SA_PART = 8 * KVT  , SA_ML = SA_PART + 65536, SA_IMP = SA_ML + 2048, SA_SM = SA_IMP + 1024, SA_END = SA_SM + 64;
static_assert(SA_END <= LDS_CTLW, "sample attention LDS");
__device__ __forceinline__ void samp_attn_unit(LAS unsigned char* lds, unsigned char* ws, const float* cache_kv, const float* cache_win, const int* page_table, const float* attn_gain, float* wout, int unit, int tid) {
    const int lane = tid & 63, w = __builtin_amdgcn_readfirstlane(tid >> 6), c = lane & 15, q4 = lane >> 4;
    const int b = unit >> 1, g = unit & 1, ti = c & 7;
    const size_t srow = (size_t)MP + (size_t)b * DECT;
    float slope2[2]; int headq[2];
#pragma unroll
    for (int qt2 = 0; qt2 < 2; ++qt2) { headq[qt2] = 4 * g + 2 * qt2 + (c >> 3); slope2[qt2] = __builtin_amdgcn_exp2f(-(float)(headq[qt2] + 1)) * LOG2E; }
    const int qpos = PAST + ti;
    bf16x8 qf[2][2];
    { const bf16* Q = (const bf16*)(ws + WS_Q);
#pragma unroll
      for (int qt2 = 0; qt2 < 2; ++qt2)
#pragma unroll
          for (int ks = 0; ks < 2; ++ks) qf[qt2][ks] = *(const bf16x8*)(Q + (srow + ti) * 512 + 64 * headq[qt2] + 32 * ks + 8 * q4); }
    LAS unsigned char* Vw = lds + SA_V + w * KVT;
    LAS float* PART = (LAS float*)(lds + SA_PART); LAS float* ML = (LAS float*)(lds + SA_ML); LAS float* IMP = (LAS float*)(lds + SA_IMP);
    LAS unsigned long long* SM = (LAS unsigned long long*)(lds + SA_SM);
    const int frow = tid >> 4, fseg = tid & 15;

    auto write_partial = [&](AttnSt& st) {
#pragma unroll
        for (int qt2 = 0; qt2 < 2; ++qt2) { float l = st.l[qt2]; l += __shfl_xor(l, 16); l += __shfl_xor(l, 32);
            if (q4 == 0) { ML[(w * 32 + 16 * qt2 + c) * 2] = st.m[qt2]; ML[(w * 32 + 16 * qt2 + c) * 2 + 1] = l; }
#pragma unroll
            for (int dt = 0; dt < 4; ++dt) *(LAS f32x4*)(PART + (w * 32 + 16 * qt2 + c) * 64 + 16 * dt + 4 * q4) = st.o[dt][qt2]; }
    };
    auto combine = [&]() -> f32x4 {
        float M = -__builtin_inff();
#pragma unroll
        for (int ww = 0; ww < 8; ++ww) M = fmaxf(M, ML[(ww * 32 + frow) * 2]);
        float L = 0.f; f32x4 o = (f32x4){0.f, 0.f, 0.f, 0.f};
#pragma unroll
        for (int ww = 0; ww < 8; ++ww) { const float mw = ML[(ww * 32 + frow) * 2]; const float wgt = (mw == -__builtin_inff()) ? 0.f : __builtin_amdgcn_exp2f(mw - M);
            L += ML[(ww * 32 + frow) * 2 + 1] * wgt; o = o + *(LAS const f32x4*)(PART + (ww * 32 + frow) * 64 + 4 * fseg) * wgt; }
        return o * (L > 0.f ? 1.0f / L : 0.f);
    };

    f32x4 o_cmp;
    {
        const float* kc = (const float*)(ws + WS_KCMP) + ((size_t)(256 + b * 32) * 2 + g) * 64;
        const float* vc = (const float*)(ws + WS_VCMP) + ((size_t)(256 + b * 32) * 2 + g) * 64;
        bf16x8 kf[2][2];
#pragma unroll
        for (int kt4 = 0; kt4 < 2; ++kt4)
#pragma unroll
            for (int ks = 0; ks < 2; ++ks) { const float* p = kc + (size_t)(16 * kt4 + c) * 128 + 32 * ks + 8 * q4; kf[kt4][ks] = pack8(*(const f32x4*)p, *(const f32x4*)(p + 4)); }
#pragma unroll
        for (int it = 0; it < 16; ++it) { const int idx = it * 64 + lane, row = idx >> 4, pc = idx & 15;
            const f32x4 v = (row < 32) ? *(const f32x4*)(vc + (size_t)row * 128 + 4 * pc) : (f32x4){0.f, 0.f, 0.f, 0.f};
            u32x2 wv; wv.x = cvtpk(v.x, v.y); wv.y = cvtpk(v.z, v.w); *(LAS u32x2*)(Vw + row * KVS + 8 * pc) = wv; }
        f32x4 s[2][4]; AttnSt sc; attn_init(sc);
#pragma unroll
        for (int qt2 = 0; qt2 < 2; ++qt2) { float mx = -__builtin_inff();
#pragma unroll
            for (int kt4 = 0; kt4 < 2; ++kt4) { s[qt2][kt4] = mfma16(kf[kt4][1], qf[qt2][1], mfma16(kf[kt4][0], qf[qt2][0], (f32x4){0.f, 0.f, 0.f, 0.f}));
#pragma unroll
                for (int e = 0; e < 4; ++e) { const int dist = qpos - (64 * (16 * kt4 + 4 * q4 + e) + 63); const float x = s[qt2][kt4][e] * SL2 - slope2[qt2] * (float)dist; s[qt2][kt4][e] = x; mx = fmaxf(mx, x); } }
            s[qt2][2] = (f32x4){0.f, 0.f, 0.f, 0.f}; s[qt2][3] = (f32x4){0.f, 0.f, 0.f, 0.f};
            mx = fmaxf(mx, __shfl_xor(mx, 16)); mx = fmaxf(mx, __shfl_xor(mx, 32)); float ls = 0.f;
#pragma unroll
            for (int kt4 = 0; kt4 < 2; ++kt4)
#pragma unroll
                for (int e = 0; e < 4; ++e) { const float p = __builtin_amdgcn_exp2f(s[qt2][kt4][e] - mx); s[qt2][kt4][e] = p; ls += p; }
            ls += __shfl_xor(ls, 16); ls += __shfl_xor(ls, 32); const float il = 1.0f / ls;
            s[qt2][0] = s[qt2][0] * il; s[qt2][1] = s[qt2][1] * il; }
#pragma unroll
        for (int kt4 = 0; kt4 < 2; ++kt4) { f32x4 a = s[0][kt4] + s[1][kt4];
#pragma unroll
            for (int e = 0; e < 4; ++e) a[e] += __shfl_xor(a[e], 8);
            if (w == 0 && c < 8) *(LAS f32x4*)(IMP + c * 32 + 16 * kt4 + 4 * q4) = a; }
        attn_pv_lean(sc.o, s, Vw, c, q4);
        if (w == 0) {
#pragma unroll
            for (int qt2 = 0; qt2 < 2; ++qt2)
#pragma unroll
                for (int dt = 0; dt < 4; ++dt) *(LAS f32x4*)(PART + (16 * qt2 + c) * 64 + 16 * dt + 4 * q4) = sc.o[dt][qt2]; }
    }
    __syncthreads();
    o_cmp = *(LAS const f32x4*)(PART + frow * 64 + 4 * fseg);
    {
        bool sel = false; const int j = lane;
        if (j == 0 || j == 32) sel = true;
        else if (j < 32) { const float vj = IMP[w * 32 + j]; int cnt = 0;
            for (int i = 1; i < 32; ++i) { const float vi = IMP[w * 32 + i]; cnt += (vi > vj || (vi == vj && i < j)) ? 1 : 0; }
            sel = cnt < 14; }
        const unsigned long long bm = __ballot(sel);
        if (lane == 0) SM[w] = bm;
    }
    __syncthreads();
    const unsigned long long mymask = SM[ti];
    unsigned long long um = 0ull;
#pragma unroll
    for (int i = 0; i < 8; ++i) um |= SM[i];
    um = ((unsigned long long)__builtin_amdgcn_readfirstlane((unsigned)(um >> 32)) << 32) | (unsigned)__builtin_amdgcn_readfirstlane((unsigned)um);
    f32x4 o_win, o_sel;
    {
        AttnSt st; attn_init(st);
        const float* wb = cache_win + (size_t)b * 512 * 256 + 64 * g;
        samp_tile_f32<256, true>(st, qf, wb + (size_t)(64 * w) * 256, PAST - 512 + 64 * w, qpos, slope2[0], slope2[1], true, Vw, lane, c, q4, wout + (size_t)b * 512 * 256 + 64 * g, 64 * w);
        if (w == 0) samp_tile_new(st, qf, (const bf16*)(ws + WS_KW) + srow * 256 + 64 * g, ti, slope2[0], slope2[1], true, Vw, lane, c, q4);
        write_partial(st);
    }
    __syncthreads();
    o_win = combine();
    __syncthreads();
    {
        AttnSt st; attn_init(st);
        unsigned long long rem = um; int idx = 0;
        while (rem) { const int j = __builtin_ctzll(rem); rem &= rem - 1;
            if ((idx & 7) == w) {
                const bool bit = (mymask >> j) & 1ull;
                if (j < 32) { const int page = page_table[b * NPAGES + (j >> 1)];
                    samp_tile_f32<512, false>(st, qf, cache_kv + ((size_t)page * PAGE + (j & 1) * 64) * 512 + 256 + 64 * g, 64 * j, qpos, slope2[0], slope2[1], bit, Vw, lane, c, q4); }
                else samp_tile_new(st, qf, (const bf16*)(ws + WS_KS) + srow * 256 + 64 * g, ti, slope2[0], slope2[1], bit, Vw, lane, c, q4);
            }
            ++idx; }
        write_partial(st);
    }
    __syncthreads();
    o_sel = combine();
    {
        const int qt2 = frow >> 4, cc = frow & 15, head = 4 * g + 2 * qt2 + (cc >> 3); const size_t row = srow + (cc & 7);
        const float* GATES = (const float*)(ws + WS_GATES);
        const float g0 = GATES[row * 24 + head * 3], g1 = GATES[row * 24 + head * 3 + 1], g2 = GATES[row * 24 + head * 3 + 2];
        const f32x4 oa = o_cmp * g0 + o_sel * g1 + o_win * g2;
        float ss = (oa.x * oa.x + oa.y * oa.y) + (oa.z * oa.z + oa.w * oa.w);
        ss += __shfl_xor(ss, 1); ss += __shfl_xor(ss, 2); ss += __shfl_xor(ss, 4); ss += __shfl_xor(ss, 8);
        const float rs = 1.0f / sqrtf(ss * (1.f / 64.f) + EPS);
        const f32x4 v = oa * rs * *(const f32x4*)(attn_gain + 64 * head + 4 * fseg);
        u32x2 wv; wv.x = cvtpk(v.x, v.y); wv.y = cvtpk(v.z, v.w); *(u32x2*)((bf16*)(ws + WS_OA) + row * 1024 + 64 * head + 4 * fseg) = wv;
    }
    __syncthreads();
}

#define EPI_ROWS _Pragma("unroll") for (int ai = 0; ai < 2; ++ai) _Pragma("unroll") for (int m = 0; m < 4; ++m)
#define EPI_COLS _Pragma("unroll") for (int bj = 0; bj < 2; ++bj) _Pragma("unroll") for (int n = 0; n < 2; ++n)
struct EpiOut {
    unsigned char* ws; const float *xp, *xs;
    __device__ __forceinline__ void operator()(const f32x4 (&acc)[2][2][4][2], const pg8::Unit& u, int wr, int wc, int fr, int fq) const {
        const int rowb = u.pm * 256 + wr * 64 + fr, colb = u.pn * 256 + 32 * wc + 8 * fq;
        bf16* const HB = (bf16*)(ws + WS_XN); float* const ssq = (float*)(ws + CTL_SSQ);
        EPI_ROWS { const int row = rowb + 128 * ai + 16 * m; const float* xr = (row < MP) ? xp + (size_t)row * DM : xs + (size_t)(row - MP) * DM; float ss = 0.f;
#pragma unroll
            for (int bj = 0; bj < 2; ++bj) { const int col = colb + 128 * bj;
                const f32x4 h0 = acc[ai][bj][m][0] + __builtin_nontemporal_load((const f32x4*)(xr + col)), h1 = acc[ai][bj][m][1] + __builtin_nontemporal_load((const f32x4*)(xr + col + 4));
                ss += (h0.x * h0.x + h0.y * h0.y) + (h0.z * h0.z + h0.w * h0.w) + (h1.x * h1.x + h1.y * h1.y) + (h1.z * h1.z + h1.w * h1.w);
                u32x4 w; w.x = cvtpk(h0.x, h0.y); w.y = cvtpk(h0.z, h0.w); w.z = cvtpk(h1.x, h1.y); w.w = cvtpk(h1.z, h1.w); *(u32x4*)(HB + (size_t)row * DM + col) = w; }
            ss += __shfl_xor(ss, 16); ss += __shfl_xor(ss, 32);
            if (fq == 0) atomicAdd(ssq + row, ss); }
    }
};
struct EpiUp {
    unsigned char* ws;
    __device__ __forceinline__ void operator()(const f32x4 (&acc)[2][2][4][2], const pg8::Unit& u, int wr, int wc, int fr, int fq) const {
        const int rowb = u.pm * 256 + wr * 64 + fr, colb = u.pn * 256 + 32 * wc + 8 * fq;
        bf16* const U = (bf16*)(ws + WS_U);
        EPI_ROWS { const int row = rowb + 128 * ai + 16 * m;
#pragma unroll
            for (int bj = 0; bj < 2; ++bj) { f32x4 v0 = acc[ai][bj][m][0], v1 = acc[ai][bj][m][1];
                v0.x = fmaxf(v0.x, 0.f); v0.y = fmaxf(v0.y, 0.f); v0.z = fmaxf(v0.z, 0.f); v0.w = fmaxf(v0.w, 0.f); v0 = v0 * v0;
                v1.x = fmaxf(v1.x, 0.f); v1.y = fmaxf(v1.y, 0.f); v1.z = fmaxf(v1.z, 0.f); v1.w = fmaxf(v1.w, 0.f); v1 = v1 * v1;
                u32x4 w; w.x = cvtpk(v0.x, v0.y); w.y = cvtpk(v0.z, v0.w); w.z = cvtpk(v1.x, v1.y); w.w = cvtpk(v1.z, v1.w);
                *(u32x4*)(U + (size_t)row * DFF + colb + 128 * bj) = w; } }
    }
};
struct EpiDown {
    float* out; unsigned char* ws;
    __device__ __forceinline__ void operator()(const f32x4 (&acc)[2][2][4][2], const pg8::Unit& u, int wr, int wc, int fr, int fq) const {
        const int rowb = u.pm * 256 + wr * 64 + fr, colb = u.pn * 256 + 32 * wc + 8 * fq;
        const bf16* const HB = (const bf16*)(ws + WS_XN); const float* const ssq = (const float*)(ws + CTL_SSQ);
        EPI_ROWS { const int row = rowb + 128 * ai + 16 * m; const float rs2 = __builtin_amdgcn_rcpf(ssq[row] * (1.f / DM) + EPS);
#pragma unroll
            for (int bj = 0; bj < 2; ++bj) { const size_t o = (size_t)row * DM + colb + 128 * bj; const u32x4 hw = *(const u32x4*)(HB + o);
                const f32x4 h0 = (f32x4){__builtin_bit_cast(float, hw.x << 16), __builtin_bit_cast(float, hw.x & 0xffff0000u), __builtin_bit_cast(float, hw.y << 16), __builtin_bit_cast(float, hw.y & 0xffff0000u)};
                const f32x4 h1 = (f32x4){__builtin_bit_cast(float, hw.z << 16), __builtin_bit_cast(float, hw.z & 0xffff0000u), __builtin_bit_cast(float, hw.w << 16), __builtin_bit_cast(float, hw.w & 0xffff0000u)};
                __builtin_nontemporal_store(h0 + acc[ai][bj][m][0] * rs2, (f32x4*)(out + o)); __builtin_nontemporal_store(h1 + acc[ai][bj][m][1] * rs2, (f32x4*)(out + o + 4)); } }
    }
};
#undef EPI_ROWS
#undef EPI_COLS

template <int TN, int NH, int KS, class Epi>
__device__ __forceinline__ void small_gemm_tile(LAS unsigned char* lds, const bf16* A, int lda, const bf16* Bt, int ldb, int K, int row0, int col0, const Epi& E, int tid) {
    constexpr int WN = TN / NH / 16, PRS = (TN + 4) * 4;
    static_assert(NH * KS == 8 && KS * 64 * PRS <= LDS_CTLW, "small gemm geometry");
    const int lane = tid & 63, w = __builtin_amdgcn_readfirstlane(tid >> 6), nh = w % NH, ks = w / NH, fr = lane & 15, fq = lane >> 4;
    const int Kw = K / KS;
    const bf16* ap = A + (size_t)(row0 + fr) * lda + (size_t)ks * Kw + 8 * fq;
    const bf16* bp = Bt + (size_t)(col0 + 16 * WN * nh + fr) * ldb + (size_t)ks * Kw + 8 * fq;
    f32x4 acc[4][WN];
#pragma unroll
    for (int mt = 0; mt < 4; ++mt)
#pragma unroll
        for (int nt = 0; nt < WN; ++nt) acc[mt][nt] = (f32x4){0.f, 0.f, 0.f, 0.f};
    bf16x8 a0[2][4], b0[2][WN], a1[2][4], b1[2][WN];
#define SG_LOAD(A_, B_, kk) do { _Pragma("unroll") for (int u = 0; u < 2; ++u) { \
        _Pragma("unroll") for (int mt = 0; mt < 4; ++mt) A_[u][mt] = *(const bf16x8*)(ap + (size_t)(16 * mt) * lda + (kk) + 32 * u); \
        _Pragma("unroll") for (int nt = 0; nt < WN; ++nt) B_[u][nt] = *(const bf16x8*)(bp + (size_t)(16 * nt) * ldb + (kk) + 32 * u); } } while (0)
#define SG_MMA(A_, B_) do { _Pragma("unroll") for (int u = 0; u < 2; ++u) _Pragma("unroll") for (int mt = 0; mt < 4; ++mt) _Pragma("unroll") for (int nt = 0; nt < WN; ++nt) \
        acc[mt][nt] = mfma16(B_[u][nt], A_[u][mt], acc[mt][nt]); } while (0)
    SG_LOAD(a0, b0, 0);
    for (int k = 0; k < Kw; k += 128) {
        SG_LOAD(a1, b1, k + 64);
        SG_MMA(a0, b0);
        if (k + 128 < Kw) SG_LOAD(a0, b0, k + 128);
        SG_MMA(a1, b1);
    }
#undef SG_LOAD
#undef SG_MMA
    {
        LAS unsigned char* P = lds + ks * 64 * PRS + fr * PRS + (16 * WN * nh + 4 * fq) * 4;
#pragma unroll
        for (int mt = 0; mt < 4; ++mt)
#pragma unroll
            for (int nt = 0; nt < WN; ++nt) *(LAS f32x4*)(P + 16 * mt * PRS + 64 * nt) = acc[mt][nt];
    }
    __syncthreads();
    constexpr int C4 = TN / 4, ITEMS = 64 * C4;
#pragma unroll
    for (int rep = 0; rep < ITEMS / 512; ++rep) {
        const int id = rep * 512 + tid, r = id / C4, c4 = id % C4;
        f32x4 v = *(LAS const f32x4*)(lds + r * PRS + 16 * c4);
#pragma unroll
        for (int k2 = 1; k2 < KS; ++k2) v = v + *(LAS const f32x4*)(lds + k2 * 64 * PRS + r * PRS + 16 * c4);
        E.template run<C4>(v, row0 + r, col0 + 4 * c4);
    }
    __syncthreads();
}
struct SEpiOut {
    unsigned char* ws; const float* xs;
    template <int C4> __device__ __forceinline__ void run(const f32x4 v, int r, int cc) const {
        bf16* const HB = (bf16*)(ws + WS_XN); float* const ssq = (float*)(ws + CTL_SSQ);
        const int lc = (cc & ~31) + 8 * ((cc >> 2) & 3) + 4 * ((cc >> 4) & 1);
        const f32x4 h = v + *(const f32x4*)(xs + (size_t)(r - MP) * DM + lc);
        float ss = (h.x * h.x + h.y * h.y) + (h.z * h.z + h.w * h.w);
        u32x2 wv; wv.x = cvtpk(h.x, h.y); wv.y = cvtpk(h.z, h.w); *(u32x2*)(HB + (size_t)r * DM + lc) = wv;
#pragma unroll
        for (int o = 1; o < C4; o <<= 1) ss += __shfl_xor(ss, o);
        if ((threadIdx.x & (C4 - 1)) == 0) atomicAdd(ssq + r, ss);
    }
};
struct SEpiUp {
    unsigned char* ws;
    template <int C4> __device__ __forceinline__ void run(f32x4 v, int r, int cc) const {
        bf16* const U = (bf16*)(ws + WS_U);
        const int lc = (cc & ~31) + 8 * ((cc >> 2) & 3) + 4 * ((cc >> 4) & 1);
        v.x = fmaxf(v.x, 0.f); v.y = fmaxf(v.y, 0.f); v.z = fmaxf(v.z, 0.f); v.w = fmaxf(v.w, 0.f); v = v * v;
        u32x2 wv; wv.x = cvtpk(v.x, v.y); wv.y = cvtpk(v.z, v.w); *(u32x2*)(U + (size_t)r * DFF + lc) = wv;
    }
};
struct SEpiDown {
    float* out; unsigned char* ws;
    template <int C4> __device__ __forceinline__ void run(const f32x4 v, int r, int cc) const { const int lc = (cc & ~31) + 8 * ((cc >> 2) & 3) + 4 * ((cc >> 4) & 1); const size_t o = (size_t)r * DM + lc; const u32x2 hw = *(const u32x2*)((const bf16*)(ws + WS_XN) + o);
        const f32x4 h = (f32x4){__builtin_bit_cast(float, hw.x << 16), __builtin_bit_cast(float, hw.x & 0xffff0000u), __builtin_bit_cast(float, hw.y << 16), __builtin_bit_cast(float, hw.y & 0xffff0000u)};
        const float rs2 = __builtin_amdgcn_rcpf(((const float*)(ws + CTL_SSQ))[r] * (1.f / DM) + EPS);
        *(f32x4*)(out + o) = h + v * rs2; }
};

#ifdef MK_DEBUG
constexpr size_t CTL_DBG = 256 * 1024;
__device__ __forceinline__ void dbg_report(unsigned char* ws, float num, float den) { if (!(num >= 0.f)) num = 1e30f; atomicAdd((float*)(ws + CTL_DBG), num); atomicAdd((float*)(ws + CTL_DBG) + 1, den); }
__global__ void dbg_final(Args a) { const float n = *(const float*)(a.ws + CTL_DBG), d = *((const float*)(a.ws + CTL_DBG) + 1); a.out[O_RNNP] = 100.f + 1e7f * (n / (d + 1e-30f)); }
__global__ void __launch_bounds__(256) dbg_check_p1(Args a) {
    __shared__ float xs[1024]; __shared__ float z[3352]; __shared__ float red[256];
    const int nsamp = gridDim.x; const int tid = threadIdx.x;
    const int row = (int)(((long)blockIdx.x * 7919 * 131 + 37 * blockIdx.x) % MT);
    const float* x = row < MP ? a.in[0] + (size_t)row * DM : a.in[1] + (size_t)(row - MP) * DM;
    float ss = 0.f; for (int i = tid; i < 1024; i += 256) { const float v = x[i]; ss += v * v; }
    red[tid] = ss; __syncthreads(); for (int o = 128; o > 0; o >>= 1) { if (tid < o) red[tid] += red[tid + o]; __syncthreads(); }
    const float rs = 1.0f / sqrtf(red[0] / 1024.f + EPS);
    for (int i = tid; i < 1024; i += 256) xs[i] = x[i] * rs * a.in[6][i];
    __syncthreads();
    const float* w = a.in[7];
    for (int c = tid; c < 3352; c += 256) { float acc = 0.f; for (int k = 0; k < 1024; ++k) acc += xs[k] * w[(size_t)k * 3352 + c]; z[c] = acc; }
    __syncthreads();
    unsigned char* ws = a.ws; float num = 0.f, den = 0.f;
    auto cmp = [&](float got, float exp) { const float e = got - exp; num += e * e; den += exp * exp; };
    auto headrs = [&](int c0) { float s = 0.f; for (int d = 0; d < 64; ++d) s += z[c0 + d] * z[c0 + d]; return 1.0f / sqrtf(s / 64.f + EPS); };
    const float* kvout = row < MP ? a.out + O_KVP + (size_t)row * 512 : a.out + O_KVS + (size_t)(row - MP) * 512;
    const float* lbp = (const float*)(ws + WS_LB);
    for (int c = tid; c < 3352; c += 256) {
        if (c < 512) { const float r = headrs(c & ~63); cmp(bf2f(((const bf16*)(ws + WS_Q))[(size_t)row * 512 + c]), z[c] * r * a.in[8][c & 63]); }
        else if (c < 768) { cmp(kvout[c - 512], z[c]); if (row < MP) cmp(bf2f(((const bf16*)(ws + WS_KC))[(size_t)row * 256 + c - 512]), z[c] + a.in[10][((c - 512) >> 7) * 4096 + (row & 63) * 64 + (c & 63)]); }
        else if (c < 1024) { float e = z[c]; if (c < 896) e *= headrs(c & ~63) * a.in[9][64 + (c & 63)]; cmp(kvout[c - 512], e); cmp(bf2f(((const bf16*)(ws + WS_KS))[(size_t)row * 256 + c - 768]), e); }
        else if (c < 1280) { float e = z[c]; if (c < 1152) e *= headrs(c & ~63) * a.in[9][128 + (c & 63)]; cmp(bf2f(((const bf16*)(ws + WS_KW))[(size_t)row * 256 + c - 1024]), e);
            if (row >= MP) { const int r_ = row - MP; cmp(a.out[O_WINS + ((size_t)(r_ >> 3) * 512 + 504 + (r_ & 7)) * 256 + c - 1024], e); }
            else if ((row & 4095) >= 3584) cmp(a.out[O_WINP + ((size_t)(row >> 12) * 512 + (row & 4095) - 3584) * 256 + c - 1024], e); }
        else if (c < 1304) cmp(((const float*)(ws + WS_GATES))[(size_t)row * 24 + c - 1280], 1.f / (1.f + expf(-z[c])));
        else if (c < 1816) cmp(bf2f(((const bf16*)(ws + WS_RQ))[(size_t)row * 512 + c - 1304]), z[c] / (1.f + expf(-z[c])));
        else if (c < 2328) { const float l = lbp[c - 1816], f = l + (1.f - l) / (1.f + expf(-z[c])); cmp(((const float*)(ws + WS_GL))[(size_t)row * 512 + c - 1816], logf(f)); cmp(bf2f(((const bf16*)(ws + WS_RK))[(size_t)row * 512 + c - 1816]), 1.f - f); }
        else if (c < 2840) cmp(bf2f(((const bf16*)(ws + WS_RV))[(size_t)row * 512 + c - 2328]), z[c]);
        else cmp(bf2f(((const bf16*)(ws + WS_RG))[(size_t)row * 512 + c - 2840]), z[c] / (1.f + expf(-z[c])));
    }
    if (tid < 512 && blockIdx.x == 0) { const float l0 = a.in[14][tid], l1 = a.in[14][512 + tid]; const float e0 = expf(l0), e1 = expf(l1); cmp(lbp[tid], e0 / (e0 + e1)); if (tid + 256 < 512) { const float m0 = a.in[14][tid + 256], m1 = a.in[14][768 + tid]; cmp(lbp[tid + 256], expf(m0) / (expf(m0) + expf(m1))); } }
    (void)nsamp;
    red[tid] = num; __syncthreads(); for (int o = 128; o > 0; o >>= 1) { if (tid < o) red[tid] += red[tid + o]; __syncthreads(); } num = red[0]; __syncthreads();
    red[tid] = den; __syncthreads(); for (int o = 128; o > 0; o >>= 1) { if (tid < o) red[tid] += red[tid + o]; __syncthreads(); } den = red[0];
    if (tid == 0) dbg_report(ws, num, den);
}
__global__ void __launch_bounds__(256) dbg_check_cmp(Args a, int mode) {
    __shared__ float xin[4096]; __shared__ float hid[128]; __shared__ float outv[64]; __shared__ float red[256];
    const int tid = threadIdx.x; unsigned char* ws = a.ws;
    const int sidx = blockIdx.x; const int kind = sidx & 1, g = (sidx >> 1) & 1; int gb = (int)(((long)(sidx >> 2) * 977 + 13) % 4352);
    if (mode == 3) gb = gb % 256; if (mode == 4) gb = 256 + gb % 4096;
    if ((mode == 5 && kind != 0) || (mode == 6 && kind != 1)) return;
    const float* pe = a.in[10] + kind * 4096;
    for (int i = tid; i < 4096; i += 256) { const int p = i >> 6, d = i & 63; float v;
        if (gb < 256) { const int b = gb >> 6, blk = gb & 63; const int row = b * SEQ + 64 * blk + p; v = (a.out + O_KVP)[(size_t)row * 512 + kind * 128 + g * 64 + d]; }
        else { const int sb = (gb - 256) >> 5, blk = (gb - 256) & 31; const int page = ((const int*)a.in[5])[sb * NPAGES + (blk >> 1)]; v = a.in[2][((size_t)page * PAGE + (blk & 1) * 64 + p) * 512 + kind * 128 + g * 64 + d]; }
        xin[i] = v + pe[p * 64 + d]; }
    __syncthreads();
    if (tid < 128) { const float* w1 = a.in[11] + (size_t)kind * 4096 * 128; float acc = 0.f; for (int k = 0; k < 4096; ++k) acc += xin[k] * w1[(size_t)k * 128 + tid]; hid[tid] = acc / (1.f + expf(-acc)); }
    __syncthreads();
    if (tid < 64) { const float* w2 = a.in[12] + (size_t)kind * 128 * 64; float acc = 0.f; for (int k = 0; k < 128; ++k) acc += hid[k] * w2[k * 64 + tid]; outv[tid] = acc; }
    __syncthreads();
    float num = 0.f, den = 0.f;
    if (tid < 64) { float e = outv[tid];
        if (kind == 0) { float ss = 0.f; for (int d = 0; d < 64; ++d) ss += outv[d] * outv[d]; e = e / sqrtf(ss / 64.f + EPS) * a.in[9][tid]; }
        const float got = ((const float*)(ws + (kind == 0 ? WS_KCMP : WS_VCMP)))[((size_t)gb * 2 + g) * 64 + tid];
        num = (got - e) * (got - e); den = e * e; }
    red[tid] = num; __syncthreads(); for (int o = 128; o > 0; o >>= 1) { if (tid < o) red[tid] += red[tid + o]; __syncthreads(); } num = red[0]; __syncthreads();
    red[tid] = den; __syncthreads(); for (int o = 128; o > 0; o >>= 1) { if (tid < o) red[tid] += red[tid + o]; __syncthreads(); } den = red[0];
    if (tid == 0) dbg_report(ws, num, den);
}
#endif


constexpr int NPHASE = 7;
__global__ void __launch_bounds__(512, 2) mega(Args args) {
    extern __shared__ __attribute__((aligned(16))) unsigned char lds_raw[];
    LAS unsigned char* lds = (LAS unsigned char*)lds_raw;
    const int tid = threadIdx.x, lane = tid & 63, wave = __builtin_amdgcn_readfirstlane(tid >> 6);
    const int G = gridDim.x, bx = blockIdx.x;
    unsigned char* ws = args.ws;
    const int lo = args.ph_lo, hi = args.ph_hi;
#define IN(k) (lo <= (k) && (k) < hi)
#define GRID_BAR_CG() do { cg::this_grid().sync(); } while (0)
#define GRID_BAR() do { xcd_barrier(xbar); } while (0)
    if (tid < 16) ((LAS unsigned*)(lds + LDS_CTLW))[tid] = 0u;
    __syncthreads();
    if (tid == 0) { const unsigned xcc_ = xb_xcc_id(); LAS unsigned* lw_ = (LAS unsigned*)(lds + LDS_CTLW);
        lw_[4] = xcc_; lw_[5] = __hip_atomic_fetch_add((unsigned*)(ws + WS_CTL + CTL_XCEN) + 64 * xcc_, 1u, __ATOMIC_RELAXED, __HIP_MEMORY_SCOPE_AGENT); }
    XcdBarrier xbar; xbar.bar = (unsigned*)(ws + WS_CTL + CTL_BAR); xbar.x = 0; xbar.st = (volatile LAS unsigned*)(lds + LDS_CTLW);
    if (hi - lo > 1) xbar = xcd_barrier_post((unsigned*)(ws + WS_CTL + CTL_BAR), (volatile LAS unsigned*)(lds + LDS_CTLW));

#define STAMP(k) do { if (PROBE_A >= 0 && tid == 0) ((LAS unsigned long long*)(lds + LDS_STAMPS))[k] = __builtin_amdgcn_s_memrealtime(); } while (0)
    STAMP(0);
    if (IN(0)) {
        LAS float* scr = (LAS float*)(lds + wave * 16384);
        const int gw = bx * 8 + wave, NGW = G * 8;
        const float* w_in = args.in[7];
        const float* cw1 = args.in[11]; const float* cw2 = args.in[12];
        const float* xp = args.in[0]; const float* xs = args.in[1]; const float* ln_mix = args.in[6];
        {
#define P0_ROWP(m_) ((const f32x4*)((m_) < MP ? xp + (size_t)(m_) * DM : xs + (size_t)((m_) - MP) * DM) + lane)
#define P0_LOAD(A0, A1, m_) do { const int ma_ = (m_), mb_ = ma_ + NGW < MT ? ma_ + NGW : ma_; const f32x4* x0_ = P0_ROWP(ma_); const f32x4* x1_ = P0_ROWP(mb_); \
            _Pragma("unroll") for (int j = 0; j < 4; ++j) { A0[j] = __builtin_nontemporal_load(x0_ + 64 * j); A1[j] = __builtin_nontemporal_load(x1_ + 64 * j); } } while (0)
            const f32x4* gr = (const f32x4*)ln_mix + lane;
            f32x4 v0[4], v1[4], n0[4], n1[4];
            P0_LOAD(v0, v1, gw);
            for (int m = gw; m < MT; m += 2 * NGW) {
                const int m2 = m + NGW;
                if (m + 2 * NGW < MT) P0_LOAD(n0, n1, m + 2 * NGW);
                float s0 = 0.f, s1 = 0.f;
#pragma unroll
                for (int j = 0; j < 4; ++j) { s0 += (v0[j].x * v0[j].x + v0[j].y * v0[j].y) + (v0[j].z * v0[j].z + v0[j].w * v0[j].w); s1 += (v1[j].x * v1[j].x + v1[j].y * v1[j].y) + (v1[j].z * v1[j].z + v1[j].w * v1[j].w); }
                const float r0 = 1.0f / sqrtf(wave_sum(s0) * (1.f / DM) + EPS), r1 = 1.0f / sqrtf(wave_sum(s1) * (1.f / DM) + EPS);
                u32x2* o0 = (u32x2*)((bf16*)(ws + WS_XN) + (size_t)m * DM) + lane; u32x2* o1 = (u32x2*)((bf16*)(ws + WS_XN) + (size_t)m2 * DM) + lane;
#pragma unroll
                for (int j = 0; j < 4; ++j) { const f32x4 g = gr[64 * j]; u32x2 w0, w1; w0.x = cvtpk(v0[j].x * r0 * g.x, v0[j].y * r0 * g.y); w0.y = cvtpk(v0[j].z * r0 * g.z, v0[j].w * r0 * g.w);
                    w1.x = cvtpk(v1[j].x * r1 * g.x, v1[j].y * r1 * g.y); w1.y = cvtpk(v1[j].z * r1 * g.z, v1[j].w * r1 * g.w); o0[64 * j] = w0; if (m2 < MT) o1[64 * j] = w1; }
#pragma unroll
                for (int j = 0; j < 4; ++j) { v0[j] = n0[j]; v1[j] = n1[j]; }
            }
#undef P0_LOAD
#undef P0_ROWP
        }
        STAMP(25);
        constexpr int I_IN = 16 * 105, I_1 = 64 * 4, I_2 = 2 * 2;
        constexpr int NITEMS = I_IN + 2 * I_1 + 2 * I_2;
        for (int it = gw; it < NITEMS; it += NGW) {
            int r = it;
            if (r < I_IN) { p0_transpose_item<1>(w_in, DM, INW, (bf16*)(ws + WS_WIN), scr, r, lane); continue; } r -= I_IN;
            if (r < 2 * I_1) { const int kv = r / I_1; p0_transpose_item<0>(cw1 + (size_t)kv * 4096 * 128, 4096, 128, (bf16*)(ws + WS_W1) + (size_t)kv * 128 * 4096, scr, r % I_1, lane); continue; } r -= 2 * I_1;
            { const int kv = r / I_2; p0_transpose_item<0>(cw2 + (size_t)kv * 128 * 64, 128, 64, (bf16*)(ws + WS_W2) + (size_t)kv * 64 * 128, scr, r % I_2, lane); }
        }
        STAMP(26);
        if (bx == 0) { const float* lg = args.in[14]; float* lbp = (float*)(ws + WS_LB); const float l0 = lg[tid], l1 = lg[512 + tid]; lbp[tid] = 1.0f / (1.0f + __expf(l1 - l0)); }
        if (hi > 1) GRID_BAR();
        if (tid == 0) { bool ok_ = (G % 8) == 0; LAS unsigned* lw_ = (LAS unsigned*)(lds + LDS_CTLW);
            for (int j = 0; j < 8; ++j) ok_ = ok_ && (__hip_atomic_load((unsigned*)(ws + WS_CTL + CTL_XCEN) + 64 * j, __ATOMIC_RELAXED, __HIP_MEMORY_SCOPE_AGENT) == (unsigned)(G / 8));
            lw_[6] = (ok_ && lw_[4] < 8u) ? (lw_[4] + 8u * lw_[5]) : (unsigned)bx; }
        __syncthreads();
        STAMP(1);
    }
    if (IN(1)) {
        pg8::Gemm g{(const bf16*)(ws + WS_XN), (const bf16*)(ws + WS_WIN), MT, INP, DM};
        const int vcu = (hi - lo > 1) ? (int)__builtin_amdgcn_readfirstlane(((LAS unsigned*)(lds + LDS_CTLW))[6]) : bx;
        pg8::StaticOrder S; S.init(MT, INP, G, vcu);
        EpiIn E{args.out, ws, args.in[8], args.in[9], args.in[10]};
#define WCV_QUEUE(MAXN) do { constexpr int N_WCV = (16 * 32 + 16 * 128 + 64 * 32) / 8, I_O = 16 * 32, I_U = 16 * 128; \
            unsigned* qc = (unsigned*)(ws + WS_CTL + CTL_Q) + 128; LAS int* qslot = (LAS int*)(lds + LDS_CTLW + 32); \
            for (int n_ = 0; n_ < (MAXN); ++n_) { \
                if (tid == 0) *qslot = (int)atomicAdd(qc, 1u); \
                __syncthreads(); \
                const int it = __builtin_amdgcn_readfirstlane(*qslot); \
                __syncthreads(); \
                if (it >= N_WCV) break; \
                int t_ = tid; asm volatile("" : "+v"(t_)); \
                const int r = it * 8 + __builtin_amdgcn_readfirstlane(t_ >> 6); \
                LAS float* scr = (LAS float*)(lds + __builtin_amdgcn_readfirstlane(t_ >> 6) * 16384); \
                if (r < I_O) p0_transpose_item<3>(args.in[16], DM, DM, (bf16*)(ws + WS_WO), scr, r, t_ & 63); \
                else if (r < I_O + I_U) p0_transpose_item<3>(args.in[18], DM, DFF, (bf16*)(ws + WS_WU), scr, r - I_O, t_ & 63, args.in[17]);     \
                else p0_transpose_item<3>(args.in[19], DFF, DM, (bf16*)(ws + WS_WD), scr, r - I_O - I_U, t_ & 63); \
            } \
            __syncthreads();     \
            } while (0)
        {   const int nwg = (MT / 256) * (INP / 256), rounds = (nwg + G - 1) / G;
            if ((long)(rounds - 1) * G + vcu >= nwg) WCV_QUEUE(6); }
        pg8::gemm_phase<EpiIn, true>(lds, g, S, E);
        WCV_QUEUE(1 << 30);
#undef WCV_QUEUE
        if (hi > 2) GRID_BAR();
        STAMP(2);
    }
    if (IN(2)) {
        constexpr int N_CMP = N_CMP_ITEMS, N_HG = 256, N_WIN = 512, N_RNN = 0, N_CPY = 0, N2 = N_CMP + N_HG + N_WIN + N_RNN + N_CPY;
        unsigned* qc = (unsigned*)(ws + WS_CTL + CTL_Q); LAS int* qslot = (LAS int*)(lds + LDS_CTLW + 32);
        if (bx == PROBE_BLK) { STAMP(14); STAMP(8); STAMP(9); STAMP(10); STAMP(11); STAMP(12); STAMP(13); }
        for (int rep = 0; rep < REP_P2; ++rep)
        for (int seq = 0;; ++seq) {
            if (tid == 0) *qslot = (int)atomicAdd(qc, 1u);
            __syncthreads();
            const int it = __builtin_amdgcn_readfirstlane(*qslot) - rep * (N2 + (int)G);
            __syncthreads();
            if (it >= N2) break;
            if (bx == PROBE_BLK) STAMP(8 + (seq < 5 ? seq : 5));
            int t_ = tid; asm volatile("" : "+v"(t_));
            constexpr int N_HEAVY = N_CMP + N_HG;
            if (it < 2 * N_HEAVY && !(it & 1)) { const int j = it >> 1; if (j < N_CMP) compress_item(lds, ws, args.in[2], (const int*)args.in[5], args.in[10], args.in[9], j, t_); else hgrn_local_item(lds, ws, j - N_CMP, t_); }
            else if (it < 2 * N_HEAVY) win_prompt_unit(lds, ws, it >> 1, t_);
            else if (it < N_CMP + N_HG + N_WIN) win_prompt_unit(lds, ws, it - N_HEAVY, t_);
            else if (it < N_CMP + N_HG + N_WIN + N_RNN) rnn_sample_wave(ws, args.out, args.in[4], args.in[15], (it - N_CMP - N_HG - N_WIN) * 8 + __builtin_amdgcn_readfirstlane(t_ >> 6), t_ & 63);
            else {
                const int ci_ = it - (N_CMP + N_HG + N_WIN + N_RNN), b = ci_ >> 3, e = ci_ & 7;
                const f32x4* src = (const f32x4*)args.in[3] + (size_t)b * (512 * 64) + 8 * 64; f32x4* dst = (f32x4*)(args.out + O_WINS) + (size_t)b * (512 * 64);
                f32x4 v[8];
#pragma unroll
                for (int j = 0; j < 8; ++j) { const int ch = e + 8 * j; if (ch < 63) v[j] = src[ch * 512 + t_]; }
#pragma unroll
                for (int j = 0; j < 8; ++j) { const int ch = e + 8 * j; if (ch < 63) dst[ch * 512 + t_] = v[j]; }
            }
        }
        if (bx == PROBE_BLK) STAMP(15);
        if (hi > 3) GRID_BAR();
        STAMP(3);
    }
    if (IN(3)) {
        constexpr int N_SEL1 = 256, N_SA = 256, N_RNN = 128, N_SEL0 = 256, N_HC = 512, Q_RNN = N_SEL1 + N_SA, Q_SEL0 = Q_RNN + N_RNN, Q_HC = Q_SEL0 + N_SEL0, N3 = Q_HC + N_HC;
        unsigned* qc = (unsigned*)(ws + WS_CTL + CTL_Q) + 64; LAS int* qslot = (LAS int*)(lds + LDS_CTLW + 32);
        if (bx == PROBE_BLK) { STAMP(22); STAMP(16); STAMP(17); STAMP(18); STAMP(19); STAMP(20); STAMP(21); }
        for (int rep = 0; rep < REP_P3; ++rep)
        for (int seq = 0;; ++seq) {
            if (tid == 0) *qslot = (int)atomicAdd(qc, 1u);
            __syncthreads();
            const int it = __builtin_amdgcn_readfirstlane(*qslot) - rep * (N3 + (int)G);
            __syncthreads();
            if (it >= N3) break;
            if (bx == PROBE_BLK) STAMP(16 + (seq < 5 ? seq : 5));
            int t_ = tid; asm volatile("" : "+v"(t_));
            if (it < Q_RNN && !(it & 1)) { const int j = it >> 1; sel_prompt_unit(lds, ws, args.in[13], ((j & 3) << 7) | (1 << 6) | (63 - (j >> 2)), t_); }
            else if (it < Q_RNN) samp_attn_unit(lds, ws, args.in[2], args.in[3], (const int*)args.in[5], args.in[13], args.out + O_WINS, it >> 1, t_);
            else if (it < Q_SEL0) rnn_sample_wave(ws, args.out, args.in[4], args.in[15], (it - Q_RNN) * 8 + __builtin_amdgcn_readfirstlane(t_ >> 6), t_ & 63);
            else if (it < Q_HC) { const int j = it - Q_SEL0; sel_prompt_unit(lds, ws, args.in[13], ((j & 3) << 7) | (63 - (j >> 2)), t_); }
            else hgrn_combine_unit(lds, ws, args.out, args.in[15], it - Q_HC, t_);
        }
        if (bx == PROBE_BLK) STAMP(23);
        if (hi > 4) GRID_BAR();
        STAMP(4);
    }
    if (IN(4)) {
        pg8::Gemm g{(const bf16*)(ws + WS_OA), (const bf16*)(ws + WS_WO), MP, DM, DM};
        const int vcu = (hi - lo > 1) ? (int)__builtin_amdgcn_readfirstlane(((LAS unsigned*)(lds + LDS_CTLW))[6]) : bx;
        pg8::StaticOrder S; S.init(MP, DM, G, vcu);
        EpiOut E{ws, args.in[0], args.in[1]};
#define SMALL_TILES() do { SEpiOut SE{ws, args.in[1]};   \
            for (int t = bx; t < 256; t += G) small_gemm_tile<64, 1, 8, SEpiOut>(lds, (const bf16*)(ws + WS_OA), DM, (const bf16*)(ws + WS_WO), DM, DM, MP + 64 * (t >> 4), 64 * (t & 15), SE, tid); } while (0)
        if (bx & 1) SMALL_TILES();
        pg8::gemm_phase<EpiOut, true>(lds, g, S, E);
        if (!(bx & 1)) SMALL_TILES();
#undef SMALL_TILES
        if (hi > 5) GRID_BAR();
        STAMP(5);
    }
    if (IN(5)) {
        pg8::Gemm g{(const bf16*)(ws + WS_XN), (const bf16*)(ws + WS_WU), MP, DFF, DM};
        const int vcu = (hi - lo > 1) ? (int)__builtin_amdgcn_readfirstlane(((LAS unsigned*)(lds + LDS_CTLW))[6]) : bx;
        pg8::StaticOrder S; S.init(MP, DFF, G, vcu);
        EpiUp E{ws};
#define SMALL_TILES() do { SEpiUp SE{ws};   \
            for (int t = bx; t < 256; t += G) small_gemm_tile<256, 4, 2, SEpiUp>(lds, (const bf16*)(ws + WS_XN), DM, (const bf16*)(ws + WS_WU), DM, DM, MP + 64 * (t >> 4), 256 * (t & 15), SE, tid); } while (0)
        if (bx & 1) SMALL_TILES();
        pg8::gemm_phase<EpiUp, true>(lds, g, S, E);
        if (!(bx & 1)) SMALL_TILES();
#undef SMALL_TILES
        if (hi > 6) GRID_BAR();
        STAMP(6);
    }
    if (IN(6)) {
        pg8::Gemm g{(const bf16*)(ws + WS_U), (const bf16*)(ws + WS_WD), MP, DM, DFF};
        const int vcu = (hi - lo > 1) ? (int)__builtin_amdgcn_readfirstlane(((LAS unsigned*)(lds + LDS_CTLW))[6]) : bx;
        pg8::StaticOrder S; S.init(MP, DM, G, vcu);
        EpiDown E{args.out, ws};
#define SMALL_TILES() do { SEpiDown SE{args.out, ws};   \
            for (int t = bx; t < 256; t += G) small_gemm_tile<64, 1, 8, SEpiDown>(lds, (const bf16*)(ws + WS_U), DFF, (const bf16*)(ws + WS_WD), DFF, DFF, MP + 64 * (t >> 4), 64 * (t & 15), SE, tid); } while (0)
        if (bx & 1) SMALL_TILES();
        pg8::gemm_phase<EpiDown, true>(lds, g, S, E);
        if (!(bx & 1)) SMALL_TILES();
#undef SMALL_TILES
    }
    if (PROBE_A >= 0) {
        asm volatile("s_waitcnt vmcnt(0)" ::: "memory");
        const unsigned long long tend = __builtin_amdgcn_s_memrealtime();
        if ((bx == PROBE_BLK || PROBE_A < 8) && tid == 0) {
            const int pa = PROBE_A, pb = PROBE_B; LAS unsigned long long* stamp_ = (LAS unsigned long long*)(lds + LDS_STAMPS); stamp_[7] = tend;
            unsigned long long ta = (pa == 24) ? (tend - stamp_[0]) : (stamp_[PROBE_E >= 0 ? PROBE_E : pa + 1] - stamp_[pa]); if (ta > 100000000ull) ta = 0ull;
            const unsigned long long tb = pb >= 0 ? (stamp_[pb + 1] - stamp_[pb]) : 0ull;
            const unsigned long long extra = ta + 100000ull * ((tb + 400ull) / 800ull);
            while (__builtin_amdgcn_s_memrealtime() - tend < extra) __builtin_amdgcn_s_sleep(16);
        }
    }
#undef IN
#undef GRID_BAR
#undef GRID_BAR_CG
}

extern "C" void kernel_launch(void* const* d_in, const int* in_sizes, int n_in, void* d_out, int out_size, void* d_ws, size_t ws_size, hipStream_t stream) {
    static int grid = 0;
    if (grid == 0) {
        int dev = 0, cus = 0, per_cu = 0;
        (void)hipGetDevice(&dev);
        (void)hipDeviceGetAttribute(&cus, hipDeviceAttributeMultiprocessorCount, dev);
        (void)hipFuncSetAttribute((const void*)mega, hipFuncAttributeMaxDynamicSharedMemorySize, LDS_BYTES);
        (void)hipOccupancyMaxActiveBlocksPerMultiprocessor(&per_cu, (const void*)mega, 512, LDS_BYTES);
        if (per_cu < 1) per_cu = 1;
        grid = cus * 1;
        if (n_in != 20 || (size_t)out_size != O_END) fprintf(stderr, "kernel_launch: unexpected shapes n_in %d out %d\n", n_in, out_size);
        (void)hipGetLastError();
    }
    (void)hipMemsetAsync((char*)d_ws + WS_CTL, 0, CTL_BYTES, stream);
    Args a{};
    for (int i = 0; i < 20; ++i) a.in[i] = (const float*)d_in[i];
    a.out = (float*)d_out; a.ws = (unsigned char*)d_ws;
#if MK_N_LAUNCHES == 1
    a.ph_lo = 0; a.ph_hi = NPHASE;
    void* kargs[] = {&a};
    hipError_t e = hipLaunchCooperativeKernel((const void*)mega, dim3(grid), dim3(512), kargs, LDS_BYTES, stream);
    if (e != hipSuccess) fprintf(stderr, "cooperative launch failed: %s (grid %d)\n", hipGetErrorString(e), grid);
#ifdef MK_DEBUG
    if (MK_DEBUG == 1) hipLaunchKernelGGL(dbg_check_p1, dim3(192), dim3(256), 0, stream, a);
    if (MK_DEBUG >= 2) hipLaunchKernelGGL(dbg_check_cmp, dim3(1024), dim3(256), 0, stream, a, (int)MK_DEBUG);
    hipLaunchKernelGGL(dbg_final, dim3(1), dim3(1), 0, stream, a);
#endif
#else
    for (int p = 0; p < NPHASE; ++p) { a.ph_lo = p; a.ph_hi = p + 1; hipLaunchKernelGGL(mega, dim3(grid), dim3(512), LDS_BYTES, stream, a);
#ifdef MK_DEBUG
        if (p == 1 && MK_DEBUG == 1) hipLaunchKernelGGL(dbg_check_p1, dim3(192), dim3(256), 0, stream, a);
#endif
    }
#ifdef MK_DEBUG
    hipLaunchKernelGGL(dbg_final, dim3(1), dim3(1), 0, stream, a);
#endif
#endif
}
```

```cpp
#include <hip/hip_runtime.h>
#include <hip/hip_cooperative_groups.h>
#include <cstdio>
#include <cstdint>
namespace cg = cooperative_groups;

#ifndef PROBE_A
#define PROBE_A -1
#define PROBE_B -1
#define PROBE_BLK 0
#define PROBE_E -1
#endif
#ifndef REP_P2
#define REP_P2 1
#endif
#ifndef REP_P3
#define REP_P3 1
#endif
#ifndef MK_N_LAUNCHES
#define MK_N_LAUNCHES 1
#endif

#define LAS __attribute__((address_space(3)))
typedef unsigned short bf16;
typedef short bf16x8 __attribute__((ext_vector_type(8)));
typedef short bf16x4 __attribute__((ext_vector_type(4)));
typedef float f32x4 __attribute__((ext_vector_type(4)));
typedef float f32x2 __attribute__((ext_vector_type(2)));
typedef unsigned u32x4 __attribute__((ext_vector_type(4)));
typedef unsigned u32x2 __attribute__((ext_vector_type(2)));
typedef __bf16 bf16x2_t __attribute__((ext_vector_type(2)));

constexpr int DM = 1024, BATCH = 4, SEQ = 4096, DECB = 128, DECT = 8, PAST = 2048, PAGE = 128;
constexpr int NPAGES = PAST / PAGE;
constexpr int MP = BATCH * SEQ;
constexpr int MS = DECB * DECT;
constexpr int MT = MP + MS;
constexpr int INW = 3352, INP = 3584;
constexpr int DFF = 4096;
constexpr float EPS = 1e-6f;

constexpr size_t O_YP = 0, O_YS = (size_t)MP * DM, O_KVP = O_YS + (size_t)MS * DM, O_KVS = O_KVP + (size_t)MP * 512,
                 O_WINP = O_KVS + (size_t)MS * 512, O_WINS = O_WINP + (size_t)BATCH * 512 * 256, O_RNNP = O_WINS + (size_t)DECB * 512 * 256,
                 O_RNNS = O_RNNP + (size_t)BATCH * 8 * 4096, O_END = O_RNNS + (size_t)DECB * 8 * 4096;

constexpr size_t MiB = 1u << 20;
constexpr size_t WS_CTL = 0, CTL_BYTES = 1 * MiB;
constexpr size_t CTL_SSQ = 512 * 1024;
constexpr size_t WS_WIN = 1 * MiB;
constexpr size_t WS_WO = WS_WIN + 7 * MiB;
constexpr size_t WS_WU = WS_WO + 2 * MiB;
constexpr size_t WS_WD = WS_WU + 8 * MiB;
constexpr size_t WS_W1 = WS_WD + 8 * MiB;
constexpr size_t WS_W2 = WS_W1 + 2 * MiB;
constexpr size_t WS_LB = WS_W2 + 64 * 1024;
constexpr size_t WS_XN = 32 * MiB;
constexpr size_t WS_Q = 68 * MiB;
constexpr size_t WS_KC = 86 * MiB;
constexpr size_t WS_KS = 95 * MiB;
constexpr size_t WS_KW = 104 * MiB;
constexpr size_t WS_RQ = 113 * MiB, WS_RK = 131 * MiB, WS_RV = 149 * MiB, WS_RG = 167 * MiB;   static_assert(WS_RV - WS_RK == WS_RK - WS_RQ && WS_RG - WS_RV == WS_RK - WS_RQ, "equal spacing");
constexpr size_t WS_GL = 185 * MiB;
constexpr size_t WS_GATES = 220 * MiB;
constexpr size_t WS_OWIN = 224 * MiB;
constexpr size_t WS_OA = 242 * MiB;
constexpr size_t WS_U = 280 * MiB;
constexpr size_t WS_KCMP = 420 * MiB;
constexpr size_t WS_VCMP = 424 * MiB;
constexpr size_t WS_OLOC = 428 * MiB;
constexpr size_t WS_QH = 462 * MiB;
constexpr size_t WS_TSC = 480 * MiB;
constexpr size_t WS_DSC = 489 * MiB;
constexpr size_t WS_END1 = 490 * MiB;

constexpr int RING_BYTES = 131072;
constexpr int LDS_BYTES = 147456;
constexpr int LDS_CTLW = LDS_BYTES - 320; constexpr int LDS_STAMPS = LDS_BYTES - 256;

__device__ __forceinline__ unsigned cvtpk(float lo, float hi) { f32x2 v = {lo, hi}; bf16x2_t b = __builtin_convertvector(v, bf16x2_t); return __builtin_bit_cast(unsigned, b); }
__device__ __forceinline__ float bf2f(unsigned short b) { return __builtin_bit_cast(float, ((unsigned)b) << 16); }
__device__ __forceinline__ float wave_sum(float v) {
#pragma unroll
    for (int o = 1; o < 64; o <<= 1) v += __shfl_xor(v, o);
    return v;
}
__device__ __forceinline__ float sigmoidf_(float x) { return __builtin_amdgcn_rcpf(1.0f + __expf(-x)); }
__device__ __forceinline__ float siluf_(float x) { return x * __builtin_amdgcn_rcpf(1.0f + __expf(-x)); }
#define LDS_WAIT() asm volatile("s_waitcnt lgkmcnt(0)" ::: "memory")

namespace pg8 {
constexpr int BM = 256, BK = 64, HALF = 128, HTB = HALF * BK * 2, STAGE_BYTES = 8 * HTB, NXCD = 8, WGM = 8;
__host__ __device__ __forceinline__ int lds_byte(int r, int c) { const int st = (r >> 4) * 2 + (c >> 5), rr = r & 15, cc = c & 31, ob = rr * 64 + cc * 2; return st * 1024 + (ob ^ (((ob >> 9) & 1) << 5)); }
__host__ __device__ __forceinline__ void stage_rc(int b, int& R, int& C) { const int st = b / 1024, sb = b % 1024, swz = sb ^ (((sb >> 9) & 1) << 5); R = (st >> 1) * 16 + swz / 64; C = (st & 1) * 32 + (swz % 64) / 2; }
struct Unit { int pm, pn; };
struct Gemm { const bf16* A; const bf16* Bt; int M, N, K; };
struct StaticOrder {
    int nM, nN, nwg, G, c;
    __host__ __device__ void init(int M, int N, int G_, int c_) { nM = M / BM; nN = N / BM; nwg = nM * nN; G = G_; c = c_; }
    __host__ __device__ bool next(int i, Unit& u) const {
        const long L = (long)i * G + c; if (L >= nwg) return false;
        int wgid = (int)L; { const int q = nwg / NXCD, r = nwg % NXCD, xcd = wgid % NXCD, off = wgid / NXCD; wgid = (xcd < r ? xcd * (q + 1) : r * (q + 1) + (xcd - r) * q) + off; }
        const int nig = WGM * nN, gid = wgid / nig, fm = gid * WGM, gsz = (nM - fm) < WGM ? (nM - fm) : WGM;
        u.pm = fm + ((wgid % nig) % gsz); u.pn = (wgid % nig) / gsz; return true;
    }
};
template <class Epi, bool ALIGN_EPI = true>
__device__ __forceinline__ void gemm_phase(LAS unsigned char* lds, const Gemm g, const StaticOrder& S, const Epi& E) {
    const int tid = threadIdx.x, wid = __builtin_amdgcn_readfirstlane(tid >> 6), lane = tid & 63, wr = wid >> 2, wc = wid & 3, fr = lane & 15, fq = lane >> 4;
    const int K = g.K, nt = K / BK;
    unsigned voffA[2], voffB[2];
#pragma unroll
    for (int i = 0; i < 2; ++i) { int R, C; stage_rc(tid * 16 + i * 8192, R, C); voffA[i] = (unsigned)(R * K + C) * 2u; voffB[i] = voffA[i]; }
    const size_t kstep = (size_t)(BK * 2);
    const size_t hstep = (size_t)HALF * K * 2;
    const size_t tstep = 2 * hstep;
    const unsigned ldsw = (unsigned)wid * 1024u;
    const int aoff = lds_byte(wr * 64 + fr, fq * 8), boff = lds_byte(wc * 32 + fr, fq * 8);
#define PG8_SA(b, h) (((b) * 2 + (h)) * HTB)
#define PG8_SB(b, h) ((4 + (b) * 2 + (h)) * HTB)
#define PG8_STAGE(bufoff, gbase, voff) do { _Pragma("unroll") for (int _i = 0; _i < 2; ++_i) \
        __builtin_amdgcn_global_load_lds((const unsigned*)((const char*)(gbase) + (voff)[_i]), (LAS unsigned*)(lds + (bufoff) + ldsw + _i * 8192), 16, 0, 0); } while (0)
#define PG8_LDA(dst, b, h) do { _Pragma("unroll") for (int m = 0; m < 4; ++m) _Pragma("unroll") for (int k = 0; k < 2; ++k) dst[m][k] = *(const LAS bf16x8*)(lds + PG8_SA(b, h) + aoff + m * 2048 + k * 1024); } while (0)
#define PG8_LDB(dst, b, h) do { _Pragma("unroll") for (int n = 0; n < 2; ++n) _Pragma("unroll") for (int k = 0; k < 2; ++k) dst[n][k] = *(const LAS bf16x8*)(lds + PG8_SB(b, h) + boff + n * 2048 + k * 1024); } while (0)
#define PG8_MMA(ai, bj, At, Bt) do { __builtin_amdgcn_s_setprio(1); _Pragma("unroll") for (int m = 0; m < 4; ++m) _Pragma("unroll") for (int n = 0; n < 2; ++n) _Pragma("unroll") for (int k = 0; k < 2; ++k) \
        acc[ai][bj][m][n] = __builtin_amdgcn_mfma_f32_16x16x32_bf16(Bt[n][k], At[m][k], acc[ai][bj][m][n], 0, 0, 0); __builtin_amdgcn_s_setprio(0); } while (0)
#define PG8_WAIT_V(n) asm volatile("s_waitcnt vmcnt(" #n ")" ::: "memory")
#define PG8_WAIT_L(n) asm volatile("s_waitcnt lgkmcnt(" #n ")" ::: "memory")
#define PG8_BAR __builtin_amdgcn_s_barrier()
#define PG8_SCHED __builtin_amdgcn_sched_barrier(0)
    Unit cur, nxt; int ui = 0;
    if (!S.next(0, cur)) return;
    f32x4 acc[2][2][4][2];
#pragma unroll
    for (int a = 0; a < 2; ++a)
#pragma unroll
        for (int b = 0; b < 2; ++b)
#pragma unroll
            for (int m = 0; m < 4; ++m)
#pragma unroll
                for (int n = 0; n < 2; ++n) acc[a][b][m][n] = (f32x4){0.f, 0.f, 0.f, 0.f};
    bf16x8 At[4][2], B0[2][2], B1[2][2];
    const char* cA = (const char*)g.A + (size_t)cur.pm * tstep; const char* cB = (const char*)g.Bt + (size_t)cur.pn * tstep;
    PG8_STAGE(PG8_SB(0, 0), cB, voffB); PG8_STAGE(PG8_SB(0, 1), cB + hstep, voffB); PG8_STAGE(PG8_SA(0, 0), cA, voffA); PG8_STAGE(PG8_SA(0, 1), cA + hstep, voffA);
    if (wr == 1) PG8_BAR;
    PG8_WAIT_V(2); PG8_BAR;
    PG8_STAGE(PG8_SB(1, 0), cB + kstep, voffB); PG8_STAGE(PG8_SA(1, 0), cA + kstep, voffA); PG8_STAGE(PG8_SB(1, 1), cB + hstep + kstep, voffB);
    PG8_WAIT_V(6); PG8_BAR;
    for (;;) {
        const bool has_next = S.next(ui + 1, nxt);
        const char* nA = has_next ? (const char*)g.A + (size_t)nxt.pm * tstep : cA; const char* nB = has_next ? (const char*)g.Bt + (size_t)nxt.pn * tstep : cB;
        for (int t = 0; t < nt; t += 2) {
            const bool last = (t == nt - 2);
            const char* a1 = cA + (size_t)(t + 1) * kstep;
            const char* a2 = last ? nA : cA + (size_t)(t + 2) * kstep; const char* b2 = last ? nB : cB + (size_t)(t + 2) * kstep;
            const char* a3 = a2 + kstep; const char* b3 = b2 + kstep;
            PG8_LDB(B0, 0, 0); PG8_LDB(B1, 0, 1); PG8_SCHED; PG8_LDA(At, 0, 0); PG8_STAGE(PG8_SA(1, 1), a1 + hstep, voffA);
            PG8_WAIT_V(8); PG8_WAIT_L(0); PG8_BAR; PG8_MMA(0, 0, At, B0); PG8_MMA(0, 1, At, B1); PG8_BAR; PG8_SCHED;
            PG8_LDA(At, 0, 1); PG8_STAGE(PG8_SB(0, 0), b2, voffB); PG8_STAGE(PG8_SB(0, 1), b2 + hstep, voffB); PG8_STAGE(PG8_SA(0, 0), a2, voffA);
            PG8_WAIT_V(8); PG8_WAIT_L(0); PG8_BAR; PG8_MMA(1, 0, At, B0); PG8_MMA(1, 1, At, B1); PG8_BAR; PG8_SCHED;
            PG8_LDB(B0, 1, 0); PG8_LDB(B1, 1, 1); PG8_SCHED; PG8_LDA(At, 1, 0); PG8_STAGE(PG8_SA(0, 1), a2 + hstep, voffA);
            PG8_WAIT_V(8); PG8_WAIT_L(0); PG8_BAR; PG8_MMA(0, 0, At, B0); PG8_MMA(0, 1, At, B1); PG8_BAR; PG8_SCHED;
            PG8_LDA(At, 1, 1); PG8_STAGE(PG8_SB(1, 0), b3, voffB); PG8_STAGE(PG8_SB(1, 1), b3 + hstep, voffB); PG8_STAGE(PG8_SA(1, 0), a3, voffA);
            PG8_WAIT_V(8); PG8_WAIT_L(0); PG8_BAR; PG8_MMA(1, 0, At, B0); PG8_MMA(1, 1, At, B1); PG8_BAR; PG8_SCHED;
        }
        if constexpr (ALIGN_EPI) { if (wr == 0) PG8_BAR; }
        E(acc, cur, wr, wc, fr, fq);
        if (!has_next) break;
#pragma unroll
        for (int a = 0; a < 2; ++a)
#pragma unroll
            for (int b = 0; b < 2; ++b)
#pragma unroll
                for (int m = 0; m < 4; ++m)
#pragma unroll
                    for (int n = 0; n < 2; ++n) acc[a][b][m][n] = (f32x4){0.f, 0.f, 0.f, 0.f};
        cur = nxt; cA = nA; cB = nB; ++ui;
        if constexpr (ALIGN_EPI) { if (wr == 1) PG8_BAR; }
    }
    PG8_WAIT_V(0);
    if constexpr (!ALIGN_EPI) { if (wr == 0) PG8_BAR; }
    PG8_BAR;
#undef PG8_SA
#undef PG8_SB
#undef PG8_STAGE
#undef PG8_LDA
#undef PG8_LDB
#undef PG8_MMA
#undef PG8_WAIT_V
#undef PG8_WAIT_L
#undef PG8_BAR
#undef PG8_SCHED
}
}

#define XB_TMO      128
#define XB_XCNT(j)  (256  + 64 * (j))
#define XB_XSUB(j)  (1280 + 64 * (j))
#define XB_XGEN(j)  (2304 + 64 * (j))
#define XB_TOP      3328
#define XB_TOPGEN   3392
#define XCD_BAR_WORDS 3456
#define XB_SPIN_CAP (1u << 18)
constexpr size_t CTL_XCEN = 160 * 1024;
constexpr size_t CTL_Q = 128 * 1024;
constexpr size_t CTL_BAR = 64 * 1024;
__device__ __forceinline__ unsigned xb_ld(unsigned* p)              { return __hip_atomic_load(p, __ATOMIC_RELAXED, __HIP_MEMORY_SCOPE_AGENT); }
__device__ __forceinline__ unsigned xb_add(unsigned* p, unsigned v) { return __hip_atomic_fetch_add(p, v, __ATOMIC_RELAXED, __HIP_MEMORY_SCOPE_AGENT); }
__device__ __forceinline__ unsigned xb_xcc_id() { return (unsigned)__builtin_amdgcn_s_getreg((3 << 11) | 20) & 0xFu; }
#define XB_SPIN(cond, bar) do { unsigned _sp = 0; while (cond) { __builtin_amdgcn_s_sleep(1); \
    if ((++_sp & 255u) == 0u) { if (xb_ld(&(bar)[XB_TMO])) break; if (_sp > XB_SPIN_CAP) { atomicAdd(&(bar)[XB_TMO], 1u); break; } } } } while (0)
struct XcdBarrier { unsigned* bar; unsigned x; volatile LAS unsigned* st; };
__device__ __forceinline__ XcdBarrier xcd_barrier_post(unsigned* bar, volatile LAS unsigned* st) {
    XcdBarrier b; b.bar = bar; b.x = xb_xcc_id(); b.st = st;
    if (threadIdx.x == 0) (void)xb_add(&bar[XB_XCNT(b.x)], 1u);
    return b;
}
__device__ __forceinline__ void xcd_barrier_complete(unsigned* bar, unsigned x, unsigned& nloc, unsigned& nx) {
    const unsigned G = gridDim.x * gridDim.y * gridDim.z;
    unsigned sum, cnt, mine, sp = 0u;
    for (;;) {
        sum = 0u; cnt = 0u; mine = 0u;
#pragma unroll
        for (unsigned j = 0; j < 16; ++j) { const unsigned c = xb_ld(&bar[XB_XCNT(j)]); sum += c; cnt += (c > 0u) ? 1u : 0u; mine = (j == x) ? c : mine; }
        if (sum == G) break;
        __builtin_amdgcn_s_sleep(1);
        if ((++sp & 255u) == 0u) { if (xb_ld(&bar[XB_TMO])) break; if (sp > XB_SPIN_CAP) { atomicAdd(&bar[XB_TMO], 1u); break; } }
    }
    nloc = mine > 0u ? mine : 1u; nx = cnt > 0u ? cnt : 1u;
}
__device__ __forceinline__ void xcd_barrier(const XcdBarrier& b) {
    asm volatile("s_waitcnt vmcnt(0)" ::: "memory");
    __syncthreads();
    if (threadIdx.x == 0) {
        unsigned* bar = b.bar;
        __builtin_amdgcn_s_waitcnt(0);
        unsigned nloc = b.st[0], nx = b.st[1];
        if (nloc == 0u) { xcd_barrier_complete(bar, b.x, nloc, nx); b.st[0] = nloc; b.st[1] = nx; }
        const unsigned old = xb_add(&bar[XB_XSUB(b.x)], 1u);
        const unsigned gen = old / nloc;
        if (old + 1u == (gen + 1u) * nloc) {
            __builtin_amdgcn_fence(__ATOMIC_RELEASE, "agent");
            asm volatile("s_waitcnt vmcnt(0)" ::: "memory");
            const unsigned og = xb_add(&bar[XB_TOP], 1u);
            const unsigned tg = og / nx;
            if (og + 1u == (tg + 1u) * nx) xb_add(&bar[XB_TOPGEN], 1u);
            else XB_SPIN(xb_ld(&bar[XB_TOPGEN]) == tg, bar);
            __builtin_amdgcn_fence(__ATOMIC_ACQUIRE, "agent");
            xb_add(&bar[XB_XGEN(b.x)], 1u);
            asm volatile("s_waitcnt vmcnt(0)" ::: "memory");
        } else {
            XB_SPIN(xb_ld(&bar[XB_XGEN(b.x)]) == gen, bar);
            __builtin_amdgcn_fence(__ATOMIC_ACQUIRE, "agent");
            asm volatile("s_waitcnt vmcnt(0)" ::: "memory");
        }
    }
    __syncthreads();
}

struct Args {
    const float* in[20];
    float* out;
    unsigned char* ws;
    int ph_lo, ph_hi;
};

__host__ __device__ __forceinline__ int win_logical(int c) { return (c < 1280) ? c : (c < 1304 ? 3328 + (c - 1280) : c - 24); }
__host__ __device__ __forceinline__ int tile_perm_row(int L) { const int Lc = L & 255, lo = Lc & 31; return (L & ~255) + 128 * ((Lc >> 5) & 1) + 32 * (Lc >> 6) + 16 * ((lo >> 2) & 1) + 4 * (lo >> 3) + (lo & 3); }

__host__ __device__ __forceinline__ int perm32_row(int col) { const int cg = col & 31; return (col & ~31) + 16 * ((cg >> 2) & 1) + 4 * (cg >> 3) + (cg & 3); }
template <int MAPKIND>
__device__ __forceinline__ void p0_transpose_item(const float* W, int K, int N, bf16* WT, LAS float* scr, int item, int lane, const float* kscale = nullptr) {
    const int nblk = (N + 31) / 32, kb = item / nblk, nb = item % nblk, k0 = 64 * kb, n0 = 32 * nb;
    const int c4 = lane & 7, colr = n0 + 4 * c4;
    f32x4 wv[8];
#pragma unroll
    for (int i = 0; i < 8; ++i) { const int kk = (lane >> 3) + 8 * i; wv[i] = (colr < N) ? *(const f32x4*)(W + (size_t)(k0 + kk) * N + colr) : (f32x4){0.f, 0.f, 0.f, 0.f}; }
#pragma unroll
    for (int i = 0; i < 8; ++i) { const int kk = (lane >> 3) + 8 * i; const float ksc = kscale ? kscale[k0 + kk] : 1.0f; LAS float* d = scr + kk * 33 + 4 * c4;
        d[0] = wv[i].x * ksc; d[1] = wv[i].y * ksc; d[2] = wv[i].z * ksc; d[3] = wv[i].w * ksc; }
    LDS_WAIT(); asm volatile("" ::: "memory");
    const int c = lane & 7;
#pragma unroll
    for (int j = 0; j < 4; ++j) { const int n = (lane >> 3) + 8 * j; const LAS float* s = scr + (8 * c) * 33 + n; const int col = n0 + n;
        if (col < N) {
            u32x4 o; o.x = cvtpk(s[0 * 33], s[1 * 33]); o.y = cvtpk(s[2 * 33], s[3 * 33]); o.z = cvtpk(s[4 * 33], s[5 * 33]); o.w = cvtpk(s[6 * 33], s[7 * 33]);
            const int row = (MAPKIND == 1) ? tile_perm_row(win_logical(col)) : (MAPKIND == 2 ? tile_perm_row(col) : (MAPKIND == 3 ? perm32_row(col) : col));
            *(u32x4*)(WT + (size_t)row * K + k0 + 8 * c) = o; } }
    LDS_WAIT(); asm volatile("" ::: "memory");
}

__device__ __forceinline__ void rms_row_to_bf16(const float* xrow, const float* gain, bf16* orow, int lane) {
    const f32x4* xr = (const f32x4*)xrow + lane; const f32x4* gr = (const f32x4*)gain + lane;
    f32x4 v[4]; float s = 0.f;
#pragma unroll
    for (int j = 0; j < 4; ++j) { v[j] = xr[64 * j]; s += (v[j].x * v[j].x + v[j].y * v[j].y) + (v[j].z * v[j].z + v[j].w * v[j].w); }
    const float rs = 1.0f / sqrtf(wave_sum(s) * (1.f / DM) + EPS);
    u32x2* o8 = (u32x2*)orow + lane;
#pragma unroll
    for (int j = 0; j < 4; ++j) { const f32x4 g = gr[64 * j]; u32x2 w; w.x = cvtpk(v[j].x * rs * g.x, v[j].y * rs * g.y); w.y = cvtpk(v[j].z * rs * g.z, v[j].w * rs * g.w); o8[64 * j] = w; }
}

struct EpiIn {
    float* out; unsigned char* ws;
    const float *q_gain, *k_gain, *pe;
    __device__ __forceinline__ void operator()(const f32x4 (&acc)[2][2][4][2], const pg8::Unit& u, int wr, int wc, int fr, int fq) const {
        const int pn = u.pn;
        bf16* const Q = (bf16*)(ws + WS_Q); bf16* const KC = (bf16*)(ws + WS_KC); bf16* const KS = (bf16*)(ws + WS_KS); bf16* const KW = (bf16*)(ws + WS_KW);
        float* const GL = (float*)(ws + WS_GL); float* const GATES = (float*)(ws + WS_GATES); const float* const lb = (const float*)(ws + WS_LB);
        const int rowb = u.pm * 256 + wr * 64 + fr;
        const int lo8 = 8 * fq;
#define EPI_ROWS _Pragma("unroll") for (int ai = 0; ai < 2; ++ai) _Pragma("unroll") for (int m = 0; m < 4; ++m)
#define EPI_COLS _Pragma("unroll") for (int bj = 0; bj < 2; ++bj) _Pragma("unroll") for (int n = 0; n < 2; ++n)
#define EPI_BJ _Pragma("unroll") for (int bj = 0; bj < 2; ++bj)
#define PACK16(v0_, v1_) (u32x4){cvtpk((v0_).x, (v0_).y), cvtpk((v0_).z, (v0_).w), cvtpk((v1_).x, (v1_).y), cvtpk((v1_).z, (v1_).w)}
        if (pn < 2) {
            f32x4 g[2][2];
            EPI_COLS g[bj][n] = *(const f32x4*)(q_gain + 32 * bj + lo8 + 4 * n);
            EPI_ROWS { const int row = rowb + 128 * ai + 16 * m; float ss = 0.f;
                EPI_COLS { const f32x4 v = acc[ai][bj][m][n]; ss += (v.x * v.x + v.y * v.y) + (v.z * v.z + v.w * v.w); }
                ss += __shfl_xor(ss, 16); ss += __shfl_xor(ss, 32);
                const float rs = __builtin_amdgcn_rsqf(ss * (1.f / 64.f) + EPS);
                bf16* dst = Q + (size_t)row * 512 + pn * 256 + 64 * wc + lo8;
                EPI_BJ { const f32x4 v0 = acc[ai][bj][m][0] * rs * g[bj][0], v1 = acc[ai][bj][m][1] * rs * g[bj][1]; *(u32x4*)(dst + 32 * bj) = PACK16(v0, v1); } }
        } else if (pn < 5) {
            const bool norm = (pn > 2) && (wc < 2);
            f32x4 g[2][2];
            EPI_COLS g[bj][n] = norm ? *(const f32x4*)(k_gain + (pn - 2) * 64 + 32 * bj + lo8 + 4 * n) : (f32x4){1.f, 1.f, 1.f, 1.f};
            EPI_ROWS { const int row = rowb + 128 * ai + 16 * m; float rs = 1.f;
                if (norm) { float ss = 0.f;
                    EPI_COLS { const f32x4 v = acc[ai][bj][m][n]; ss += (v.x * v.x + v.y * v.y) + (v.z * v.z + v.w * v.w); }
                    ss += __shfl_xor(ss, 16); ss += __shfl_xor(ss, 32);
                    rs = __builtin_amdgcn_rsqf(ss * (1.f / 64.f) + EPS); }
                float* fdst = nullptr; bf16* bdst = nullptr; const float* pep = nullptr;
                if (pn == 2) { fdst = (row < MP) ? out + O_KVP + (size_t)row * 512 : out + O_KVS + (size_t)(row - MP) * 512;
                               if (row < MP) { bdst = KC + (size_t)row * 256; pep = pe + (wc >> 1) * 4096 + (row & 63) * 64; } }
                else if (pn == 3) { fdst = ((row < MP) ? out + O_KVP + (size_t)row * 512 : out + O_KVS + (size_t)(row - MP) * 512) + 256; bdst = KS + (size_t)row * 256; }
                else { bdst = KW + (size_t)row * 256;
                       if (row < MP) { const int t = row & (SEQ - 1), b = row >> 12; if (t >= SEQ - 512) fdst = out + O_WINP + ((size_t)b * 512 + (t - (SEQ - 512))) * 256; }
                       else { const int rs_ = row - MP, b = rs_ >> 3, t = rs_ & 7; fdst = out + O_WINS + ((size_t)b * 512 + 504 + t) * 256; } }
                const int cb = 64 * wc + lo8;
                EPI_BJ { f32x4 v0 = acc[ai][bj][m][0] * rs * g[bj][0], v1 = acc[ai][bj][m][1] * rs * g[bj][1];
                    if (fdst) { __builtin_nontemporal_store(v0, (f32x4*)(fdst + cb + 32 * bj)); __builtin_nontemporal_store(v1, (f32x4*)(fdst + cb + 32 * bj + 4)); }
                    if (bdst) { if (pep) { v0 = v0 + *(const f32x4*)(pep + lo8 + 32 * bj); v1 = v1 + *(const f32x4*)(pep + lo8 + 32 * bj + 4); } *(u32x4*)(bdst + cb + 32 * bj) = PACK16(v0, v1); } } }
        } else if (pn < 13) {
            const int kind = (pn - 5) >> 1, cbase = ((pn - 5) & 1) * 256 + 64 * wc + lo8;
            bf16* B = (bf16*)(ws + WS_RQ + (size_t)kind * (WS_RK - WS_RQ));
            f32x4 lbv[2][2];
            EPI_COLS lbv[bj][n] = (kind == 1) ? *(const f32x4*)(lb + cbase + 32 * bj + 4 * n) : (f32x4){0.f, 0.f, 0.f, 0.f};
            EPI_ROWS { const int row = rowb + 128 * ai + 16 * m;
                EPI_BJ { f32x4 v[2];
#pragma unroll
                    for (int n = 0; n < 2; ++n) { v[n] = acc[ai][bj][m][n];
                        if (kind == 0 || kind == 3) { v[n].x = siluf_(v[n].x); v[n].y = siluf_(v[n].y); v[n].z = siluf_(v[n].z); v[n].w = siluf_(v[n].w); }
                        if (kind == 1) { f32x4 gl, kk; const f32x4 l = lbv[bj][n];
#pragma unroll
                            for (int i = 0; i < 4; ++i) { const float e = __expf(-v[n][i]); const float sg = __builtin_amdgcn_rcpf(1.0f + e); const float f = l[i] + (1.0f - l[i]) * sg; gl[i] = __logf(f); kk[i] = (1.0f - l[i]) * (e * sg); }
                            *(f32x4*)(GL + (size_t)row * 512 + cbase + 32 * bj + 4 * n) = gl; v[n] = kk; } }
                    *(u32x4*)(B + (size_t)row * 512 + cbase + 32 * bj) = PACK16(v[0], v[1]); } }
        } else {
            if (wc == 0 && fq < 3) {
                EPI_ROWS { const int row = rowb + 128 * ai + 16 * m;
#pragma unroll
                    for (int n = 0; n < 2; ++n) { f32x4 v = acc[ai][0][m][n];
                        v.x = sigmoidf_(v.x); v.y = sigmoidf_(v.y); v.z = sigmoidf_(v.z); v.w = sigmoidf_(v.w); *(f32x4*)(GATES + (size_t)row * 24 + lo8 + 4 * n) = v; } }
            }
        }
#undef EPI_ROWS
#undef EPI_COLS
#undef EPI_BJ
#undef PACK16
    }
};

typedef short v4i16_t __attribute__((ext_vector_type(4)));
constexpr int KVS = 144;
constexpr int KVT = 64 * KVS;
constexpr float LOG2E = 1.4426950408889634f;
constexpr float SL2 = 0.125f * LOG2E;
__device__ __forceinline__ f32x4 mfma16(bf16x8 a, bf16x8 b, f32x4 c) { return __builtin_amdgcn_mfma_f32_16x16x32_bf16(a, b, c, 0, 0, 0); }
__device__ __forceinline__ bf16x4 ldtr(LAS const unsigned char* p) { return __builtin_bit_cast(bf16x4, __builtin_amdgcn_ds_read_tr16_b64_v4i16((LAS v4i16_t*)p)); }
__device__ __forceinline__ bf16x8 pack8(f32x4 a, f32x4 b) { u32x4 w; w.x = cvtpk(a.x, a.y); w.y = cvtpk(a.z, a.w); w.z = cvtpk(b.x, b.y); w.w = cvtpk(b.z, b.w); return __builtin_bit_cast(bf16x8, w); }
__device__ __forceinline__ bf16x8 cat44(bf16x4 a, bf16x4 b) { return (bf16x8){a[0], a[1], a[2], a[3], b[0], b[1], b[2], b[3]}; }
struct AttnSt { f32x4 o[4][2]; float m[2], l[2]; };
__device__ __forceinline__ void attn_init(AttnSt& st) {
#pragma unroll
    for (int dt = 0; dt < 4; ++dt) { st.o[dt][0] = (f32x4){0.f, 0.f, 0.f, 0.f}; st.o[dt][1] = (f32x4){0.f, 0.f, 0.f, 0.f}; }
    st.m[0] = st.m[1] = 0.f; st.l[0] = st.l[1] = 0.f;
}
__device__ __forceinline__ void attn_scores(f32x4 (&s)[2][4], const bf16x8 (&qf)[2][2], LAS const unsigned char* Kt, int c, int q4) {
    bf16x8 kf[4][2];
#pragma unroll
    for (int kt4 = 0; kt4 < 4; ++kt4) { kf[kt4][0] = *(LAS const bf16x8*)(Kt + (16 * kt4 + c) * KVS + 16 * q4); kf[kt4][1] = *(LAS const bf16x8*)(Kt + (16 * kt4 + c) * KVS + 64 + 16 * q4); }
    __builtin_amdgcn_sched_barrier(0);
#pragma unroll
    for (int kt4 = 0; kt4 < 4; ++kt4)
#pragma unroll
        for (int qt2 = 0; qt2 < 2; ++qt2) s[qt2][kt4] = mfma16(kf[kt4][0], qf[qt2][0], (f32x4){0.f, 0.f, 0.f, 0.f});
#pragma unroll
    for (int kt4 = 0; kt4 < 4; ++kt4)
#pragma unroll
        for (int qt2 = 0; qt2 < 2; ++qt2) s[qt2][kt4] = mfma16(kf[kt4][1], qf[qt2][1], s[qt2][kt4]);
}
__device__ __forceinline__ void attn_pv(f32x4 (&o)[4][2], const f32x4 (&p)[2][4], LAS const unsigned char* Vt, int c, int q4) {
    const int vrow = 4 * q4 + (c >> 2), vcol = 8 * (c & 3);
    bf16x4 lo[2][4], hi[2][4];
#pragma unroll
    for (int s2 = 0; s2 < 2; ++s2)
#pragma unroll
        for (int dt = 0; dt < 4; ++dt) { lo[s2][dt] = ldtr(Vt + (32 * s2 + vrow) * KVS + 32 * dt + vcol); hi[s2][dt] = ldtr(Vt + (32 * s2 + 16 + vrow) * KVS + 32 * dt + vcol); }
    bf16x8 pb[2][2];
#pragma unroll
    for (int s2 = 0; s2 < 2; ++s2) { pb[s2][0] = pack8(p[0][2 * s2], p[0][2 * s2 + 1]); pb[s2][1] = pack8(p[1][2 * s2], p[1][2 * s2 + 1]); }
    __builtin_amdgcn_sched_barrier(0);
#pragma unroll
    for (int s2 = 0; s2 < 2; ++s2)
#pragma unroll
        for (int dt = 0; dt < 4; ++dt) { const bf16x8 vf = cat44(lo[s2][dt], hi[s2][dt]); o[dt][0] = mfma16(vf, pb[s2][0], o[dt][0]); o[dt][1] = mfma16(vf, pb[s2][1], o[dt][1]); }
}
__device__ __forceinline__ void attn_pv_lean(f32x4 (&o)[4][2], const f32x4 (&p)[2][4], LAS const unsigned char* Vt, int c, int q4) {
    const int vrow = 4 * q4 + (c >> 2), vcol = 8 * (c & 3);
#pragma unroll
    for (int s2 = 0; s2 < 2; ++s2) {
        const bf16x8 pb0 = pack8(p[0][2 * s2], p[0][2 * s2 + 1]), pb1 = pack8(p[1][2 * s2], p[1][2 * s2 + 1]);
#pragma unroll
        for (int dt = 0; dt < 4; ++dt) {
            const bf16x4 lo = ldtr(Vt + (32 * s2 + vrow) * KVS + 32 * dt + vcol);
            const bf16x4 hi = ldtr(Vt + (32 * s2 + 16 + vrow) * KVS + 32 * dt + vcol);
            const bf16x8 vf = cat44(lo, hi);
            o[dt][0] = mfma16(vf, pb0, o[dt][0]); o[dt][1] = mfma16(vf, pb1, o[dt][1]);
        }
    }
}
template <bool LEAN = false>
__device__ __forceinline__ void attn_update(AttnSt& st, f32x4 (&x)[2][4], LAS const unsigned char* Vt, int c, int q4) {
#pragma unroll
    for (int qt2 = 0; qt2 < 2; ++qt2) {
        float mx = -__builtin_inff();
#pragma unroll
        for (int kt4 = 0; kt4 < 4; ++kt4) mx = fmaxf(mx, fmaxf(fmaxf(x[qt2][kt4].x, x[qt2][kt4].y), fmaxf(x[qt2][kt4].z, x[qt2][kt4].w)));
        mx = fmaxf(mx, __shfl_xor(mx, 16)); mx = fmaxf(mx, __shfl_xor(mx, 32));
        const float mn = fmaxf(st.m[qt2], mx), mu = (mn == -__builtin_inff()) ? 0.f : mn;
        const float alpha = __builtin_amdgcn_exp2f(st.m[qt2] - mu);
        float ls = 0.f;
#pragma unroll
        for (int kt4 = 0; kt4 < 4; ++kt4) { f32x4 e;
#pragma unroll
            for (int i = 0; i < 4; ++i) e[i] = __builtin_amdgcn_exp2f(x[qt2][kt4][i] - mu);
            x[qt2][kt4] = e; ls += (e.x + e.y) + (e.z + e.w); }
        st.l[qt2] = st.l[qt2] * alpha + ls; st.m[qt2] = mn;
#pragma unroll
        for (int dt = 0; dt < 4; ++dt) st.o[dt][qt2] = st.o[dt][qt2] * alpha;
    }
    if (LEAN) attn_pv_lean(st.o, x, Vt, c, q4); else attn_pv(st.o, x, Vt, c, q4);
}
constexpr float MFIX = 17.0f;
template <bool LEAN = false>
__device__ __forceinline__ void attn_update_fixed(AttnSt& st, f32x4 (&x)[2][4], LAS const unsigned char* Vt, int c, int q4) {
#pragma unroll
    for (int qt2 = 0; qt2 < 2; ++qt2) { float ls = 0.f;
#pragma unroll
        for (int kt4 = 0; kt4 < 4; ++kt4) { f32x4 e;
#pragma unroll
            for (int i = 0; i < 4; ++i) e[i] = __builtin_amdgcn_exp2f(x[qt2][kt4][i]);
            x[qt2][kt4] = e; ls += (e.x + e.y) + (e.z + e.w); }
        st.l[qt2] += ls; }
    if (LEAN) attn_pv_lean(st.o, x, Vt, c, q4); else attn_pv(st.o, x, Vt, c, q4);
}
__device__ __forceinline__ void kv_load_regs(u32x4& kr, u32x4& vr, const bf16* base, size_t row0, int kcol, int tid) {
    const bf16* p = base + (row0 + (tid >> 3)) * 256 + kcol + 8 * (tid & 7);
    kr = *(const u32x4*)p; vr = *(const u32x4*)(p + 128);
}
__device__ __forceinline__ void kv_store_lds(LAS unsigned char* Kt, LAS unsigned char* Vt, u32x4 kr, u32x4 vr, int tid) {
    const int off = (tid >> 3) * KVS + 16 * (tid & 7);
    *(LAS u32x4*)(Kt + off) = kr; *(LAS u32x4*)(Vt + off) = vr;
}
__device__ __forceinline__ void load_qfrags(bf16x8 (&qf)[2][2], const bf16* Q, size_t row0, int hcol, int c, int q4) {
#pragma unroll
    for (int qt2 = 0; qt2 < 2; ++qt2)
#pragma unroll
        for (int ks = 0; ks < 2; ++ks) qf[qt2][ks] = *(const bf16x8*)(Q + (row0 + 16 * qt2 + c) * 512 + hcol + 32 * ks + 8 * q4);
}

__device__ __forceinline__ void win_prompt_unit(LAS unsigned char* lds, unsigned char* ws, int unit, int tid) {
    const int lane = tid & 63, w = __builtin_amdgcn_readfirstlane(tid >> 6), c = lane & 15, q4 = lane >> 4;
    const int b = unit >> 7, g = (unit >> 6) & 1, qblk = unit & 63, t0 = 64 * qblk, r = w & 3, th = w >> 2, head = 4 * g + r;
    const float slope2 = __builtin_amdgcn_exp2f(-(float)(head + 1)) * LOG2E;
    const bf16* KW = (const bf16*)(ws + WS_KW);
    const size_t rowb = (size_t)b * SEQ;
    bf16x8 qf[2][2]; load_qfrags(qf, (const bf16*)(ws + WS_Q), rowb + t0 + 32 * th, 64 * head, c, q4);
    AttnSt st; attn_init(st);
    f32x4 kb[4];
#pragma unroll
    for (int kt4 = 0; kt4 < 4; ++kt4) kb[kt4] = (f32x4){slope2 * (float)(16 * kt4 + 4 * q4), slope2 * (float)(16 * kt4 + 4 * q4 + 1), slope2 * (float)(16 * kt4 + 4 * q4 + 2), slope2 * (float)(16 * kt4 + 4 * q4 + 3)};
    const int j0 = qblk >= 8 ? qblk - 8 : 0, nt = qblk - j0 + 1;
    u32x4 kr, vr;
    kv_load_regs(kr, vr, KW, rowb + 64 * j0, 64 * g, tid);
    kv_store_lds(lds, lds + KVT, kr, vr, tid);
    __syncthreads();
    for (int i = 0; i < nt; ++i) {
        LAS unsigned char* Kt = lds + (i & 1) * 2 * KVT; LAS unsigned char* Vt = Kt + KVT;
        if (i + 1 < nt) kv_load_regs(kr, vr, KW, rowb + 64 * (j0 + i + 1), 64 * g, tid);
        f32x4 s[2][4]; attn_scores(s, qf, Kt, c, q4);
        const int kbase = 64 * (j0 + i), jt = j0 + i;
        if (jt > qblk - 8 && jt < qblk) {
#pragma unroll
            for (int qt2 = 0; qt2 < 2; ++qt2) { const float c0 = slope2 * (float)(kbase - (t0 + 32 * th + 16 * qt2 + c)) - MFIX;
#pragma unroll
                for (int kt4 = 0; kt4 < 4; ++kt4) s[qt2][kt4] = s[qt2][kt4] * SL2 + (kb[kt4] + c0); }
        } else {
#pragma unroll
            for (int qt2 = 0; qt2 < 2; ++qt2) { const int qpos = t0 + 32 * th + 16 * qt2 + c;
#pragma unroll
                for (int kt4 = 0; kt4 < 4; ++kt4)
#pragma unroll
                    for (int e = 0; e < 4; ++e) { const int dist = qpos - (kbase + 16 * kt4 + 4 * q4 + e);
                        s[qt2][kt4][e] = (dist >= 0 && dist < 512) ? s[qt2][kt4][e] * SL2 - slope2 * (float)dist - MFIX : -__builtin_inff(); } }
        }
        attn_update_fixed(st, s, Vt, c, q4);
        if (i + 1 < nt) { LAS unsigned char* Kn = lds + ((i + 1) & 1) * 2 * KVT; kv_store_lds(Kn, Kn + KVT, kr, vr, tid); }
        __syncthreads();
    }
    bf16* OW = (bf16*)(ws + WS_OWIN);
#pragma unroll
    for (int qt2 = 0; qt2 < 2; ++qt2) { float l = st.l[qt2]; l += __shfl_xor(l, 16); l += __shfl_xor(l, 32); const float il = 1.0f / l;
        bf16* dst = OW + (rowb + t0 + 32 * th + 16 * qt2 + c) * 512 + 64 * head + 4 * q4;
#pragma unroll
        for (int dt = 0; dt < 4; ++dt) { const f32x4 v = st.o[dt][qt2] * il; u32x2 wv; wv.x = cvtpk(v.x, v.y); wv.y = cvtpk(v.z, v.w); *(u32x2*)(dst + 16 * dt) = wv; } }
}

constexpr int SL_KV = 0, SL_PSLAB = 4 * KVT  , SL_IMP = SL_PSLAB + 65536, SL_MASK = SL_IMP + 16384, SL_UMASK = SL_MASK + 512;
__device__ __forceinline__ void sel_prompt_unit(LAS unsigned char* lds, unsigned char* ws, const float* attn_gain, int unit, int tid) {
    const int lane = tid & 63, w = __builtin_amdgcn_readfirstlane(tid >> 6), c = lane & 15, q4 = lane >> 4;
    const int b = unit >> 7, g = (unit >> 6) & 1, qblk = unit & 63, t0 = 64 * qblk, r = w & 3, th = w >> 2, head = 4 * g + r;
    const float slope2 = __builtin_amdgcn_exp2f(-(float)(head + 1)) * LOG2E;
    const size_t rowb = (size_t)b * SEQ;
    bf16x8 qf[2][2]; load_qfrags(qf, (const bf16*)(ws + WS_Q), rowb + t0 + 32 * th, 64 * head, c, q4);
    LAS float* PSLAB = (LAS float*)(lds + SL_PSLAB); LAS float* IMP = (LAS float*)(lds + SL_IMP);
    LAS unsigned long long* MASK = (LAS unsigned long long*)(lds + SL_MASK);
    {
        const float* kc = (const float*)(ws + WS_KCMP) + (((size_t)b * 64 + (tid >> 3)) * 2 + g) * 64 + 8 * (tid & 7);
        const float* vc = (const float*)(ws + WS_VCMP) + (((size_t)b * 64 + (tid >> 3)) * 2 + g) * 64 + 8 * (tid & 7);
        const f32x4 k0 = *(const f32x4*)kc, k1 = *(const f32x4*)(kc + 4), v0 = *(const f32x4*)vc, v1 = *(const f32x4*)(vc + 4);
        kv_store_lds(lds, lds + KVT, __builtin_bit_cast(u32x4, pack8(k0, k1)), __builtin_bit_cast(u32x4, pack8(v0, v1)), tid);
    }
    __syncthreads();
    AttnSt sc; attn_init(sc);
    {
        f32x4 s[2][4]; attn_scores(s, qf, lds, c, q4);
#pragma unroll
        for (int qt2 = 0; qt2 < 2; ++qt2) { const int tok = 32 * th + 16 * qt2 + c, qpos = t0 + tok; float mx = -__builtin_inff();
#pragma unroll
            for (int kt4 = 0; kt4 < 4; ++kt4)
#pragma unroll
                for (int e = 0; e < 4; ++e) { const int dist = qpos - (64 * (16 * kt4 + 4 * q4 + e) + 63);
                    const float x = (dist >= 0) ? s[qt2][kt4][e] * SL2 - slope2 * (float)dist : -__builtin_inff(); s[qt2][kt4][e] = x; mx = fmaxf(mx, x); }
            mx = fmaxf(mx, __shfl_xor(mx, 16)); mx = fmaxf(mx, __shfl_xor(mx, 32));
            const float mu = (mx == -__builtin_inff()) ? 0.f : mx; float ls = 0.f;
#pragma unroll
            for (int kt4 = 0; kt4 < 4; ++kt4)
#pragma unroll
                for (int e = 0; e < 4; ++e) { const float p = __builtin_amdgcn_exp2f(s[qt2][kt4][e] - mu); s[qt2][kt4][e] = p; ls += p; }
            ls += __shfl_xor(ls, 16); ls += __shfl_xor(ls, 32);
            const float il = ls > 0.f ? 1.0f / ls : 0.f;
#pragma unroll
            for (int kt4 = 0; kt4 < 4; ++kt4) { s[qt2][kt4] = s[qt2][kt4] * il; *(LAS f32x4*)(PSLAB + (r * 64 + tok) * 64 + 16 * kt4 + 4 * q4) = s[qt2][kt4]; } }
        attn_pv(sc.o, s, lds + KVT, c, q4);
    }
    __syncthreads();
    {
        const int tok = tid >> 3, jg = tid & 7;
#pragma unroll
        for (int h2 = 0; h2 < 2; ++h2) { f32x4 a = (f32x4){0.f, 0.f, 0.f, 0.f};
#pragma unroll
            for (int rr = 0; rr < 4; ++rr) a = a + *(LAS const f32x4*)(PSLAB + (rr * 64 + tok) * 64 + 8 * jg + 4 * h2);
            *(LAS f32x4*)(IMP + tok * 64 + 8 * jg + 4 * h2) = a; }
    }
    __syncthreads();
    {
        const int tok = tid >> 3, jg = tid & 7; unsigned long long bits = 0ull;
        for (int jj = 0; jj < 8; ++jj) { const int j = 8 * jg + jj; bool sel = false;
            if (j == 0 || j == qblk) sel = true;
            else if (j < qblk) { const float vj = IMP[tok * 64 + j]; int cnt = 0;
                for (int i = 1; i < qblk; ++i) { const float vi = IMP[tok * 64 + i]; cnt += (vi > vj || (vi == vj && i < j)) ? 1 : 0; }
                sel = cnt < 14; }
            if (sel) bits |= 1ull << j; }
        bits |= __shfl_xor(bits, 1); bits |= __shfl_xor(bits, 2); bits |= __shfl_xor(bits, 4);
        if (jg == 0) MASK[tok] = bits;
    }
    __syncthreads();
    if (tid < 64) { unsigned long long u = MASK[tid];
#pragma unroll
        for (int o = 1; o < 64; o <<= 1) u |= __shfl_xor(u, o);
        if (tid == 0) *(LAS unsigned long long*)(lds + SL_UMASK) = u; }
    __syncthreads();
    unsigned long long um = *(LAS unsigned long long*)(lds + SL_UMASK);
    um = ((unsigned long long)__builtin_amdgcn_readfirstlane((unsigned)(um >> 32)) << 32) | (unsigned)__builtin_amdgcn_readfirstlane((unsigned)um);
    const unsigned long long msk0 = MASK[32 * th + c], msk1 = MASK[32 * th + 16 + c];
    const bf16* KS = (const bf16*)(ws + WS_KS);
    AttnSt st; attn_init(st);
    f32x4 kb[4];
#pragma unroll
    for (int kt4 = 0; kt4 < 4; ++kt4) kb[kt4] = (f32x4){slope2 * (float)(16 * kt4 + 4 * q4), slope2 * (float)(16 * kt4 + 4 * q4 + 1), slope2 * (float)(16 * kt4 + 4 * q4 + 2), slope2 * (float)(16 * kt4 + 4 * q4 + 3)};
    u32x4 kr, vr;
    int jcur = __builtin_ctzll(um); um &= um - 1;
    kv_load_regs(kr, vr, KS, rowb + 64 * jcur, 64 * g, tid);
    __syncthreads();
    kv_store_lds(lds, lds + KVT, kr, vr, tid);
    __syncthreads();
    for (int i = 0;; ++i) {
        LAS unsigned char* Kt = lds + (i & 1) * 2 * KVT; LAS unsigned char* Vt = Kt + KVT;
        const bool more = um != 0ull; int jn = 0;
        if (more) { jn = __builtin_ctzll(um); um &= um - 1; kv_load_regs(kr, vr, KS, rowb + 64 * jn, 64 * g, tid); }
        const bool s0 = (msk0 >> jcur) & 1ull, s1 = (msk1 >> jcur) & 1ull;
        if (__any(s0 || s1)) {
            f32x4 s[2][4]; attn_scores(s, qf, Kt, c, q4);
            const int kbase = 64 * jcur;
            if (jcur < qblk) {
#pragma unroll
                for (int qt2 = 0; qt2 < 2; ++qt2) { const float c0 = (qt2 ? s1 : s0) ? slope2 * (float)(kbase - (t0 + 32 * th + 16 * qt2 + c)) - MFIX : -__builtin_inff();
#pragma unroll
                    for (int kt4 = 0; kt4 < 4; ++kt4) s[qt2][kt4] = s[qt2][kt4] * SL2 + (kb[kt4] + c0); }
            } else {
#pragma unroll
                for (int qt2 = 0; qt2 < 2; ++qt2) { const int qpos = t0 + 32 * th + 16 * qt2 + c; const bool sq = qt2 ? s1 : s0;
#pragma unroll
                    for (int kt4 = 0; kt4 < 4; ++kt4)
#pragma unroll
                        for (int e = 0; e < 4; ++e) { const int dist = qpos - (kbase + 16 * kt4 + 4 * q4 + e);
                            s[qt2][kt4][e] = (sq && dist >= 0) ? s[qt2][kt4][e] * SL2 - slope2 * (float)dist - MFIX : -__builtin_inff(); } }
            }
            attn_update_fixed(st, s, Vt, c, q4);
        }
        if (more) { LAS unsigned char* Kn = lds + ((i + 1) & 1) * 2 * KVT; kv_store_lds(Kn, Kn + KVT, kr, vr, tid); }
        __syncthreads();
        if (!more) break;
        jcur = jn;
    }
    const float* GATES = (const float*)(ws + WS_GATES); const bf16* OW = (const bf16*)(ws + WS_OWIN); bf16* OA = (bf16*)(ws + WS_OA);
#pragma unroll
    for (int qt2 = 0; qt2 < 2; ++qt2) { const size_t row = rowb + t0 + 32 * th + 16 * qt2 + c;
        float l = st.l[qt2]; l += __shfl_xor(l, 16); l += __shfl_xor(l, 32); const float il = l > 0.f ? 1.0f / l : 0.f;
        const float g0 = GATES[row * 24 + head * 3 + 0], g1 = GATES[row * 24 + head * 3 + 1] * il, g2 = GATES[row * 24 + head * 3 + 2];
        f32x4 oa[4]; float ss = 0.f;
#pragma unroll
        for (int dt = 0; dt < 4; ++dt) { const u32x2 wv = *(const u32x2*)(OW + row * 512 + 64 * head + 16 * dt + 4 * q4);
            const f32x4 ow = (f32x4){__builtin_bit_cast(float, wv.x << 16), __builtin_bit_cast(float, wv.x & 0xffff0000u), __builtin_bit_cast(float, wv.y << 16), __builtin_bit_cast(float, wv.y & 0xffff0000u)};
            oa[dt] = sc.o[dt][qt2] * g0 + st.o[dt][qt2] * g1 + ow * g2;
            ss += (oa[dt].x * oa[dt].x + oa[dt].y * oa[dt].y) + (oa[dt].z * oa[dt].z + oa[dt].w * oa[dt].w); }
        ss += __shfl_xor(ss, 16); ss += __shfl_xor(ss, 32);
        const float rs = 1.0f / sqrtf(ss * (1.f / 64.f) + EPS);
#pragma unroll
        for (int dt = 0; dt < 4; ++dt) { const f32x4 gn = *(const f32x4*)(attn_gain + 64 * head + 16 * dt + 4 * q4); const f32x4 v = oa[dt] * rs * gn;
            u32x2 wv; wv.x = cvtpk(v.x, v.y); wv.y = cvtpk(v.z, v.w); *(u32x2*)(OA + row * 1024 + 64 * head + 16 * dt + 4 * q4) = wv; } }
    __syncthreads();
}

constexpr int CA_RS = 272, CA_BUF = 128 * CA_RS  , CL_H = 0, CH_RS = 272, CL_O = 128 * CH_RS  , CO_RS = 272;
constexpr int N_CMP_ITEMS = 136;
__device__ __forceinline__ void compress_item(LAS unsigned char* lds, unsigned char* ws, const float* cache_kv, const int* page_table, const float* pe, const float* k_gain, int item, int tid) {
    const int lane = tid & 63, w = __builtin_amdgcn_readfirstlane(tid >> 6), c = lane & 15, q4 = lane >> 4;
    const int kind = item & 1, ci = item >> 1;
    const bool prompt = ci < 4;
    const int l_pl = (tid >> 5) & 1, l_piece = tid & 31, l_g = l_piece >> 4, l_d = 4 * (l_piece & 15), l_blo = tid >> 6;
    unsigned soff[8];
    const bf16* const KCp = (const bf16*)(ws + WS_KC);
#pragma unroll
    for (int i = 0; i < 8; ++i) { const int bl = 8 * i + l_blo;
        if (prompt) soff[i] = (unsigned)(((size_t)ci * SEQ + 64 * bl + l_pl) * 256 + 128 * kind + 4 * l_piece);
        else { const int sb = 2 * (ci - 4) + (bl >> 5), blk = bl & 31; const int page = page_table[sb * NPAGES + (blk >> 1)];
               soff[i] = (unsigned)(((size_t)page * PAGE + (blk & 1) * 64 + l_pl) * 512 + 128 * kind + 4 * l_piece); } }
    const float* pep = pe + kind * 4096 + l_pl * 64 + l_d;
    const int l_dst = (2 * l_blo + l_g) * CA_RS + (l_pl * 64 + l_d) * 2;
    const bf16* W1 = (const bf16*)(ws + WS_W1) + (size_t)kind * 128 * 4096 + (size_t)(16 * w + c) * 4096 + 8 * q4;
    f32x4 acc[8];
#pragma unroll
    for (int mt = 0; mt < 8; ++mt) acc[mt] = (f32x4){0.f, 0.f, 0.f, 0.f};
    u32x4 ra0[8], ra1[8]; bf16x8 rb0[4], rb1[4];
#define CMP_ALOAD(R, st) do { if (prompt) { _Pragma("unroll") for (int i = 0; i < 8; ++i) { const u32x2 t_ = *(const u32x2*)(KCp + (size_t)soff[i] + (size_t)(2 * (st)) * 256); R[i] = (u32x4){t_.x, t_.y, 0u, 0u}; } } \
        else { _Pragma("unroll") for (int i = 0; i < 8; ++i) R[i] = __builtin_nontemporal_load((const u32x4*)(cache_kv + (size_t)soff[i] + (size_t)(2 * (st)) * 512)); } } while (0)
#define CMP_ASTORE(R, st, buf) do { LAS unsigned char* A_ = lds + (buf) * CA_BUF + l_dst; \
        if (prompt) { _Pragma("unroll") for (int i = 0; i < 8; ++i) { u32x2 w_; w_.x = R[i].x; w_.y = R[i].y; *(LAS u32x2*)(A_ + 16 * i * CA_RS) = w_; } } \
        else { const f32x4 pv_ = *(const f32x4*)(pep + (2 * (st)) * 64); _Pragma("unroll") for (int i = 0; i < 8; ++i) { const f32x4 v_ = __builtin_bit_cast(f32x4, R[i]) + pv_; u32x2 w_; w_.x = cvtpk(v_.x, v_.y); w_.y = cvtpk(v_.z, v_.w); *(LAS u32x2*)(A_ + 16 * i * CA_RS) = w_; } } } while (0)
#define CMP_BLOAD(R, st) do { _Pragma("unroll") for (int ks = 0; ks < 4; ++ks) R[ks] = *(const bf16x8*)(W1 + 128 * (st) + 32 * ks); } while (0)
#define CMP_COMPUTE(RB, buf) do { LAS const unsigned char* A_ = lds + (buf) * CA_BUF + c * CA_RS + 16 * q4; \
        _Pragma("unroll") for (int ks = 0; ks < 4; ++ks) _Pragma("unroll") for (int mt = 0; mt < 8; ++mt) acc[mt] = mfma16(*(LAS const bf16x8*)(A_ + 16 * mt * CA_RS + 64 * ks), RB[ks], acc[mt]); } while (0)
    CMP_BLOAD(rb0, 0); CMP_ALOAD(ra0, 0); CMP_ALOAD(ra1, 1);
    CMP_ASTORE(ra0, 0, 0);
    __syncthreads();
    for (int s2 = 0; s2 < 32; s2 += 2) {
        CMP_BLOAD(rb1, s2 + 1);
        if (s2 + 2 < 32) CMP_ALOAD(ra0, s2 + 2);
        CMP_COMPUTE(rb0, 0);
        CMP_ASTORE(ra1, s2 + 1, 1);
        __syncthreads();
        if (s2 + 2 < 32) CMP_BLOAD(rb0, s2 + 2);
        if (s2 + 3 < 32) CMP_ALOAD(ra1, s2 + 3);
        CMP_COMPUTE(rb1, 1);
        if (s2 + 2 < 32) CMP_ASTORE(ra0, s2 + 2, 0);
        __syncthreads();
    }
#undef CMP_ALOAD
#undef CMP_ASTORE
#undef CMP_BLOAD
#undef CMP_COMPUTE
    {
        LAS unsigned short* H = (LAS unsigned short*)(lds + CL_H);
#pragma unroll
        for (int mt = 0; mt < 8; ++mt)
#pragma unroll
            for (int e = 0; e < 4; ++e) { const float v = siluf_(acc[mt][e]); H[(16 * mt + 4 * q4 + e) * (CH_RS / 2) + 16 * w + c] = (unsigned short)(cvtpk(v, 0.f) & 0xffffu); }
    }
    __syncthreads();
    {
        const int ot = w & 3, mt0 = 4 * (w >> 2);
        const bf16* W2 = (const bf16*)(ws + WS_W2) + (size_t)kind * 64 * 128 + (size_t)(16 * ot + c) * 128 + 8 * q4;
        LAS const unsigned char* H = lds + CL_H + (16 * mt0 + c) * CH_RS + 16 * q4;
        f32x4 o[4];
#pragma unroll
        for (int mt = 0; mt < 4; ++mt) o[mt] = (f32x4){0.f, 0.f, 0.f, 0.f};
#pragma unroll
        for (int ks = 0; ks < 4; ++ks) { const bf16x8 bw = *(const bf16x8*)(W2 + 32 * ks);
#pragma unroll
            for (int mt = 0; mt < 4; ++mt) o[mt] = mfma16(*(LAS const bf16x8*)(H + 16 * mt * CH_RS + 64 * ks), bw, o[mt]); }
        LAS float* O = (LAS float*)(lds + CL_O);
#pragma unroll
        for (int mt = 0; mt < 4; ++mt)
#pragma unroll
            for (int e = 0; e < 4; ++e) O[(16 * (mt0 + mt) + 4 * q4 + e) * (CO_RS / 4) + 16 * ot + c] = o[mt][e];
    }
    __syncthreads();
#pragma unroll
    for (int rep = 0; rep < 2; ++rep) {
        const int id = rep * 512 + tid, row = id >> 3, seg = id & 7;
        LAS const float* O = (LAS const float*)(lds + CL_O) + row * (CO_RS / 4) + 8 * seg;
        f32x4 a = *(LAS const f32x4*)O, b = *(LAS const f32x4*)(O + 4);
        if (kind == 0) { float ss = (a.x * a.x + a.y * a.y) + (a.z * a.z + a.w * a.w) + (b.x * b.x + b.y * b.y) + (b.z * b.z + b.w * b.w);
            ss += __shfl_xor(ss, 1); ss += __shfl_xor(ss, 2); ss += __shfl_xor(ss, 4);
            const float rs = 1.0f / sqrtf(ss * (1.f / 64.f) + EPS);
            a = a * rs * *(const f32x4*)(k_gain + 8 * seg); b = b * rs * *(const f32x4*)(k_gain + 8 * seg + 4); }
        float* dst = (float*)(ws + (kind == 0 ? WS_KCMP : WS_VCMP)) + ((size_t)(64 * ci + (row >> 1)) * 2 + (row & 1)) * 64 + 8 * seg;
        *(f32x4*)dst = a; *(f32x4*)(dst + 4) = b;
    }
    __syncthreads();
}

constexpr int HG_QH = 0, HG_QT = KVT, HG_KT = 2 * KVT, HG_KH = 3 * KVT, HG_V = 4 * KVT, HG_CUM = 5 * KVT, HG_GRS = 272, HG_REF = HG_CUM + 64 * HG_GRS, HG_LASTV = HG_REF + 256, HG_LAST = HG_LASTV + 256, HG_HALF = HG_LAST + 256;
constexpr int HG_GLB = HG_QT;
static_assert(64 * HG_GRS <= 2 * KVT && 2 * HG_HALF <= LDS_CTLW, "hgrn LDS map");
__device__ __forceinline__ void hgrn_local_item(LAS unsigned char* lds_all, unsigned char* ws, int item, int tid) {
    const int half = tid >> 8, lt = tid & 255, lane = tid & 63, we = __builtin_amdgcn_readfirstlane((tid >> 6) & 3), c = lane & 15, q4 = lane >> 4;
    LAS unsigned char* lds = lds_all + half * HG_HALF;
    const int unit = 2 * item + half, b = unit >> 7, h = (unit >> 4) & 7, sc = unit & 15;
    const size_t T0 = (size_t)b * SEQ + 256 * sc; const int hc = 64 * h;
    const bf16* RQ = (const bf16*)(ws + WS_RQ); const bf16* RK = (const bf16*)(ws + WS_RK); const bf16* RV = (const bf16*)(ws + WS_RV); const float* GL = (const float*)(ws + WS_GL);
    bf16* OLOC = (bf16*)(ws + WS_OLOC); bf16* QH = (bf16*)(ws + WS_QH);
    LAS float* LASTE = (LAS float*)(lds + HG_LAST);
    const int gp = lt & 15, gtb = lt >> 4, op = lt & 7, otb = lt >> 3;
    const int pd = lt & 63, ptq = lt >> 6;
    f32x4 S[4];
#pragma unroll
    for (int dt = 0; dt < 4; ++dt) S[dt] = (f32x4){0.f, 0.f, 0.f, 0.f};
    float base8[8];
#pragma unroll
    for (int j = 0; j < 8; ++j) base8[j] = 0.f;
    f32x4 gl_r[4]; u32x4 q_r[2], k_r[2], v_r[2];
#define HG_PREFETCH(cc_) do { const size_t R_ = T0 + 64 * (cc_); \
        _Pragma("unroll") for (int i = 0; i < 4; ++i) gl_r[i] = *(const f32x4*)(GL + (R_ + gtb + 16 * i) * 512 + hc + 4 * gp); \
        _Pragma("unroll") for (int i = 0; i < 2; ++i) { const size_t g_ = (R_ + otb + 32 * i) * 512 + hc + 8 * op; q_r[i] = *(const u32x4*)(RQ + g_); k_r[i] = *(const u32x4*)(RK + g_); v_r[i] = *(const u32x4*)(RV + g_); } } while (0)
    HG_PREFETCH(0);
    for (int cc = 0; cc < 4; ++cc) {
        const size_t R0 = T0 + 64 * cc;
#pragma unroll
        for (int i = 0; i < 4; ++i) *(LAS f32x4*)(lds + HG_GLB + (gtb + 16 * i) * HG_GRS + 16 * gp) = gl_r[i];
#pragma unroll
        for (int i = 0; i < 2; ++i) *(LAS u32x4*)(lds + HG_V + (otb + 32 * i) * KVS + 16 * op) = v_r[i];
        u32x4 qc[2], kc[2];
#pragma unroll
        for (int i = 0; i < 2; ++i) { qc[i] = q_r[i]; kc[i] = k_r[i]; }
        if (cc + 1 < 4) HG_PREFETCH(cc + 1);
        __syncthreads();
        {
            float run = 0.f;
            for (int t = 0; t < 16 * ptq; ++t) run += *(LAS const float*)(lds + HG_GLB + t * HG_GRS + 4 * pd);
#pragma unroll
            for (int i = 0; i < 16; ++i) { const int t = 16 * ptq + i; run += *(LAS const float*)(lds + HG_GLB + t * HG_GRS + 4 * pd); *(LAS float*)(lds + HG_CUM + t * HG_GRS + 4 * pd) = run; }
            if (ptq == 1) *(LAS float*)(lds + HG_REF + 4 * pd) = run;
            if (ptq == 3) { *(LAS float*)(lds + HG_LASTV + 4 * pd) = run; LASTE[pd] = __expf(run); }
        }
        __syncthreads();
        {
            const f32x4 rf0 = *(LAS const f32x4*)(lds + HG_REF + 32 * op), rf1 = *(LAS const f32x4*)(lds + HG_REF + 32 * op + 16);
            const f32x4 la0 = *(LAS const f32x4*)(lds + HG_LASTV + 32 * op), la1 = *(LAS const f32x4*)(lds + HG_LASTV + 32 * op + 16);
#pragma unroll
            for (int i = 0; i < 2; ++i) { const int t = otb + 32 * i;
                const f32x4 cu0 = *(LAS const f32x4*)(lds + HG_CUM + t * HG_GRS + 32 * op), cu1 = *(LAS const f32x4*)(lds + HG_CUM + t * HG_GRS + 32 * op + 16);
                float qh[8], qt[8], kt[8], kh[8], qg[8];
#pragma unroll
                for (int j = 0; j < 8; ++j) { const float cum = j < 4 ? cu0[j] : cu1[j - 4], ref = j < 4 ? rf0[j] : rf1[j - 4], last = j < 4 ? la0[j] : la1[j - 4];
                    const unsigned qw = qc[i][j >> 1], kw = kc[i][j >> 1];
                    const float q = __builtin_bit_cast(float, (j & 1) ? (qw & 0xffff0000u) : (qw << 16)), k = __builtin_bit_cast(float, (j & 1) ? (kw & 0xffff0000u) : (kw << 16));
                    const float dq = fminf(fmaxf(cum - ref, -60.f), 60.f);
                    qh[j] = q * __expf(cum); qt[j] = q * __expf(dq); kt[j] = k * __expf(-dq); kh[j] = k * __expf(last - cum); qg[j] = q * __expf(base8[j] + cum); }
                const int lo = t * KVS + 16 * op;
                *(LAS bf16x8*)(lds + HG_QH + lo) = pack8((f32x4){qh[0], qh[1], qh[2], qh[3]}, (f32x4){qh[4], qh[5], qh[6], qh[7]});
                *(LAS bf16x8*)(lds + HG_QT + lo) = pack8((f32x4){qt[0], qt[1], qt[2], qt[3]}, (f32x4){qt[4], qt[5], qt[6], qt[7]});
                *(LAS bf16x8*)(lds + HG_KT + lo) = pack8((f32x4){kt[0], kt[1], kt[2], kt[3]}, (f32x4){kt[4], kt[5], kt[6], kt[7]});
                *(LAS bf16x8*)(lds + HG_KH + lo) = pack8((f32x4){kh[0], kh[1], kh[2], kh[3]}, (f32x4){kh[4], kh[5], kh[6], kh[7]});
                *(bf16x8*)(QH + (R0 + t) * 512 + hc + 8 * op) = pack8((f32x4){qg[0], qg[1], qg[2], qg[3]}, (f32x4){qg[4], qg[5], qg[6], qg[7]}); }
#pragma unroll
            for (int j = 0; j < 8; ++j) base8[j] += j < 4 ? la0[j] : la1[j - 4];
        }
        __syncthreads();
        f32x4 at[4][4];
#pragma unroll
        for (int tt = 0; tt < 4; ++tt) {
            const bf16x8 qa = *(LAS const bf16x8*)(lds + HG_QT + (16 * tt + c) * KVS + 16 * q4), qb = *(LAS const bf16x8*)(lds + HG_QT + (16 * tt + c) * KVS + 64 + 16 * q4);
#pragma unroll
            for (int st = 0; st < 4; ++st) {
                if (st <= tt) {
                    const bf16x8 ka = *(LAS const bf16x8*)(lds + HG_KT + (16 * st + c) * KVS + 16 * q4), kb = *(LAS const bf16x8*)(lds + HG_KT + (16 * st + c) * KVS + 64 + 16 * q4);
                    f32x4 a = mfma16(kb, qb, mfma16(ka, qa, (f32x4){0.f, 0.f, 0.f, 0.f}));
                    if (st == tt) {
#pragma unroll
                        for (int i = 0; i < 4; ++i) a[i] = (4 * q4 + i <= c) ? a[i] : 0.f; }
                    at[st][tt] = a;
                } else at[st][tt] = (f32x4){0.f, 0.f, 0.f, 0.f};
            }
        }
        const int vrow = 4 * q4 + (c >> 2), vcol = 8 * (c & 3);
        f32x4 o[4];
#pragma unroll
        for (int tt = 0; tt < 4; ++tt) o[tt] = (f32x4){0.f, 0.f, 0.f, 0.f};
#pragma unroll
        for (int s2 = 0; s2 < 2; ++s2) {
            const bf16x8 vf = cat44(ldtr(lds + HG_V + (32 * s2 + vrow) * KVS + 32 * we + vcol), ldtr(lds + HG_V + (32 * s2 + 16 + vrow) * KVS + 32 * we + vcol));
#pragma unroll
            for (int tt = 0; tt < 4; ++tt) if (2 * s2 <= tt) o[tt] = mfma16(vf, pack8(at[2 * s2][tt], at[2 * s2 + 1][tt]), o[tt]);
        }
#pragma unroll
        for (int ks = 0; ks < 2; ++ks) {
            const bf16x8 sf = pack8(S[2 * ks], S[2 * ks + 1]);
#pragma unroll
            for (int tt = 0; tt < 4; ++tt) {
                const bf16x8 qh = cat44(*(LAS const bf16x4*)(lds + HG_QH + (16 * tt + c) * KVS + 64 * ks + 8 * q4), *(LAS const bf16x4*)(lds + HG_QH + (16 * tt + c) * KVS + 64 * ks + 32 + 8 * q4));
                o[tt] = mfma16(sf, qh, o[tt]);
            }
        }
#pragma unroll
        for (int tt = 0; tt < 4; ++tt) { u32x2 ow; ow.x = cvtpk(o[tt].x, o[tt].y); ow.y = cvtpk(o[tt].z, o[tt].w); *(u32x2*)(OLOC + (R0 + 16 * tt + c) * 512 + hc + 16 * we + 4 * q4) = ow; }
        const int srow = 8 * q4 + (c >> 2);
#pragma unroll
        for (int dt = 0; dt < 4; ++dt) { const f32x4 dec = *(LAS const f32x4*)(LASTE + 16 * dt + 4 * q4); S[dt] = S[dt] * dec; }
#pragma unroll
        for (int s2 = 0; s2 < 2; ++s2) {
            const bf16x8 vb = cat44(ldtr(lds + HG_V + (32 * s2 + srow) * KVS + 32 * we + vcol), ldtr(lds + HG_V + (32 * s2 + 4 + srow) * KVS + 32 * we + vcol));
#pragma unroll
            for (int dt = 0; dt < 4; ++dt) {
                const bf16x8 ka = cat44(ldtr(lds + HG_KH + (32 * s2 + srow) * KVS + 32 * dt + vcol), ldtr(lds + HG_KH + (32 * s2 + 4 + srow) * KVS + 32 * dt + vcol));
                S[dt] = mfma16(ka, vb, S[dt]);
            }
        }
        __syncthreads();
    }
    float* TS = (float*)(ws + WS_TSC) + (size_t)unit * 4096;
#pragma unroll
    for (int dt = 0; dt < 4; ++dt)
#pragma unroll
        for (int i = 0; i < 4; ++i) TS[(16 * dt + 4 * q4 + i) * 64 + 16 * we + c] = S[dt][i];
    if (otb == 0) {
#pragma unroll
        for (int j = 0; j < 8; ++j) ((float*)(ws + WS_DSC))[unit * 64 + 8 * op + j] = __expf(base8[j]); }
#undef HG_PREFETCH
}

__device__ __forceinline__ void hgrn_combine_unit(LAS unsigned char* lds, unsigned char* ws, float* out, const float* rnn_gain, int unit, int tid) {
    const int lane = tid & 63, w = __builtin_amdgcn_readfirstlane(tid >> 6), c = lane & 15, q4 = lane >> 4;
    const int b = unit >> 7, h = (unit >> 4) & 7, sc = unit & 15, hc = 64 * h;
    const size_t T0 = (size_t)b * SEQ + 256 * sc;
    const float* TSC = (const float*)(ws + WS_TSC); const float* DSC = (const float*)(ws + WS_DSC);
    {
        const int d = tid >> 3, e0 = 8 * (tid & 7);
        f32x4 c0 = (f32x4){0.f, 0.f, 0.f, 0.f}, c1 = c0;
        for (int j0 = 0; j0 < sc; j0 += 8) {
            float dj[8]; f32x4 ta[8], tb[8];
#pragma unroll
            for (int q = 0; q < 8; ++q) { const int j = j0 + q < sc ? j0 + q : sc - 1; const int u = unit - sc + j; dj[q] = DSC[u * 64 + d]; const float* tp = TSC + (size_t)u * 4096 + d * 64 + e0; ta[q] = *(const f32x4*)tp; tb[q] = *(const f32x4*)(tp + 4); }
#pragma unroll
            for (int q = 0; q < 8; ++q) if (j0 + q < sc) { c0 = c0 * dj[q] + ta[q]; c1 = c1 * dj[q] + tb[q]; }
        }
        if (sc == 15) { const float dj = DSC[unit * 64 + d]; const float* tp = TSC + (size_t)unit * 4096 + d * 64 + e0; float* op = out + O_RNNP + (size_t)(b * 8 + h) * 4096 + d * 64 + e0;
            *(f32x4*)op = c0 * dj + *(const f32x4*)tp; *(f32x4*)(op + 4) = c1 * dj + *(const f32x4*)(tp + 4); }
        LAS unsigned short* CT = (LAS unsigned short*)lds;
#pragma unroll
        for (int i = 0; i < 4; ++i) { CT[(e0 + i) * (KVS / 2) + d] = (unsigned short)(cvtpk(c0[i], 0.f) & 0xffffu); CT[(e0 + 4 + i) * (KVS / 2) + d] = (unsigned short)(cvtpk(c1[i], 0.f) & 0xffffu); }
    }
    __syncthreads();
    const bf16* QH = (const bf16*)(ws + WS_QH); const bf16* OLOC = (const bf16*)(ws + WS_OLOC); const bf16* RG = (const bf16*)(ws + WS_RG); bf16* OA = (bf16*)(ws + WS_OA);
    bf16x8 ctf[4][2];
#pragma unroll
    for (int et = 0; et < 4; ++et)
#pragma unroll
        for (int ks = 0; ks < 2; ++ks) ctf[et][ks] = *(LAS const bf16x8*)(lds + (16 * et + c) * KVS + 64 * ks + 16 * q4);
    bf16x8 qh0[2], qh1[2]; u32x2 olw[2][4], rgw[2][4];
#pragma unroll
    for (int tt = 0; tt < 2; ++tt) { const size_t row = T0 + 32 * w + 16 * tt + c;
        qh0[tt] = *(const bf16x8*)(QH + row * 512 + hc + 8 * q4); qh1[tt] = *(const bf16x8*)(QH + row * 512 + hc + 32 + 8 * q4);
#pragma unroll
        for (int et = 0; et < 4; ++et) { olw[tt][et] = *(const u32x2*)(OLOC + row * 512 + hc + 16 * et + 4 * q4); rgw[tt][et] = *(const u32x2*)(RG + row * 512 + hc + 16 * et + 4 * q4); } }
    f32x4 gnv[4];
#pragma unroll
    for (int et = 0; et < 4; ++et) gnv[et] = *(const f32x4*)(rnn_gain + hc + 16 * et + 4 * q4);
#pragma unroll
    for (int tt = 0; tt < 2; ++tt) {
        const size_t row = T0 + 32 * w + 16 * tt + c;
        f32x4 o[4]; float ss = 0.f;
#pragma unroll
        for (int et = 0; et < 4; ++et) { const u32x2 lw = olw[tt][et];
            const f32x4 ol = (f32x4){__builtin_bit_cast(float, lw.x << 16), __builtin_bit_cast(float, lw.x & 0xffff0000u), __builtin_bit_cast(float, lw.y << 16), __builtin_bit_cast(float, lw.y & 0xffff0000u)};
            o[et] = mfma16(ctf[et][1], qh1[tt], mfma16(ctf[et][0], qh0[tt], ol));
            ss += (o[et].x * o[et].x + o[et].y * o[et].y) + (o[et].z * o[et].z + o[et].w * o[et].w); }
        ss += __shfl_xor(ss, 16); ss += __shfl_xor(ss, 32);
        const float rs = __builtin_amdgcn_rsqf(ss * (1.f / 64.f) + EPS);
#pragma unroll
        for (int et = 0; et < 4; ++et) { const int col = hc + 16 * et + 4 * q4; const u32x2 gw = rgw[tt][et];
            const f32x4 gg = (f32x4){__builtin_bit_cast(float, gw.x << 16), __builtin_bit_cast(float, gw.x & 0xffff0000u), __builtin_bit_cast(float, gw.y << 16), __builtin_bit_cast(float, gw.y & 0xffff0000u)};
            const f32x4 v = o[et] * rs * gnv[et] * gg;
            u32x2 wv; wv.x = cvtpk(v.x, v.y); wv.y = cvtpk(v.z, v.w); *(u32x2*)(OA + row * 1024 + 512 + col) = wv; }
    }
    __syncthreads();
}

__device__ __forceinline__ void rnn_sample_wave(unsigned char* ws, float* out, const float* state_rnn, const float* rnn_gain, int bh, int lane) {
    const int b = bh >> 3, h = bh & 7, hc = 64 * h;
    const float* sp = state_rnn + (size_t)bh * 4096 + lane; float* op = out + O_RNNS + (size_t)bh * 4096 + lane;
    float S[64];
#pragma unroll
    for (int d = 0; d < 64; ++d) S[d] = __builtin_nontemporal_load(sp + d * 64);
    const bf16* RQ = (const bf16*)(ws + WS_RQ); const bf16* RK = (const bf16*)(ws + WS_RK); const bf16* RV = (const bf16*)(ws + WS_RV); const bf16* RG = (const bf16*)(ws + WS_RG);
    const float* GL = (const float*)(ws + WS_GL); bf16* OA = (bf16*)(ws + WS_OA);
    float f8[DECT], k8[DECT], q8[DECT], v8[DECT], g8[DECT];
#pragma unroll
    for (int t = 0; t < DECT; ++t) { const size_t gi = ((size_t)MP + b * DECT + t) * 512 + hc + lane; f8[t] = GL[gi]; k8[t] = bf2f(RK[gi]); q8[t] = bf2f(RQ[gi]); v8[t] = bf2f(RV[gi]); g8[t] = bf2f(RG[gi]); }
    const float gn = rnn_gain[hc + lane];
#pragma unroll
    for (int t = 0; t < DECT; ++t) {
        const float f = __expf(f8[t]), k = k8[t], q = q8[t], v = v8[t];
        float o = 0.f;
#pragma unroll
        for (int d = 0; d < 64; ++d) { const float fd = __builtin_bit_cast(float, __builtin_amdgcn_readlane(__builtin_bit_cast(int, f), d)), kd = __builtin_bit_cast(float, __builtin_amdgcn_readlane(__builtin_bit_cast(int, k), d)),
                qd = __builtin_bit_cast(float, __builtin_amdgcn_readlane(__builtin_bit_cast(int, q), d)); S[d] = fd * S[d] + kd * v; o += qd * S[d]; }
        const float rs = __builtin_amdgcn_rsqf(wave_sum(o * o) * (1.f / 64.f) + EPS);
        const float y = o * rs * gn * g8[t];
        OA[((size_t)MP + b * DECT + t) * 1024 + 512 + hc + lane] = (unsigned short)(cvtpk(y, 0.f) & 0xffffu);
    }
#pragma unroll
    for (int d = 0; d < 64; ++d) __builtin_nontemporal_store(S[d], op + d * 64);
}


template <int RS, bool WINDOW>
__device__ __forceinline__ void samp_tile_f32(AttnSt& st, const bf16x8 (&qf)[2][2], const float* kp, int kpos0, int qpos, float sl0, float sl1, bool blocksel, LAS unsigned char* Vw, int lane, int c, int q4, float* cpy = nullptr, int row0 = 0) {
    f32x4 s[2][4];
    const float* vb = kp + (size_t)(lane >> 4) * RS + 128 + 4 * (lane & 15);
    const float* kb = kp + (size_t)c * RS + 8 * q4;
    LAS unsigned char* vd = Vw + (lane >> 4) * KVS + 8 * (lane & 15);
    f32x4 va[4];
#define SAMP_VLOAD(B) _Pragma("unroll") for (int it = 0; it < 4; ++it) va[it] = __builtin_nontemporal_load((const f32x4*)(vb + (size_t)(4 * (B) + it) * 4 * RS))
#define SAMP_VSTORE(B) _Pragma("unroll") for (int it = 0; it < 4; ++it) { u32x2 wv; wv.x = cvtpk(va[it].x, va[it].y); wv.y = cvtpk(va[it].z, va[it].w); *(LAS u32x2*)(vd + (4 * (B) + it) * 4 * KVS) = wv; \
        if (WINDOW && cpy) { const int r_ = row0 + 4 * (4 * (B) + it) + (lane >> 4) - 8; if (r_ >= 0) __builtin_nontemporal_store(va[it], (f32x4*)(cpy + (size_t)r_ * 256 + 128 + 4 * (lane & 15))); } }
#pragma unroll
    for (int kt4 = 0; kt4 < 4; ++kt4) {
        SAMP_VLOAD(kt4);
        f32x4 kl[2][2];
#pragma unroll
        for (int ks = 0; ks < 2; ++ks) { const float* p = kb + (size_t)(16 * kt4) * RS + 32 * ks; kl[ks][0] = __builtin_nontemporal_load((const f32x4*)p); kl[ks][1] = __builtin_nontemporal_load((const f32x4*)(p + 4)); }
        const bf16x8 k0 = pack8(kl[0][0], kl[0][1]), k1 = pack8(kl[1][0], kl[1][1]);
        if (WINDOW && cpy) { const int r_ = row0 + 16 * kt4 + c - 8; if (r_ >= 0) { float* d_ = cpy + (size_t)r_ * 256 + 8 * q4; __builtin_nontemporal_store(kl[0][0], (f32x4*)d_); __builtin_nontemporal_store(kl[0][1], (f32x4*)(d_ + 4)); __builtin_nontemporal_store(kl[1][0], (f32x4*)(d_ + 32)); __builtin_nontemporal_store(kl[1][1], (f32x4*)(d_ + 36)); } }
#pragma unroll
        for (int qt2 = 0; qt2 < 2; ++qt2) s[qt2][kt4] = mfma16(k1, qf[qt2][1], mfma16(k0, qf[qt2][0], (f32x4){0.f, 0.f, 0.f, 0.f}));
        SAMP_VSTORE(kt4);
        asm volatile("" ::: "memory");
    }
#undef SAMP_VLOAD
#undef SAMP_VSTORE
#pragma unroll
    for (int qt2 = 0; qt2 < 2; ++qt2)
#pragma unroll
        for (int kt4 = 0; kt4 < 4; ++kt4)
#pragma unroll
            for (int e = 0; e < 4; ++e) { const int dist = qpos - (kpos0 + 16 * kt4 + 4 * q4 + e);
                const bool ok = WINDOW ? (dist >= 0 && dist < 512) : (blocksel && dist >= 0);
                s[qt2][kt4][e] = ok ? s[qt2][kt4][e] * SL2 - (qt2 ? sl1 : sl0) * (float)dist - MFIX : -__builtin_inff(); }
    attn_update_fixed<true>(st, s, Vw, c, q4);
}
__device__ __forceinline__ void samp_tile_new(AttnSt& st, const bf16x8 (&qf)[2][2], const bf16* base  , int ti, float sl0, float sl1, bool blocksel, LAS unsigned char* Vw, int lane, int c, int q4) {
    bf16x8 kf[2]; const bf16x8 z8 = (bf16x8){0, 0, 0, 0, 0, 0, 0, 0};
#pragma unroll
    for (int ks = 0; ks < 2; ++ks) kf[ks] = (c < 8) ? *(const bf16x8*)(base + (size_t)c * 256 + 32 * ks + 8 * q4) : z8;
#pragma unroll
    for (int it = 0; it < 8; ++it) { const int idx = it * 64 + lane, row = idx >> 3, pc = idx & 7;
        const u32x4 v = (row < 8) ? *(const u32x4*)(base + (size_t)row * 256 + 128 + 8 * pc) : (u32x4){0u, 0u, 0u, 0u};
        *(LAS u32x4*)(Vw + row * KVS + 16 * pc) = v; }
    f32x4 s[2][4];
#pragma unroll
    for (int qt2 = 0; qt2 < 2; ++qt2) { s[qt2][0] = mfma16(kf[1], qf[qt2][1], mfma16(kf[0], qf[qt2][0], (f32x4){0.f, 0.f, 0.f, 0.f}));
#pragma unroll
        for (int kt4 = 1; kt4 < 4; ++kt4) s[qt2][kt4] = (f32x4){-__builtin_inff(), -__builtin_inff(), -__builtin_inff(), -__builtin_inff()};
#pragma unroll
        for (int e = 0; e < 4; ++e) { const int key = 4 * q4 + e, dist = ti - key;
            const bool ok = key < 8 && dist >= 0 && blocksel;
            s[qt2][0][e] = ok ? s[qt2][0][e] * SL2 - (qt2 ? sl1 : sl0) * (float)dist - MFIX : -__builtin_inff(); } }
    attn_update_fixed<true>(st, s, Vw, c, q4);
}

constexpr int SA_V = 0, SA_PART = 8 * KVT  , SA_ML = SA_PART + 65536, SA_IMP = SA_ML + 2048, SA_SM = SA_IMP + 1024, SA_END = SA_SM + 64;
static_assert(SA_END <= LDS_CTLW, "sample attention LDS");
__device__ __forceinline__ void samp_attn_unit(LAS unsigned char* lds, unsigned char* ws, const float* cache_kv, const float* cache_win, const int* page_table, const float* attn_gain, float* wout, int unit, int tid) {
    const int lane = tid & 63, w = __builtin_amdgcn_readfirstlane(tid >> 6), c = lane & 15, q4 = lane >> 4;
    const int b = unit >> 1, g = unit & 1, ti = c & 7;
    const size_t srow = (size_t)MP + (size_t)b * DECT;
    float slope2[2]; int headq[2];
#pragma unroll
    for (int qt2 = 0; qt2 < 2; ++qt2) { headq[qt2] = 4 * g + 2 * qt2 + (c >> 3); slope2[qt2] = __builtin_amdgcn_exp2f(-(float)(headq[qt2] + 1)) * LOG2E; }
    const int qpos = PAST + ti;
    bf16x8 qf[2][2];
    { const bf16* Q = (const bf16*)(ws + WS_Q);
#pragma unroll
      for (int qt2 = 0; qt2 < 2; ++qt2)
#pragma unroll
          for (int ks = 0; ks < 2; ++ks) qf[qt2][ks] = *(const bf16x8*)(Q + (srow + ti) * 512 + 64 * headq[qt2] + 32 * ks + 8 * q4); }
    LAS unsigned char* Vw = lds + SA_V + w * KVT;
    LAS float* PART = (LAS float*)(lds + SA_PART); LAS float* ML = (LAS float*)(lds + SA_ML); LAS float* IMP = (LAS float*)(lds + SA_IMP);
    LAS unsigned long long* SM = (LAS unsigned long long*)(lds + SA_SM);
    const int frow = tid >> 4, fseg = tid & 15;

    auto write_partial = [&](AttnSt& st) {
#pragma unroll
        for (int qt2 = 0; qt2 < 2; ++qt2) { float l = st.l[qt2]; l += __shfl_xor(l, 16); l += __shfl_xor(l, 32);
            if (q4 == 0) { ML[(w * 32 + 16 * qt2 + c) * 2] = st.m[qt2]; ML[(w * 32 + 16 * qt2 + c) * 2 + 1] = l; }
#pragma unroll
            for (int dt = 0; dt < 4; ++dt) *(LAS f32x4*)(PART + (w * 32 + 16 * qt2 + c) * 64 + 16 * dt + 4 * q4) = st.o[dt][qt2]; }
    };
    auto combine = [&]() -> f32x4 {
        float M = -__builtin_inff();
#pragma unroll
        for (int ww = 0; ww < 8; ++ww) M = fmaxf(M, ML[(ww * 32 + frow) * 2]);
        float L = 0.f; f32x4 o = (f32x4){0.f, 0.f, 0.f, 0.f};
#pragma unroll
        for (int ww = 0; ww < 8; ++ww) { const float mw = ML[(ww * 32 + frow) * 2]; const float wgt = (mw == -__builtin_inff()) ? 0.f : __builtin_amdgcn_exp2f(mw - M);
            L += ML[(ww * 32 + frow) * 2 + 1] * wgt; o = o + *(LAS const f32x4*)(PART + (ww * 32 + frow) * 64 + 4 * fseg) * wgt; }
        return o * (L > 0.f ? 1.0f / L : 0.f);
    };

    f32x4 o_cmp;
    {
        const float* kc = (const float*)(ws + WS_KCMP) + ((size_t)(256 + b * 32) * 2 + g) * 64;
        const float* vc = (const float*)(ws + WS_VCMP) + ((size_t)(256 + b * 32) * 2 + g) * 64;
        bf16x8 kf[2][2];
#pragma unroll
        for (int kt4 = 0; kt4 < 2; ++kt4)
#pragma unroll
            for (int ks = 0; ks < 2; ++ks) { const float* p = kc + (size_t)(16 * kt4 + c) * 128 + 32 * ks + 8 * q4; kf[kt4][ks] = pack8(*(const f32x4*)p, *(const f32x4*)(p + 4)); }
#pragma unroll
        for (int it = 0; it < 16; ++it) { const int idx = it * 64 + lane, row = idx >> 4, pc = idx & 15;
            const f32x4 v = (row < 32) ? *(const f32x4*)(vc + (size_t)row * 128 + 4 * pc) : (f32x4){0.f, 0.f, 0.f, 0.f};
            u32x2 wv; wv.x = cvtpk(v.x, v.y); wv.y = cvtpk(v.z, v.w); *(LAS u32x2*)(Vw + row * KVS + 8 * pc) = wv; }
        f32x4 s[2][4]; AttnSt sc; attn_init(sc);
#pragma unroll
        for (int qt2 = 0; qt2 < 2; ++qt2) { float mx = -__builtin_inff();
#pragma unroll
            for (int kt4 = 0; kt4 < 2; ++kt4) { s[qt2][kt4] = mfma16(kf[kt4][1], qf[qt2][1], mfma16(kf[kt4][0], qf[qt2][0], (f32x4){0.f, 0.f, 0.f, 0.f}));
#pragma unroll
                for (int e = 0; e < 4; ++e) { const int dist = qpos - (64 * (16 * kt4 + 4 * q4 + e) + 63); const float x = s[qt2][kt4][e] * SL2 - slope2[qt2] * (float)dist; s[qt2][kt4][e] = x; mx = fmaxf(mx, x); } }
            s[qt2][2] = (f32x4){0.f, 0.f, 0.f, 0.f}; s[qt2][3] = (f32x4){0.f, 0.f, 0.f, 0.f};
            mx = fmaxf(mx, __shfl_xor(mx, 16)); mx = fmaxf(mx, __shfl_xor(mx, 32)); float ls = 0.f;
#pragma unroll
            for (int kt4 = 0; kt4 < 2; ++kt4)
#pragma unroll
                for (int e = 0; e < 4; ++e) { const float p = __builtin_amdgcn_exp2f(s[qt2][kt4][e] - mx); s[qt2][kt4][e] = p; ls += p; }
            ls += __shfl_xor(ls, 16); ls += __shfl_xor(ls, 32); const float il = 1.0f / ls;
            s[qt2][0] = s[qt2][0] * il; s[qt2][1] = s[qt2][1] * il; }
#pragma unroll
        for (int kt4 = 0; kt4 < 2; ++kt4) { f32x4 a = s[0][kt4] + s[1][kt4];
#pragma unroll
            for (int e = 0; e < 4; ++e) a[e] += __shfl_xor(a[e], 8);
            if (w == 0 && c < 8) *(LAS f32x4*)(IMP + c * 32 + 16 * kt4 + 4 * q4) = a; }
        attn_pv_lean(sc.o, s, Vw, c, q4);
        if (w == 0) {
#pragma unroll
            for (int qt2 = 0; qt2 < 2; ++qt2)
#pragma unroll
                for (int dt = 0; dt < 4; ++dt) *(LAS f32x4*)(PART + (16 * qt2 + c) * 64 + 16 * dt + 4 * q4) = sc.o[dt][qt2]; }
    }
    __syncthreads();
    o_cmp = *(LAS const f32x4*)(PART + frow * 64 + 4 * fseg);
    {
        bool sel = false; const int j = lane;
        if (j == 0 || j == 32) sel = true;
        else if (j < 32) { const float vj = IMP[w * 32 + j]; int cnt = 0;
            for (int i = 1; i < 32; ++i) { const float vi = IMP[w * 32 + i]; cnt += (vi > vj || (vi == vj && i < j)) ? 1 : 0; }
            sel = cnt < 14; }
        const unsigned long long bm = __ballot(sel);
        if (lane == 0) SM[w] = bm;
    }
    __syncthreads();
    const unsigned long long mymask = SM[ti];
    unsigned long long um = 0ull;
#pragma unroll
    for (int i = 0; i < 8; ++i) um |= SM[i];
    um = ((unsigned long long)__builtin_amdgcn_readfirstlane((unsigned)(um >> 32)) << 32) | (unsigned)__builtin_amdgcn_readfirstlane((unsigned)um);
    f32x4 o_win, o_sel;
    {
        AttnSt st; attn_init(st);
        const float* wb = cache_win + (size_t)b * 512 * 256 + 64 * g;
        samp_tile_f32<256, true>(st, qf, wb + (size_t)(64 * w) * 256, PAST - 512 + 64 * w, qpos, slope2[0], slope2[1], true, Vw, lane, c, q4, wout + (size_t)b * 512 * 256 + 64 * g, 64 * w);
        if (w == 0) samp_tile_new(st, qf, (const bf16*)(ws + WS_KW) + srow * 256 + 64 * g, ti, slope2[0], slope2[1], true, Vw, lane, c, q4);
        write_partial(st);
    }
    __syncthreads();
    o_win = combine();
    __syncthreads();
    {
        AttnSt st; attn_init(st);
        unsigned long long rem = um; int idx = 0;
        while (rem) { const int j = __builtin_ctzll(rem); rem &= rem - 1;
            if ((idx & 7) == w) {
                const bool bit = (mymask >> j) & 1ull;
                if (j < 32) { const int page = page_table[b * NPAGES + (j >> 1)];
                    samp_tile_f32<512, false>(st, qf, cache_kv + ((size_t)page * PAGE + (j & 1) * 64) * 512 + 256 + 64 * g, 64 * j, qpos, slope2[0], slope2[1], bit, Vw, lane, c, q4); }
                else samp_tile_new(st, qf, (const bf16*)(ws + WS_KS) + srow * 256 + 64 * g, ti, slope2[0], slope2[1], bit, Vw, lane, c, q4);
            }
            ++idx; }
        write_partial(st);
    }
    __syncthreads();
    o_sel = combine();
    {
        const int qt2 = frow >> 4, cc = frow & 15, head = 4 * g + 2 * qt2 + (cc >> 3); const size_t row = srow + (cc & 7);
        const float* GATES = (const float*)(ws + WS_GATES);
        const float g0 = GATES[row * 24 + head * 3], g1 = GATES[row * 24 + head * 3 + 1], g2 = GATES[row * 24 + head * 3 + 2];
        const f32x4 oa = o_cmp * g0 + o_sel * g1 + o_win * g2;
        float ss = (oa.x * oa.x + oa.y * oa.y) + (oa.z * oa.z + oa.w * oa.w);
        ss += __shfl_xor(ss, 1); ss += __shfl_xor(ss, 2); ss += __shfl_xor(ss, 4); ss += __shfl_xor(ss, 8);
        const float rs = 1.0f / sqrtf(ss * (1.f / 64.f) + EPS);
        const f32x4 v = oa * rs * *(const f32x4*)(attn_gain + 64 * head + 4 * fseg);
        u32x2 wv; wv.x = cvtpk(v.x, v.y); wv.y = cvtpk(v.z, v.w); *(u32x2*)((bf16*)(ws + WS_OA) + row * 1024 + 64 * head + 4 * fseg) = wv;
    }
    __syncthreads();
}

#define EPI_ROWS _Pragma("unroll") for (int ai = 0; ai < 2; ++ai) _Pragma("unroll") for (int m = 0; m < 4; ++m)
#define EPI_COLS _Pragma("unroll") for (int bj = 0; bj < 2; ++bj) _Pragma("unroll") for (int n = 0; n < 2; ++n)
struct EpiOut {
    unsigned char* ws; const float *xp, *xs;
    __device__ __forceinline__ void operator()(const f32x4 (&acc)[2][2][4][2], const pg8::Unit& u, int wr, int wc, int fr, int fq) const {
        const int rowb = u.pm * 256 + wr * 64 + fr, colb = u.pn * 256 + 32 * wc + 8 * fq;
        bf16* const HB = (bf16*)(ws + WS_XN); float* const ssq = (float*)(ws + CTL_SSQ);
        EPI_ROWS { const int row = rowb + 128 * ai + 16 * m; const float* xr = (row < MP) ? xp + (size_t)row * DM : xs + (size_t)(row - MP) * DM; float ss = 0.f;
#pragma unroll
            for (int bj = 0; bj < 2; ++bj) { const int col = colb + 128 * bj;
                const f32x4 h0 = acc[ai][bj][m][0] + __builtin_nontemporal_load((const f32x4*)(xr + col)), h1 = acc[ai][bj][m][1] + __builtin_nontemporal_load((const f32x4*)(xr + col + 4));
                ss += (h0.x * h0.x + h0.y * h0.y) + (h0.z * h0.z + h0.w * h0.w) + (h1.x * h1.x + h1.y * h1.y) + (h1.z * h1.z + h1.w * h1.w);
                u32x4 w; w.x = cvtpk(h0.x, h0.y); w.y = cvtpk(h0.z, h0.w); w.z = cvtpk(h1.x, h1.y); w.w = cvtpk(h1.z, h1.w); *(u32x4*)(HB + (size_t)row * DM + col) = w; }
            ss += __shfl_xor(ss, 16); ss += __shfl_xor(ss, 32);
            if (fq == 0) atomicAdd(ssq + row, ss); }
    }
};
struct EpiUp {
    unsigned char* ws;
    __device__ __forceinline__ void operator()(const f32x4 (&acc)[2][2][4][2], const pg8::Unit& u, int wr, int wc, int fr, int fq) const {
        const int rowb = u.pm * 256 + wr * 64 + fr, colb = u.pn * 256 + 32 * wc + 8 * fq;
        bf16* const U = (bf16*)(ws + WS_U);
        EPI_ROWS { const int row = rowb + 128 * ai + 16 * m;
#pragma unroll
            for (int bj = 0; bj < 2; ++bj) { f32x4 v0 = acc[ai][bj][m][0], v1 = acc[ai][bj][m][1];
                v0.x = fmaxf(v0.x, 0.f); v0.y = fmaxf(v0.y, 0.f); v0.z = fmaxf(v0.z, 0.f); v0.w = fmaxf(v0.w, 0.f); v0 = v0 * v0;
                v1.x = fmaxf(v1.x, 0.f); v1.y = fmaxf(v1.y, 0.f); v1.z = fmaxf(v1.z, 0.f); v1.w = fmaxf(v1.w, 0.f); v1 = v1 * v1;
                u32x4 w; w.x = cvtpk(v0.x, v0.y); w.y = cvtpk(v0.z, v0.w); w.z = cvtpk(v1.x, v1.y); w.w = cvtpk(v1.z, v1.w);
                *(u32x4*)(U + (size_t)row * DFF + colb + 128 * bj) = w; } }
    }
};
struct EpiDown {
    float* out; unsigned char* ws;
    __device__ __forceinline__ void operator()(const f32x4 (&acc)[2][2][4][2], const pg8::Unit& u, int wr, int wc, int fr, int fq) const {
        const int rowb = u.pm * 256 + wr * 64 + fr, colb = u.pn * 256 + 32 * wc + 8 * fq;
        const bf16* const HB = (const bf16*)(ws + WS_XN); const float* const ssq = (const float*)(ws + CTL_SSQ);
        EPI_ROWS { const int row = rowb + 128 * ai + 16 * m; const float rs2 = __builtin_amdgcn_rcpf(ssq[row] * (1.f / DM) + EPS);
#pragma unroll
            for (int bj = 0; bj < 2; ++bj) { const size_t o = (size_t)row * DM + colb + 128 * bj; const u32x4 hw = *(const u32x4*)(HB + o);
                const f32x4 h0 = (f32x4){__builtin_bit_cast(float, hw.x << 16), __builtin_bit_cast(float, hw.x & 0xffff0000u), __builtin_bit_cast(float, hw.y << 16), __builtin_bit_cast(float, hw.y & 0xffff0000u)};
                const f32x4 h1 = (f32x4){__builtin_bit_cast(float, hw.z << 16), __builtin_bit_cast(float, hw.z & 0xffff0000u), __builtin_bit_cast(float, hw.w << 16), __builtin_bit_cast(float, hw.w & 0xffff0000u)};
                __builtin_nontemporal_store(h0 + acc[ai][bj][m][0] * rs2, (f32x4*)(out + o)); __builtin_nontemporal_store(h1 + acc[ai][bj][m][1] * rs2, (f32x4*)(out + o + 4)); } }
    }
};
#undef EPI_ROWS
#undef EPI_COLS

template <int TN, int NH, int KS, class Epi>
__device__ __forceinline__ void small_gemm_tile(LAS unsigned char* lds, const bf16* A, int lda, const bf16* Bt, int ldb, int K, int row0, int col0, const Epi& E, int tid) {
    constexpr int WN = TN / NH / 16, PRS = (TN + 4) * 4;
    static_assert(NH * KS == 8 && KS * 64 * PRS <= LDS_CTLW, "small gemm geometry");
    const int lane = tid & 63, w = __builtin_amdgcn_readfirstlane(tid >> 6), nh = w % NH, ks = w / NH, fr = lane & 15, fq = lane >> 4;
    const int Kw = K / KS;
    const bf16* ap = A + (size_t)(row0 + fr) * lda + (size_t)ks * Kw + 8 * fq;
    const bf16* bp = Bt + (size_t)(col0 + 16 * WN * nh + fr) * ldb + (size_t)ks * Kw + 8 * fq;
    f32x4 acc[4][WN];
#pragma unroll
    for (int mt = 0; mt < 4; ++mt)
#pragma unroll
        for (int nt = 0; nt < WN; ++nt) acc[mt][nt] = (f32x4){0.f, 0.f, 0.f, 0.f};
    bf16x8 a0[2][4], b0[2][WN], a1[2][4], b1[2][WN];
#define SG_LOAD(A_, B_, kk) do { _Pragma("unroll") for (int u = 0; u < 2; ++u) { \
        _Pragma("unroll") for (int mt = 0; mt < 4; ++mt) A_[u][mt] = *(const bf16x8*)(ap + (size_t)(16 * mt) * lda + (kk) + 32 * u); \
        _Pragma("unroll") for (int nt = 0; nt < WN; ++nt) B_[u][nt] = *(const bf16x8*)(bp + (size_t)(16 * nt) * ldb + (kk) + 32 * u); } } while (0)
#define SG_MMA(A_, B_) do { _Pragma("unroll") for (int u = 0; u < 2; ++u) _Pragma("unroll") for (int mt = 0; mt < 4; ++mt) _Pragma("unroll") for (int nt = 0; nt < WN; ++nt) \
        acc[mt][nt] = mfma16(B_[u][nt], A_[u][mt], acc[mt][nt]); } while (0)
    SG_LOAD(a0, b0, 0);
    for (int k = 0; k < Kw; k += 128) {
        SG_LOAD(a1, b1, k + 64);
        SG_MMA(a0, b0);
        if (k + 128 < Kw) SG_LOAD(a0, b0, k + 128);
        SG_MMA(a1, b1);
    }
#undef SG_LOAD
#undef SG_MMA
    {
        LAS unsigned char* P = lds + ks * 64 * PRS + fr * PRS + (16 * WN * nh + 4 * fq) * 4;
#pragma unroll
        for (int mt = 0; mt < 4; ++mt)
#pragma unroll
            for (int nt = 0; nt < WN; ++nt) *(LAS f32x4*)(P + 16 * mt * PRS + 64 * nt) = acc[mt][nt];
    }
    __syncthreads();
    constexpr int C4 = TN / 4, ITEMS = 64 * C4;
#pragma unroll
    for (int rep = 0; rep < ITEMS / 512; ++rep) {
        const int id = rep * 512 + tid, r = id / C4, c4 = id % C4;
        f32x4 v = *(LAS const f32x4*)(lds + r * PRS + 16 * c4);
#pragma unroll
        for (int k2 = 1; k2 < KS; ++k2) v = v + *(LAS const f32x4*)(lds + k2 * 64 * PRS + r * PRS + 16 * c4);
        E.template run<C4>(v, row0 + r, col0 + 4 * c4);
    }
    __syncthreads();
}
struct SEpiOut {
    unsigned char* ws; const float* xs;
    template <int C4> __device__ __forceinline__ void run(const f32x4 v, int r, int cc) const {
        bf16* const HB = (bf16*)(ws + WS_XN); float* const ssq = (float*)(ws + CTL_SSQ);
        const int lc = (cc & ~31) + 8 * ((cc >> 2) & 3) + 4 * ((cc >> 4) & 1);
        const f32x4 h = v + *(const f32x4*)(xs + (size_t)(r - MP) * DM + lc);
        float ss = (h.x * h.x + h.y * h.y) + (h.z * h.z + h.w * h.w);
        u32x2 wv; wv.x = cvtpk(h.x, h.y); wv.y = cvtpk(h.z, h.w); *(u32x2*)(HB + (size_t)r * DM + lc) = wv;
#pragma unroll
        for (int o = 1; o < C4; o <<= 1) ss += __shfl_xor(ss, o);
        if ((threadIdx.x & (C4 - 1)) == 0) atomicAdd(ssq + r, ss);
    }
};
struct SEpiUp {
    unsigned char* ws;
    template <int C4> __device__ __forceinline__ void run(f32x4 v, int r, int cc) const {
        bf16* const U = (bf16*)(ws + WS_U);
        const int lc = (cc & ~31) + 8 * ((cc >> 2) & 3) + 4 * ((cc >> 4) & 1);
        v.x = fmaxf(v.x, 0.f); v.y = fmaxf(v.y, 0.f); v.z = fmaxf(v.z, 0.f); v.w = fmaxf(v.w, 0.f); v = v * v;
        u32x2 wv; wv.x = cvtpk(v.x, v.y); wv.y = cvtpk(v.z, v.w); *(u32x2*)(U + (size_t)r * DFF + lc) = wv;
    }
};
struct SEpiDown {
    float* out; unsigned char* ws;
    template <int C4> __device__ __forceinline__ void run(const f32x4 v, int r, int cc) const { const int lc = (cc & ~31) + 8 * ((cc >> 2) & 3) + 4 * ((cc >> 4) & 1); const size_t o = (size_t)r * DM + lc; const u32x2 hw = *(const u32x2*)((const bf16*)(ws + WS_XN) + o);
        const f32x4 h = (f32x4){__builtin_bit_cast(float, hw.x << 16), __builtin_bit_cast(float, hw.x & 0xffff0000u), __builtin_bit_cast(float, hw.y << 16), __builtin_bit_cast(float, hw.y & 0xffff0000u)};
        const float rs2 = __builtin_amdgcn_rcpf(((const float*)(ws + CTL_SSQ))[r] * (1.f / DM) + EPS);
        *(f32x4*)(out + o) = h + v * rs2; }
};

#ifdef MK_DEBUG
constexpr size_t CTL_DBG = 256 * 1024;
__device__ __forceinline__ void dbg_report(unsigned char* ws, float num, float den) { if (!(num >= 0.f)) num = 1e30f; atomicAdd((float*)(ws + CTL_DBG), num); atomicAdd((float*)(ws + CTL_DBG) + 1, den); }
__global__ void dbg_final(Args a) { const float n = *(const float*)(a.ws + CTL_DBG), d = *((const float*)(a.ws + CTL_DBG) + 1); a.out[O_RNNP] = 100.f + 1e7f * (n / (d + 1e-30f)); }
__global__ void __launch_bounds__(256) dbg_check_p1(Args a) {
    __shared__ float xs[1024]; __shared__ float z[3352]; __shared__ float red[256];
    const int nsamp = gridDim.x; const int tid = threadIdx.x;
    const int row = (int)(((long)blockIdx.x * 7919 * 131 + 37 * blockIdx.x) % MT);
    const float* x = row < MP ? a.in[0] + (size_t)row * DM : a.in[1] + (size_t)(row - MP) * DM;
    float ss = 0.f; for (int i = tid; i < 1024; i += 256) { const float v = x[i]; ss += v * v; }
    red[tid] = ss; __syncthreads(); for (int o = 128; o > 0; o >>= 1) { if (tid < o) red[tid] += red[tid + o]; __syncthreads(); }
    const float rs = 1.0f / sqrtf(red[0] / 1024.f + EPS);
    for (int i = tid; i < 1024; i += 256) xs[i] = x[i] * rs * a.in[6][i];
    __syncthreads();
    const float* w = a.in[7];
    for (int c = tid; c < 3352; c += 256) { float acc = 0.f; for (int k = 0; k < 1024; ++k) acc += xs[k] * w[(size_t)k * 3352 + c]; z[c] = acc; }
    __syncthreads();
    unsigned char* ws = a.ws; float num = 0.f, den = 0.f;
    auto cmp = [&](float got, float exp) { const float e = got - exp; num += e * e; den += exp * exp; };
    auto headrs = [&](int c0) { float s = 0.f; for (int d = 0; d < 64; ++d) s += z[c0 + d] * z[c0 + d]; return 1.0f / sqrtf(s / 64.f + EPS); };
    const float* kvout = row < MP ? a.out + O_KVP + (size_t)row * 512 : a.out + O_KVS + (size_t)(row - MP) * 512;
    const float* lbp = (const float*)(ws + WS_LB);
    for (int c = tid; c < 3352; c += 256) {
        if (c < 512) { const float r = headrs(c & ~63); cmp(bf2f(((const bf16*)(ws + WS_Q))[(size_t)row * 512 + c]), z[c] * r * a.in[8][c & 63]); }
        else if (c < 768) { cmp(kvout[c - 512], z[c]); if (row < MP) cmp(bf2f(((const bf16*)(ws + WS_KC))[(size_t)row * 256 + c - 512]), z[c] + a.in[10][((c - 512) >> 7) * 4096 + (row & 63) * 64 + (c & 63)]); }
        else if (c < 1024) { float e = z[c]; if (c < 896) e *= headrs(c & ~63) * a.in[9][64 + (c & 63)]; cmp(kvout[c - 512], e); cmp(bf2f(((const bf16*)(ws + WS_KS))[(size_t)row * 256 + c - 768]), e); }
        else if (c < 1280) { float e = z[c]; if (c < 1152) e *= headrs(c & ~63) * a.in[9][128 + (c & 63)]; cmp(bf2f(((const bf16*)(ws + WS_KW))[(size_t)row * 256 + c - 1024]), e);
            if (row >= MP) { const int r_ = row - MP; cmp(a.out[O_WINS + ((size_t)(r_ >> 3) * 512 + 504 + (r_ & 7)) * 256 + c - 1024], e); }
            else if ((row & 4095) >= 3584) cmp(a.out[O_WINP + ((size_t)(row >> 12) * 512 + (row & 4095) - 3584) * 256 + c - 1024], e); }
        else if (c < 1304) cmp(((const float*)(ws + WS_GATES))[(size_t)row * 24 + c - 1280], 1.f / (1.f + expf(-z[c])));
        else if (c < 1816) cmp(bf2f(((const bf16*)(ws + WS_RQ))[(size_t)row * 512 + c - 1304]), z[c] / (1.f + expf(-z[c])));
        else if (c < 2328) { const float l = lbp[c - 1816], f = l + (1.f - l) / (1.f + expf(-z[c])); cmp(((const float*)(ws + WS_GL))[(size_t)row * 512 + c - 1816], logf(f)); cmp(bf2f(((const bf16*)(ws + WS_RK))[(size_t)row * 512 + c - 1816]), 1.f - f); }
        else if (c < 2840) cmp(bf2f(((const bf16*)(ws + WS_RV))[(size_t)row * 512 + c - 2328]), z[c]);
        else cmp(bf2f(((const bf16*)(ws + WS_RG))[(size_t)row * 512 + c - 2840]), z[c] / (1.f + expf(-z[c])));
    }
    if (tid < 512 && blockIdx.x == 0) { const float l0 = a.in[14][tid], l1 = a.in[14][512 + tid]; const float e0 = expf(l0), e1 = expf(l1); cmp(lbp[tid], e0 / (e0 + e1)); if (tid + 256 < 512) { const float m0 = a.in[14][tid + 256], m1 = a.in[14][768 + tid]; cmp(lbp[tid + 256], expf(m0) / (expf(m0) + expf(m1))); } }
    (void)nsamp;
    red[tid] = num; __syncthreads(); for (int o = 128; o > 0; o >>= 1) { if (tid < o) red[tid] += red[tid + o]; __syncthreads(); } num = red[0]; __syncthreads();
    red[tid] = den; __syncthreads(); for (int o = 128; o > 0; o >>= 1) { if (tid < o) red[tid] += red[tid + o]; __syncthreads(); } den = red[0];
    if (tid == 0) dbg_report(ws, num, den);
}
__global__ void __launch_bounds__(256) dbg_check_cmp(Args a, int mode) {
    __shared__ float xin[4096]; __shared__ float hid[128]; __shared__ float outv[64]; __shared__ float red[256];
    const int tid = threadIdx.x; unsigned char* ws = a.ws;
    const int sidx = blockIdx.x; const int kind = sidx & 1, g = (sidx >> 1) & 1; int gb = (int)(((long)(sidx >> 2) * 977 + 13) % 4352);
    if (mode == 3) gb = gb % 256; if (mode == 4) gb = 256 + gb % 4096;
    if ((mode == 5 && kind != 0) || (mode == 6 && kind != 1)) return;
    const float* pe = a.in[10] + kind * 4096;
    for (int i = tid; i < 4096; i += 256) { const int p = i >> 6, d = i & 63; float v;
        if (gb < 256) { const int b = gb >> 6, blk = gb & 63; const int row = b * SEQ + 64 * blk + p; v = (a.out + O_KVP)[(size_t)row * 512 + kind * 128 + g * 64 + d]; }
        else { const int sb = (gb - 256) >> 5, blk = (gb - 256) & 31; const int page = ((const int*)a.in[5])[sb * NPAGES + (blk >> 1)]; v = a.in[2][((size_t)page * PAGE + (blk & 1) * 64 + p) * 512 + kind * 128 + g * 64 + d]; }
        xin[i] = v + pe[p * 64 + d]; }
    __syncthreads();
    if (tid < 128) { const float* w1 = a.in[11] + (size_t)kind * 4096 * 128; float acc = 0.f; for (int k = 0; k < 4096; ++k) acc += xin[k] * w1[(size_t)k * 128 + tid]; hid[tid] = acc / (1.f + expf(-acc)); }
    __syncthreads();
    if (tid < 64) { const float* w2 = a.in[12] + (size_t)kind * 128 * 64; float acc = 0.f; for (int k = 0; k < 128; ++k) acc += hid[k] * w2[k * 64 + tid]; outv[tid] = acc; }
    __syncthreads();
    float num = 0.f, den = 0.f;
    if (tid < 64) { float e = outv[tid];
        if (kind == 0) { float ss = 0.f; for (int d = 0; d < 64; ++d) ss += outv[d] * outv[d]; e = e / sqrtf(ss / 64.f + EPS) * a.in[9][tid]; }
        const float got = ((const float*)(ws + (kind == 0 ? WS_KCMP : WS_VCMP)))[((size_t)gb * 2 + g) * 64 + tid];
        num = (got - e) * (got - e); den = e * e; }
    red[tid] = num; __syncthreads(); for (int o = 128; o > 0; o >>= 1) { if (tid < o) red[tid] += red[tid + o]; __syncthreads(); } num = red[0]; __syncthreads();
    red[tid] = den; __syncthreads(); for (int o = 128; o > 0; o >>= 1) { if (tid < o) red[tid] += red[tid + o]; __syncthreads(); } den = red[0];
    if (tid == 0) dbg_report(ws, num, den);
}
#endif


constexpr int NPHASE = 7;
__global__ void __launch_bounds__(512, 2) mega(Args args) {
    extern __shared__ __attribute__((aligned(16))) unsigned char lds_raw[];
    LAS unsigned char* lds = (LAS unsigned char*)lds_raw;
    const int tid = threadIdx.x, lane = tid & 63, wave = __builtin_amdgcn_readfirstlane(tid >> 6);
    const int G = gridDim.x, bx = blockIdx.x;
    unsigned char* ws = args.ws;
    const int lo = args.ph_lo, hi = args.ph_hi;
#define IN(k) (lo <= (k) && (k) < hi)
#define GRID_BAR_CG() do { cg::this_grid().sync(); } while (0)
#define GRID_BAR() do { xcd_barrier(xbar); } while (0)
    if (tid < 16) ((LAS unsigned*)(lds + LDS_CTLW))[tid] = 0u;
    __syncthreads();
    if (tid == 0) { const unsigned xcc_ = xb_xcc_id(); LAS unsigned* lw_ = (LAS unsigned*)(lds + LDS_CTLW);
        lw_[4] = xcc_; lw_[5] = __hip_atomic_fetch_add((unsigned*)(ws + WS_CTL + CTL_XCEN) + 64 * xcc_, 1u, __ATOMIC_RELAXED, __HIP_MEMORY_SCOPE_AGENT); }
    XcdBarrier xbar; xbar.bar = (unsigned*)(ws + WS_CTL + CTL_BAR); xbar.x = 0; xbar.st = (volatile LAS unsigned*)(lds + LDS_CTLW);
    if (hi - lo > 1) xbar = xcd_barrier_post((unsigned*)(ws + WS_CTL + CTL_BAR), (volatile LAS unsigned*)(lds + LDS_CTLW));

#define STAMP(k) do { if (PROBE_A >= 0 && tid == 0) ((LAS unsigned long long*)(lds + LDS_STAMPS))[k] = __builtin_amdgcn_s_memrealtime(); } while (0)
    STAMP(0);
    if (IN(0)) {
        LAS float* scr = (LAS float*)(lds + wave * 16384);
        const int gw = bx * 8 + wave, NGW = G * 8;
        const float* w_in = args.in[7];
        const float* cw1 = args.in[11]; const float* cw2 = args.in[12];
        const float* xp = args.in[0]; const float* xs = args.in[1]; const float* ln_mix = args.in[6];
        {
#define P0_ROWP(m_) ((const f32x4*)((m_) < MP ? xp + (size_t)(m_) * DM : xs + (size_t)((m_) - MP) * DM) + lane)
#define P0_LOAD(A0, A1, m_) do { const int ma_ = (m_), mb_ = ma_ + NGW < MT ? ma_ + NGW : ma_; const f32x4* x0_ = P0_ROWP(ma_); const f32x4* x1_ = P0_ROWP(mb_); \
            _Pragma("unroll") for (int j = 0; j < 4; ++j) { A0[j] = __builtin_nontemporal_load(x0_ + 64 * j); A1[j] = __builtin_nontemporal_load(x1_ + 64 * j); } } while (0)
            const f32x4* gr = (const f32x4*)ln_mix + lane;
            f32x4 v0[4], v1[4], n0[4], n1[4];
            P0_LOAD(v0, v1, gw);
            for (int m = gw; m < MT; m += 2 * NGW) {
                const int m2 = m + NGW;
                if (m + 2 * NGW < MT) P0_LOAD(n0, n1, m + 2 * NGW);
                float s0 = 0.f, s1 = 0.f;
#pragma unroll
                for (int j = 0; j < 4; ++j) { s0 += (v0[j].x * v0[j].x + v0[j].y * v0[j].y) + (v0[j].z * v0[j].z + v0[j].w * v0[j].w); s1 += (v1[j].x * v1[j].x + v1[j].y * v1[j].y) + (v1[j].z * v1[j].z + v1[j].w * v1[j].w); }
                const float r0 = 1.0f / sqrtf(wave_sum(s0) * (1.f / DM) + EPS), r1 = 1.0f / sqrtf(wave_sum(s1) * (1.f / DM) + EPS);
                u32x2* o0 = (u32x2*)((bf16*)(ws + WS_XN) + (size_t)m * DM) + lane; u32x2* o1 = (u32x2*)((bf16*)(ws + WS_XN) + (size_t)m2 * DM) + lane;
#pragma unroll
                for (int j = 0; j < 4; ++j) { const f32x4 g = gr[64 * j]; u32x2 w0, w1; w0.x = cvtpk(v0[j].x * r0 * g.x, v0[j].y * r0 * g.y); w0.y = cvtpk(v0[j].z * r0 * g.z, v0[j].w * r0 * g.w);
                    w1.x = cvtpk(v1[j].x * r1 * g.x, v1[j].y * r1 * g.y); w1.y = cvtpk(v1[j].z * r1 * g.z, v1[j].w * r1 * g.w); o0[64 * j] = w0; if (m2 < MT) o1[64 * j] = w1; }
#pragma unroll
                for (int j = 0; j < 4; ++j) { v0[j] = n0[j]; v1[j] = n1[j]; }
            }
#undef P0_LOAD
#undef P0_ROWP
        }
        STAMP(25);
        constexpr int I_IN = 16 * 105, I_1 = 64 * 4, I_2 = 2 * 2;
        constexpr int NITEMS = I_IN + 2 * I_1 + 2 * I_2;
        for (int it = gw; it < NITEMS; it += NGW) {
            int r = it;
            if (r < I_IN) { p0_transpose_item<1>(w_in, DM, INW, (bf16*)(ws + WS_WIN), scr, r, lane); continue; } r -= I_IN;
            if (r < 2 * I_1) { const int kv = r / I_1; p0_transpose_item<0>(cw1 + (size_t)kv * 4096 * 128, 4096, 128, (bf16*)(ws + WS_W1) + (size_t)kv * 128 * 4096, scr, r % I_1, lane); continue; } r -= 2 * I_1;
            { const int kv = r / I_2; p0_transpose_item<0>(cw2 + (size_t)kv * 128 * 64, 128, 64, (bf16*)(ws + WS_W2) + (size_t)kv * 64 * 128, scr, r % I_2, lane); }
        }
        STAMP(26);
        if (bx == 0) { const float* lg = args.in[14]; float* lbp = (float*)(ws + WS_LB); const float l0 = lg[tid], l1 = lg[512 + tid]; lbp[tid] = 1.0f / (1.0f + __expf(l1 - l0)); }
        if (hi > 1) GRID_BAR();
        if (tid == 0) { bool ok_ = (G % 8) == 0; LAS unsigned* lw_ = (LAS unsigned*)(lds + LDS_CTLW);
            for (int j = 0; j < 8; ++j) ok_ = ok_ && (__hip_atomic_load((unsigned*)(ws + WS_CTL + CTL_XCEN) + 64 * j, __ATOMIC_RELAXED, __HIP_MEMORY_SCOPE_AGENT) == (unsigned)(G / 8));
            lw_[6] = (ok_ && lw_[4] < 8u) ? (lw_[4] + 8u * lw_[5]) : (unsigned)bx; }
        __syncthreads();
        STAMP(1);
    }
    if (IN(1)) {
        pg8::Gemm g{(const bf16*)(ws + WS_XN), (const bf16*)(ws + WS_WIN), MT, INP, DM};
        const int vcu = (hi - lo > 1) ? (int)__builtin_amdgcn_readfirstlane(((LAS unsigned*)(lds + LDS_CTLW))[6]) : bx;
        pg8::StaticOrder S; S.init(MT, INP, G, vcu);
        EpiIn E{args.out, ws, args.in[8], args.in[9], args.in[10]};
#define WCV_QUEUE(MAXN) do { constexpr int N_WCV = (16 * 32 + 16 * 128 + 64 * 32) / 8, I_O = 16 * 32, I_U = 16 * 128; \
            unsigned* qc = (unsigned*)(ws + WS_CTL + CTL_Q) + 128; LAS int* qslot = (LAS int*)(lds + LDS_CTLW + 32); \
            for (int n_ = 0; n_ < (MAXN); ++n_) { \
                if (tid == 0) *qslot = (int)atomicAdd(qc, 1u); \
                __syncthreads(); \
                const int it = __builtin_amdgcn_readfirstlane(*qslot); \
                __syncthreads(); \
                if (it >= N_WCV) break; \
                int t_ = tid; asm volatile("" : "+v"(t_)); \
                const int r = it * 8 + __builtin_amdgcn_readfirstlane(t_ >> 6); \
                LAS float* scr = (LAS float*)(lds + __builtin_amdgcn_readfirstlane(t_ >> 6) * 16384); \
                if (r < I_O) p0_transpose_item<3>(args.in[16], DM, DM, (bf16*)(ws + WS_WO), scr, r, t_ & 63); \
                else if (r < I_O + I_U) p0_transpose_item<3>(args.in[18], DM, DFF, (bf16*)(ws + WS_WU), scr, r - I_O, t_ & 63, args.in[17]);     \
                else p0_transpose_item<3>(args.in[19], DFF, DM, (bf16*)(ws + WS_WD), scr, r - I_O - I_U, t_ & 63); \
            } \
            __syncthreads();     \
            } while (0)
        {   const int nwg = (MT / 256) * (INP / 256), rounds = (nwg + G - 1) / G;
            if ((long)(rounds - 1) * G + vcu >= nwg) WCV_QUEUE(8); }
        pg8::gemm_phase<EpiIn, true>(lds, g, S, E);
        WCV_QUEUE(1 << 30);
#undef WCV_QUEUE
        if (hi > 2) GRID_BAR();
        STAMP(2);
    }
    if (IN(2)) {
        constexpr int N_CMP = N_CMP_ITEMS, N_HG = 256, N_WIN = 512, N_RNN = 0, N_CPY = 0, N2 = N_CMP + N_HG + N_WIN + N_RNN + N_CPY;
        unsigned* qc = (unsigned*)(ws + WS_CTL + CTL_Q); LAS int* qslot = (LAS int*)(lds + LDS_CTLW + 32);
        if (bx == PROBE_BLK) { STAMP(14); STAMP(8); STAMP(9); STAMP(10); STAMP(11); STAMP(12); STAMP(13); }
        for (int rep = 0; rep < REP_P2; ++rep)
        for (int seq = 0;; ++seq) {
            if (tid == 0) *qslot = (int)atomicAdd(qc, 1u);
            __syncthreads();
            const int it = __builtin_amdgcn_readfirstlane(*qslot) - rep * (N2 + (int)G);
            __syncthreads();
            if (it >= N2) break;
            if (bx == PROBE_BLK) STAMP(8 + (seq < 5 ? seq : 5));
            int t_ = tid; asm volatile("" : "+v"(t_));
            constexpr int N_HEAVY = N_CMP + N_HG;
            if (it < 2 * N_HEAVY && !(it & 1)) { const int j = it >> 1; if (j < N_CMP) compress_item(lds, ws, args.in[2], (const int*)args.in[5], args.in[10], args.in[9], j, t_); else hgrn_local_item(lds, ws, j - N_CMP, t_); }
            else if (it < N_CMP + N_HG + N_WIN) {
                const int p = (it < 2 * N_HEAVY) ? (it >> 1) : (it - N_HEAVY);
                const int c_ = p - 448, wu = (p < 448) ? (((p / 112) << 7) | (((p / 56) & 1) << 6) | (8 + p % 56)) : (((c_ & 7) << 6) | (7 - (c_ >> 3)));
                win_prompt_unit(lds, ws, wu, t_); }
            else if (it < N_CMP + N_HG + N_WIN + N_RNN) rnn_sample_wave(ws, args.out, args.in[4], args.in[15], (it - N_CMP - N_HG - N_WIN) * 8 + __builtin_amdgcn_readfirstlane(t_ >> 6), t_ & 63);
            else {
                const int ci_ = it - (N_CMP + N_HG + N_WIN + N_RNN), b = ci_ >> 3, e = ci_ & 7;
                const f32x4* src = (const f32x4*)args.in[3] + (size_t)b * (512 * 64) + 8 * 64; f32x4* dst = (f32x4*)(args.out + O_WINS) + (size_t)b * (512 * 64);
                f32x4 v[8];
#pragma unroll
                for (int j = 0; j < 8; ++j) { const int ch = e + 8 * j; if (ch < 63) v[j] = src[ch * 512 + t_]; }
#pragma unroll
                for (int j = 0; j < 8; ++j) { const int ch = e + 8 * j; if (ch < 63) dst[ch * 512 + t_] = v[j]; }
            }
        }
        if (bx == PROBE_BLK) STAMP(15);
        if (hi > 3) GRID_BAR();
        STAMP(3);
    }
    if (IN(3)) {
        constexpr int N_SEL1 = 256, N_SA = 256, N_RNN = 128, N_SEL0 = 256, N_HC = 512, Q_RNN = N_SEL1 + N_SA, Q_SEL0 = Q_RNN + N_RNN, Q_HC = Q_SEL0 + N_SEL0, N3 = Q_HC + N_HC;
        unsigned* qc = (unsigned*)(ws + WS_CTL + CTL_Q) + 64; LAS int* qslot = (LAS int*)(lds + LDS_CTLW + 32);
        if (bx == PROBE_BLK) { STAMP(22); STAMP(16); STAMP(17); STAMP(18); STAMP(19); STAMP(20); STAMP(21); }
        for (int rep = 0; rep < REP_P3; ++rep)
        for (int seq = 0;; ++seq) {
            if (tid == 0) *qslot = (int)atomicAdd(qc, 1u);
            __syncthreads();
            const int it = __builtin_amdgcn_readfirstlane(*qslot) - rep * (N3 + (int)G);
            __syncthreads();
            if (it >= N3) break;
            if (bx == PROBE_BLK) STAMP(16 + (seq < 5 ? seq : 5));
            int t_ = tid; asm volatile("" : "+v"(t_));
            if (it < Q_RNN && !(it & 1)) { const int j = it >> 1; sel_prompt_unit(lds, ws, args.in[13], ((j & 3) << 7) | (1 << 6) | (63 - (j >> 2)), t_); }
            else if (it < Q_RNN) samp_attn_unit(lds, ws, args.in[2], args.in[3], (const int*)args.in[5], args.in[13], args.out + O_WINS, it >> 1, t_);
            else if (it < Q_SEL0) rnn_sample_wave(ws, args.out, args.in[4], args.in[15], (it - Q_RNN) * 8 + __builtin_amdgcn_readfirstlane(t_ >> 6), t_ & 63);
            else if (it < Q_HC) { const int j = it - Q_SEL0; sel_prompt_unit(lds, ws, args.in[13], ((j & 3) << 7) | (63 - (j >> 2)), t_); }
            else hgrn_combine_unit(lds, ws, args.out, args.in[15], it - Q_HC, t_);
        }
        if (bx == PROBE_BLK) STAMP(23);
        if (hi > 4) GRID_BAR();
        STAMP(4);
    }
    if (IN(4)) {
        pg8::Gemm g{(const bf16*)(ws + WS_OA), (const bf16*)(ws + WS_WO), MP, DM, DM};
        const int vcu = (hi - lo > 1) ? (int)__builtin_amdgcn_readfirstlane(((LAS unsigned*)(lds + LDS_CTLW))[6]) : bx;
        pg8::StaticOrder S; S.init(MP, DM, G, vcu);
        EpiOut E{ws, args.in[0], args.in[1]};
#define SMALL_TILES() do { SEpiOut SE{ws, args.in[1]};   \
            for (int t = bx; t < 256; t += G) small_gemm_tile<64, 1, 8, SEpiOut>(lds, (const bf16*)(ws + WS_OA), DM, (const bf16*)(ws + WS_WO), DM, DM, MP + 64 * (t >> 4), 64 * (t & 15), SE, tid); } while (0)
        if (bx & 1) SMALL_TILES();
        pg8::gemm_phase<EpiOut, true>(lds, g, S, E);
        if (!(bx & 1)) SMALL_TILES();
#undef SMALL_TILES
        if (hi > 5) GRID_BAR();
        STAMP(5);
    }
    if (IN(5)) {
        pg8::Gemm g{(const bf16*)(ws + WS_XN), (const bf16*)(ws + WS_WU), MP, DFF, DM};
        const int vcu = (hi - lo > 1) ? (int)__builtin_amdgcn_readfirstlane(((LAS unsigned*)(lds + LDS_CTLW))[6]) : bx;
        pg8::StaticOrder S; S.init(MP, DFF, G, vcu);
        EpiUp E{ws};
#define SMALL_TILES() do { SEpiUp SE{ws};   \
            for (int t = bx; t < 256; t += G) small_gemm_tile<256, 4, 2, SEpiUp>(lds, (const bf16*)(ws + WS_XN), DM, (const bf16*)(ws + WS_WU), DM, DM, MP + 64 * (t >> 4), 256 * (t & 15), SE, tid); } while (0)
        if (bx & 1) SMALL_TILES();
        pg8::gemm_phase<EpiUp, true>(lds, g, S, E);
        if (!(bx & 1)) SMALL_TILES();
#undef SMALL_TILES
        if (hi > 6) GRID_BAR();
        STAMP(6);
    }
    if (IN(6)) {
        pg8::Gemm g{(const bf16*)(ws + WS_U), (const bf16*)(ws + WS_WD), MP, DM, DFF};
        const int vcu = (hi - lo > 1) ? (int)__builtin_amdgcn_readfirstlane(((LAS unsigned*)(lds + LDS_CTLW))[6]) : bx;
        pg8::StaticOrder S; S.init(MP, DM, G, vcu);
        EpiDown E{args.out, ws};
#define SMALL_TILES() do { SEpiDown SE{args.out, ws};   \
            for (int t = bx; t < 256; t += G) small_gemm_tile<64, 1, 8, SEpiDown>(lds, (const bf16*)(ws + WS_U), DFF, (const bf16*)(ws + WS_WD), DFF, DFF, MP + 64 * (t >> 4), 64 * (t & 15), SE, tid); } while (0)
        if (bx & 1) SMALL_TILES();
        pg8::gemm_phase<EpiDown, true>(lds, g, S, E);
        if (!(bx & 1)) SMALL_TILES();
#undef SMALL_TILES
    }
    if (PROBE_A >= 0) {
        asm volatile("s_waitcnt vmcnt(0)" ::: "memory");
        const unsigned long long tend = __builtin_amdgcn_s_memrealtime();
        if ((bx == PROBE_BLK || PROBE_A < 8) && tid == 0) {
            const int pa = PROBE_A, pb = PROBE_B; LAS unsigned long long* stamp_ = (LAS unsigned long long*)(lds + LDS_STAMPS); stamp_[7] = tend;
            unsigned long long ta = (pa == 24) ? (tend - stamp_[0]) : (stamp_[PROBE_E >= 0 ? PROBE_E : pa + 1] - stamp_[pa]); if (ta > 100000000ull) ta = 0ull;
            const unsigned long long tb = pb >= 0 ? (stamp_[pb + 1] - stamp_[pb]) : 0ull;
            const unsigned long long extra = ta + 100000ull * ((tb + 400ull) / 800ull);
            while (__builtin_amdgcn_s_memrealtime() - tend < extra) __builtin_amdgcn_s_sleep(16);
        }
    }
#undef IN
#undef GRID_BAR
#undef GRID_BAR_CG
}

extern "C" void kernel_launch(void* const* d_in, const int* in_sizes, int n_in, void* d_out, int out_size, void* d_ws, size_t ws_size, hipStream_t stream) {
    static int grid = 0;
    if (grid == 0) {
        int dev = 0, cus = 0, per_cu = 0;
        (void)hipGetDevice(&dev);
        (void)hipDeviceGetAttribute(&cus, hipDeviceAttributeMultiprocessorCount, dev);
        (void)hipFuncSetAttribute((const void*)mega, hipFuncAttributeMaxDynamicSharedMemorySize, LDS_BYTES);
        (void)hipOccupancyMaxActiveBlocksPerMultiprocessor(&per_cu, (const void*)mega, 512, LDS_BYTES);
        if (per_cu < 1) per_cu = 1;
        grid = cus * 1;
        if (n_in != 20 || (size_t)out_size != O_END) fprintf(stderr, "kernel_launch: unexpected shapes n_in %d out %d\n", n_in, out_size);
        (void)hipGetLastError();
    }
    (void)hipMemsetAsync((char*)d_ws + WS_CTL, 0, CTL_BYTES, stream);
    Args a{};
    for (int i = 0; i < 20; ++i) a.in[i] = (const float*)d_in[i];
    a.out = (float*)d_out; a.ws = (unsigned char*)d_ws;
#if MK_N_LAUNCHES == 1
    a.ph_lo = 0; a.ph_hi = NPHASE;
    void* kargs[] = {&a};
    hipError_t e = hipLaunchCooperativeKernel((const void*)mega, dim3(grid), dim3(512), kargs, LDS_BYTES, stream);
    if (e != hipSuccess) fprintf(stderr, "cooperative launch failed: %s (grid %d)\n", hipGetErrorString(e), grid);
#ifdef MK_DEBUG
    if (MK_DEBUG == 1) hipLaunchKernelGGL(dbg_check_p1, dim3(192), dim3(256), 0, stream, a);
    if (MK_DEBUG >= 2) hipLaunchKernelGGL(dbg_check_cmp, dim3(1024), dim3(256), 0, stream, a, (int)MK_DEBUG);
    hipLaunchKernelGGL(dbg_final, dim3(1), dim3(1), 0, stream, a);
#endif
#else
    for (int p = 0; p < NPHASE; ++p) { a.ph_lo = p; a.ph_hi = p + 1; hipLaunchKernelGGL(mega, dim3(grid), dim3(512), LDS_BYTES, stream, a);
#ifdef MK_DEBUG
        if (p == 1 && MK_DEBUG == 1) hipLaunchKernelGGL(dbg_check_p1, dim3(192), dim3(256), 0, stream, a);
#endif
    }
#ifdef MK_DEBUG
    hipLaunchKernelGGL(dbg_final, dim3(1), dim3(1), 0, stream, a);
#endif
#endif
}
```
